# Optimizing an MI355X kernel written in HIP

```python
import math
import jax, jax.numpy as jnp
from jax import lax
import numpy as np

D_MODEL = 2048
BATCH = 16
SEQ = 256
DEPTH = 1
DEC_BATCH = 8
DEC_SEQ = 1024
PAST_LEN = 512

GRID_W = 64
MIX_WIDTH = D_MODEL
ATTN_WIDTH = MIX_WIDTH // 2
DELTA_WIDTH = MIX_WIDTH - ATTN_WIDTH
H_A = 8
HD_A = ATTN_WIDTH // (2 * H_A)
DV_A = 2 * HD_A
H_B = 8
DK_B = DELTA_WIDTH // H_B
DV_B = DELTA_WIDTH // H_B
CONV_K = 5
CHUNK = 64
Q_BLOCK = 128
D_FF = 4 * D_MODEL
ROPE_BASE = 10000.0
EPS = 1e-6
N_MOD = 6
IN_SIZES = (2 * H_A * HD_A, 2 * H_A * HD_A, H_A * DV_A, 3 * DELTA_WIDTH, DELTA_WIDTH, 2 * H_B, 2 * H_B)
IN_COLS = 2 * H_A * HD_A * 2 + H_A * DV_A + 4 * DELTA_WIDTH + 4 * H_B

kernel_name = "hymba_diffattn_gdn_prefix_diffusion_step"


def rms_norm(x, g):
    x32 = x.astype(jnp.float32)
    y = x32 * lax.rsqrt(jnp.mean(x32 * x32, axis=-1, keepdims=True) + EPS) * g.astype(jnp.float32)
    return y.astype(x.dtype)


def l2_normalize(x):
    return x * lax.rsqrt(jnp.sum(x * x, axis=-1, keepdims=True) + EPS)


def axial_rope(x, rows):
    d = x.shape[-1]
    ax = d // 2
    nf = ax // 2
    inv = 1.0 / (ROPE_BASE ** (jnp.arange(nf, dtype=jnp.float32) * 2.0 / ax))
    row = jnp.repeat(jnp.arange(rows, dtype=jnp.float32), GRID_W)
    col = jnp.tile(jnp.arange(GRID_W, dtype=jnp.float32), rows)

    def rot(xa, pos):
        ang = pos[:, None] * inv[None, :]
        cos = jnp.cos(ang)[:, None, :]
        sin = jnp.sin(ang)[:, None, :]
        x1, x2 = xa[..., :nf], xa[..., nf:]
        return jnp.concatenate([x1 * cos - x2 * sin, x1 * sin + x2 * cos], axis=-1)

    x32 = x.astype(jnp.float32)
    out = jnp.concatenate([rot(x32[..., :ax], row), rot(x32[..., ax:], col)], axis=-1)
    return out.astype(x.dtype)


def diff_attention(q, k, v, lam):
    Bn, H, Sq, _, d = q.shape
    nb = Sq // Q_BLOCK
    qb = jnp.moveaxis(q.reshape(Bn, H, nb, Q_BLOCK, 2, d), 2, 0)
    scale = d ** -0.5

    def one_block(q_blk):
        s = jnp.einsum('bhqmd,bhkmd->bhmqk', q_blk, k).astype(jnp.float32) * scale
        p = jax.nn.softmax(s, axis=-1)
        pd = p[:, :, 0] - lam * p[:, :, 1]
        return jnp.einsum('bhqk,bhkv->bhqv', pd.astype(v.dtype), v)

    o = lax.map(one_block, qb)
    return jnp.moveaxis(o, 0, 2).reshape(Bn, H, Sq, v.shape[-1])


def short_conv(x, w):
    return lax.conv_general_dilated(
        x, w[:, None, :].astype(x.dtype), (1,), [(CONV_K // 2, CONV_K // 2)],
        dimension_numbers=('NWC', 'WIO', 'NWC'), feature_group_count=x.shape[-1])


def gdn_chunked(q, k, v, beta, g, s0):
    Bn, L, H, DK = q.shape
    DV = v.shape[-1]
    n = L // CHUNK

    def blocks(t):
        return jnp.moveaxis(t.reshape((Bn, n, CHUNK, H) + t.shape[3:]), 3, 1)

    q, k, v, beta, g = blocks(q), blocks(k), blocks(v), blocks(beta), blocks(g)
    G = jnp.cumsum(g, axis=-1)
    incl = jnp.tril(jnp.ones((CHUNK, CHUNK), dtype=bool))
    strict = jnp.tril(jnp.ones((CHUNK, CHUNK), dtype=bool), -1)
    diff = G[..., :, None] - G[..., None, :]
    decay = jnp.where(incl, jnp.exp(jnp.where(incl, diff, 0.0)), 0.0)
    kb = k * beta[..., None]
    vb = v * beta[..., None]
    lmat = jnp.where(strict, jnp.einsum('bhnid,bhnjd->bhnij', kb, k) * decay, 0.0)
    eye = jnp.eye(CHUNK, dtype=jnp.float32)
    rhs = jnp.concatenate([vb, kb * jnp.exp(G)[..., None]], axis=-1)
    sol = lax.linalg.triangular_solve(lmat + eye, rhs, left_side=True, lower=True, unit_diagonal=True)
    u, w = sol[..., :DV], sol[..., DV:]
    intra = jnp.einsum('bhnid,bhnjd->bhnij', q, k) * decay
    qg = q * jnp.exp(G)[..., None]
    g_last = G[..., -1]
    kg = k * jnp.exp(g_last[..., None] - G)[..., None]

    def step(S, xs):
        w_c, u_c, qg_c, kg_c, a_c, gl_c = xs
        v_new = u_c - jnp.einsum('bhck,bhkv->bhcv', w_c, S)
        o_c = jnp.einsum('bhck,bhkv->bhcv', qg_c, S) + jnp.einsum('bhij,bhjv->bhiv', a_c, v_new)
        S = jnp.exp(gl_c)[..., None, None] * S + jnp.einsum('bhck,bhcv->bhkv', kg_c, v_new)
        return S, o_c

    xs = tuple(jnp.moveaxis(t, 2, 0) for t in (w, u, qg, kg, intra, g_last))
    S, o = lax.scan(step, s0, xs)
    o = jnp.transpose(o, (1, 0, 3, 2, 4)).reshape(Bn, L, H, DV)
    return o, S


def delta_mixer(qkv_raw, gate, a_raw, b_raw, conv_w, a_log, dt_bias, norm_w, s0):
    Bn, L, _ = qkv_raw.shape
    qkv = jax.nn.silu(short_conv(qkv_raw, conv_w)).astype(jnp.float32)
    q, k, v = jnp.split(qkv, 3, axis=-1)
    q = l2_normalize(q.reshape(Bn, L, H_B, DK_B)) * (DK_B ** -0.5)
    k = l2_normalize(k.reshape(Bn, L, H_B, DK_B))
    v = v.reshape(Bn, L, H_B, DV_B)
    a = a_raw.astype(jnp.float32).reshape(Bn, L, 2, H_B)
    b = b_raw.astype(jnp.float32).reshape(Bn, L, 2, H_B)
    g = -jnp.exp(a_log.astype(jnp.float32)) * jax.nn.softplus(a + dt_bias.astype(jnp.float32))
    beta = jax.nn.sigmoid(b)
    s0 = s0.astype(jnp.float32)
    o_f, s_f = gdn_chunked(q, k, v, beta[:, :, 0], g[:, :, 0], s0[:, 0])
    fl = lambda t: jnp.flip(t, axis=1)
    o_b, s_b = gdn_chunked(fl(q), fl(k), fl(v), fl(beta[:, :, 1]), fl(g[:, :, 1]), s0[:, 1])
    o = o_f + fl(o_b)
    o = rms_norm(o, norm_w) * jax.nn.silu(gate.reshape(Bn, L, H_B, DV_B).astype(jnp.float32))
    return o.reshape(Bn, L, DELTA_WIDTH).astype(qkv_raw.dtype), jnp.stack([s_f, s_b], axis=1)


def trunk_layer(x, mod, lam_init, w_in, conv_w, a_log, dt_bias, delta_norm, attn_lambda,
                attn_subln, norm1, w_out, norm2, w_ff1, w_ff2, ctx=None):
    Bn, L, _ = x.shape
    sh1, sc1, g1, sh2, sc2, g2 = jnp.split(mod, N_MOD, axis=-1)
    xn = rms_norm(x, norm1) * (1 + sc1) + sh1
    proj = jnp.einsum('bld,dc->blc', xn, w_in)
    offs = []
    acc = 0
    for s in IN_SIZES[:-1]:
        acc += s
        offs.append(acc)
    qa, ka, va, qkv_b, gate_b, a_b, b_b = jnp.split(proj, offs, axis=-1)

    qa = qa.reshape(Bn, L, H_A, 2, HD_A).transpose(0, 2, 1, 3, 4)
    ka = ka.reshape(Bn, L, H_A, 2, HD_A).transpose(0, 2, 1, 3, 4)
    va = va.reshape(Bn, L, H_A, DV_A).transpose(0, 2, 1, 3)
    if ctx is None:
        keys, vals = ka, va
        s0 = jnp.zeros((Bn, 2, H_B, DK_B, DV_B), jnp.float32)
    else:
        ctx_k, ctx_v, s0 = ctx
        rows = L // GRID_W
        qa = axial_rope(qa, rows)
        keys = jnp.concatenate([ctx_k.astype(ka.dtype), axial_rope(ka, rows)], axis=2)
        vals = jnp.concatenate([ctx_v.astype(va.dtype), va], axis=2)
    lp = attn_lambda.astype(jnp.float32)
    lam = jnp.exp(jnp.sum(lp[0] * lp[1])) - jnp.exp(jnp.sum(lp[2] * lp[3])) + lam_init
    oa = diff_attention(qa, keys, vals, lam)
    oa = rms_norm(oa, attn_subln) * (1.0 - lam_init)
    oa = oa.transpose(0, 2, 1, 3).reshape(Bn, L, ATTN_WIDTH).astype(x.dtype)

    ob, s_final = delta_mixer(qkv_b, gate_b, a_b, b_b, conv_w, a_log, dt_bias, delta_norm, s0)

    mixed = jnp.einsum('blc,cd->bld', jnp.concatenate([oa, ob], axis=-1), w_out)
    h = x + g1 * mixed
    hn = rms_norm(h, norm2) * (1 + sc2) + sh2
    ff = jnp.square(jax.nn.relu(jnp.einsum('bld,df->blf', hn, w_ff1)))
    y = h + g2 * jnp.einsum('blf,fd->bld', ff, w_ff2)
    if ctx is None:
        return y, (ka, va, s_final)
    return y, None


def setup_inputs(seed: int = 0) -> dict:
    key = jax.random.key(seed)
    ks = jax.random.split(key, 24)
    nrm = jax.random.normal
    D = D_MODEL
    dt = jnp.exp(jax.random.uniform(ks[15], (DEPTH, 2, H_B), minval=math.log(1e-3), maxval=math.log(1e-1)))
    return {
        "x_prompt": nrm(ks[0], (BATCH, SEQ, D)),
        "x_sample": nrm(ks[1], (DEC_BATCH, DEC_SEQ, D)),
        "cache_attn_k": nrm(ks[2], (DEC_BATCH, DEPTH, H_A, PAST_LEN, 2, HD_A)),
        "cache_attn_v": nrm(ks[3], (DEC_BATCH, DEPTH, H_A, PAST_LEN, DV_A)),
        "state_delta": 0.5 * nrm(ks[4], (DEC_BATCH, DEPTH, 2, H_B, DK_B, DV_B)),
        "c": nrm(ks[5], (DEC_BATCH, D)),
        "c_ctx": nrm(ks[6], (D,)),
        "w_mod": 0.5 * D ** -0.5 * nrm(ks[7], (DEPTH, D, N_MOD * D)),
        "b_mod": 0.01 * nrm(ks[8], (DEPTH, N_MOD * D)),
        "norm1": 1.0 + 0.01 * nrm(ks[9], (DEPTH, D)),
        "w_in": D ** -0.5 * nrm(ks[10], (DEPTH, D, IN_COLS)),
        "conv_w": CONV_K ** -0.5 * nrm(ks[11], (DEPTH, CONV_K, 3 * DELTA_WIDTH)),
        "a_log": jnp.log(jax.random.uniform(ks[12], (DEPTH, 2, H_B), minval=1.0, maxval=16.0)),
        "dt_bias": dt + jnp.log(-jnp.expm1(-dt)),
        "delta_norm": 1.0 + 0.01 * nrm(ks[13], (DEPTH, DV_B)),
        "attn_lambda": 0.1 * nrm(ks[14], (DEPTH, 4, HD_A)),
        "attn_subln": 1.0 + 0.01 * nrm(ks[16], (DEPTH, DV_A)),
        "w_out": MIX_WIDTH ** -0.5 * nrm(ks[17], (DEPTH, MIX_WIDTH, D)),
        "norm2": 1.0 + 0.01 * nrm(ks[18], (DEPTH, D)),
        "w_ff1": D ** -0.5 * nrm(ks[19], (DEPTH, D, D_FF)),
        "w_ff2": D_FF ** -0.5 * nrm(ks[20], (DEPTH, D_FF, D)),
        "norm_f": 1.0 + 0.01 * nrm(ks[21], (D,)),
    }


def reference(x_prompt, x_sample, cache_attn_k, cache_attn_v, state_delta, c, c_ctx,
              w_mod, b_mod, norm1, w_in, conv_w, a_log, dt_bias, delta_norm, attn_lambda,
              attn_subln, w_out, norm2, w_ff1, w_ff2, norm_f):
    hp, hs = x_prompt, x_sample
    sc = jax.nn.silu(c)
    scc = jax.nn.silu(c_ctx)
    new_k, new_v, new_s = [], [], []
    for l in range(DEPTH):
        lam_init = 0.8 - 0.6 * math.exp(-0.3 * l)
        mod_ctx = (scc @ w_mod[l] + b_mod[l])[None, None, :]
        mod_lat = (sc @ w_mod[l] + b_mod[l])[:, None, :]
        params = (w_in[l], conv_w[l], a_log[l], dt_bias[l], delta_norm[l], attn_lambda[l],
                  attn_subln[l], norm1[l], w_out[l], norm2[l], w_ff1[l], w_ff2[l])
        hp, (k_l, v_l, s_l) = trunk_layer(hp, mod_ctx, lam_init, *params)
        hs, _ = trunk_layer(hs, mod_lat, lam_init, *params,
                            ctx=(cache_attn_k[:, l], cache_attn_v[:, l], state_delta[:, l]))
        new_k.append(k_l)
        new_v.append(v_l)
        new_s.append(s_l)
    y_prompt = rms_norm(hp, norm_f)
    y_sample = rms_norm(hs, norm_f)
    new_attn_k = jnp.stack(new_k, axis=1)
    new_attn_v = jnp.stack(new_v, axis=1)
    new_delta_state = jnp.stack(new_s, axis=1)
    return (y_prompt, y_sample, new_attn_k, new_attn_v, new_delta_state)
```

```cpp
#include <hip/hip_runtime.h>
#include <hip/hip_bf16.h>
#include <cstdio>
#include <cstdint>
#include <cmath>

namespace pg8 {
#define PG8_LAS __attribute__((address_space(3)))
typedef unsigned short bf16_t;
typedef short bf16x8 __attribute__((ext_vector_type(8)));
typedef float f32x4 __attribute__((ext_vector_type(4)));
typedef unsigned u32x4 __attribute__((ext_vector_type(4)));
constexpr int BM = 256, BK = 64, HALF = 128, HTB = HALF * BK * 2  , STAGE_BYTES = 8 * HTB, NXCD = 8, WGM = 8;

__host__ __device__ __forceinline__ int lds_byte(int r, int c) { const int st = (r >> 4) * 2 + (c >> 5), rr = r & 15, cc = c & 31, ob = rr * 64 + cc * 2; return st * 1024 + (ob ^ (((ob >> 9) & 1) << 5)); }
__host__ __device__ __forceinline__ void stage_rc(int b, int& R, int& C) { const int st = b / 1024, sb = b % 1024, swz = sb ^ (((sb >> 9) & 1) << 5); R = (st >> 1) * 16 + swz / 64; C = (st & 1) * 32 + (swz % 64) / 2; }
__host__ __device__ __forceinline__ int perm32(int rho) { const int n = rho >> 4, i = rho & 15; return 8 * (i >> 2) + 4 * n + (i & 3); }

struct Unit { int pm, pn; };
struct Gemm { const bf16_t* A; const bf16_t* Bt; int M, N, K; };

struct StaticOrder {
    int nM, nN, nwg, G, c;
    __host__ __device__ void init(int M, int N, int G_, int c_) { nM = M / BM; nN = N / BM; nwg = nM * nN; G = G_; c = c_; }
    __host__ __device__ bool next(int i, Unit& u) const {
        const long L = (long)i * G + c; if (L >= nwg) return false;
        int wgid = (int)L; { const int q = nwg / NXCD, r = nwg % NXCD, xcd = wgid % NXCD, off = wgid / NXCD; wgid = (xcd < r ? xcd * (q + 1) : r * (q + 1) + (xcd - r) * q) + off; }
        const int nig = WGM * nN, gid = wgid / nig, fm = gid * WGM, gsz = (nM - fm) < WGM ? (nM - fm) : WGM;
        u.pm = fm + ((wgid % nig) % gsz); u.pn = (wgid % nig) / gsz; return true;
    }
    __device__ __forceinline__ void a_ready(const Unit&) const {}
    __device__ __forceinline__ void done(const Unit&) const {}
};


__device__ __forceinline__ unsigned cvt_pk_bf16(float lo, float hi) { unsigned r; asm volatile("v_cvt_pk_bf16_f32 %0, %1, %2" : "=v"(r) : "v"(lo), "v"(hi)); return r; }

typedef unsigned u32x2 __attribute__((ext_vector_type(2)));
__device__ __forceinline__ u32x2 pack4(const f32x4 v) { u32x2 w; w.x = cvt_pk_bf16(v[0], v[1]); w.y = cvt_pk_bf16(v[2], v[3]); return w; }
struct EpiInProj {
    static constexpr bool PERM = false, AFTER_DRAIN = false;
    bf16_t *QA, *KP, *VP, *KS, *VS, *QKVB, *GATE; float *outK, *outV; const float* rope;
    __device__ __forceinline__ void operator()(const f32x4 (&acc)[2][2][4][2], const Unit& u, int ui, int wr, int wc, int fr_, int fq_) const {
        int fr = fr_, fq = fq_; asm volatile("" : "+v"(fr), "+v"(fq));
        const int pm = u.pm, pn = u.pn; const bool sample = pm >= 16;
        if (pn >= 12) {
            bf16_t* base; int ld, c0;
            if (pn < 24) { base = QKVB; ld = 3072; c0 = (pn - 12) * 256; } else { base = GATE; ld = 1024; c0 = (pn - 24) * 256; }
#pragma unroll
            for (int ai = 0; ai < 2; ++ai)
#pragma unroll
                for (int m = 0; m < 4; ++m) { const size_t row = (size_t)pm * 256 + ai * 128 + wr * 64 + m * 16 + fr;
#pragma unroll
                    for (int bj = 0; bj < 2; ++bj)
#pragma unroll
                        for (int n = 0; n < 2; ++n) *(u32x2*)(base + row * ld + c0 + bj * 128 + wc * 32 + n * 16 + 4 * fq) = pack4(acc[ai][bj][m][n]); }
        } else if (pn >= 8) {
            const int tq = (pm - 16) & 3, bs = (pm - 16) >> 2;
#pragma unroll
            for (int bj = 0; bj < 2; ++bj) { const int h = 2 * (pn - 8) + bj;
#pragma unroll
                for (int ai = 0; ai < 2; ++ai)
#pragma unroll
                    for (int m = 0; m < 4; ++m) { const int tl = ai * 128 + wr * 64 + m * 16 + fr;
#pragma unroll
                        for (int n = 0; n < 2; ++n) { const int d = wc * 32 + n * 16 + 4 * fq; const f32x4 v = acc[ai][bj][m][n];
                            if (!sample) { const size_t idx = ((size_t)(pm * 8 + h) * 256 + tl) * 128 + d; *(f32x4*)(outV + idx) = v; *(u32x2*)(VP + idx) = pack4(v); }
                            else { const size_t idx = ((size_t)(bs * 8 + h) * 1536 + 512 + tq * 256 + tl) * 128 + d; *(u32x2*)(VS + idx) = pack4(v); } } } }
        } else {
            const int tq = (pm - 16) & 3, bs = (pm - 16) >> 2; const bool isK = pn >= 4; const bool colrot = (wc & 1) != 0;
#pragma unroll
            for (int ai = 0; ai < 2; ++ai) {
                f32x4 csr = {1.f, 1.f, 1.f, 1.f}, snr = {0.f, 0.f, 0.f, 0.f};
                if (sample && !colrot) { const int pos = tq * 4 + ai * 2 + wr; csr = *(const f32x4*)(rope + pos * 16 + 4 * fq); snr = *(const f32x4*)(rope + 1024 + pos * 16 + 4 * fq); }
#pragma unroll
                for (int m = 0; m < 4; ++m) { const int tl = ai * 128 + wr * 64 + m * 16 + fr;
                    f32x4 cs = csr, sn = snr;
                    if (sample && colrot) { const int pos = m * 16 + fr; cs = *(const f32x4*)(rope + pos * 16 + 4 * fq); sn = *(const f32x4*)(rope + 1024 + pos * 16 + 4 * fq); }
#pragma unroll
                    for (int bj = 0; bj < 2; ++bj) { const f32x4 x1 = acc[ai][bj][m][0], x2 = acc[ai][bj][m][1];
                        const f32x4 o1 = x1 * cs - x2 * sn, o2 = x1 * sn + x2 * cs;
                        const int d = wc * 32 + 4 * fq;
                        if (!isK) { bf16_t* p = QA + ((size_t)pm * 256 + tl) * 1024 + pn * 256 + bj * 128 + d; *(u32x2*)p = pack4(o1); *(u32x2*)(p + 16) = pack4(o2); }
                        else { const int h = 2 * (pn - 4) + bj;
                            if (!sample) { const size_t idx = ((size_t)(pm * 8 + h) * 256 + tl) * 128 + d; *(f32x4*)(outK + idx) = o1; *(f32x4*)(outK + idx + 16) = o2; *(u32x2*)(KP + idx) = pack4(o1); *(u32x2*)(KP + idx + 16) = pack4(o2); }
                            else { const size_t idx = ((size_t)(bs * 8 + h) * 1536 + 512 + tq * 256 + tl) * 128 + d; *(u32x2*)(KS + idx) = pack4(o1); *(u32x2*)(KS + idx + 16) = pack4(o2); } } } } }
        }
    }
};
struct EpiOutProj {
    static constexpr bool PERM = false, AFTER_DRAIN = false;
    const float *xp, *xs, *mod, *norm2; float* y; bf16_t* HW; float* PART;
    __device__ __forceinline__ void operator()(const f32x4 (&acc)[2][2][4][2], const Unit& u, int ui, int wr, int wc, int fr_, int fq_) const {
        int fr = fr_, fq = fq_; asm volatile("" : "+v"(fr), "+v"(fq));
        const int pm = u.pm, pn = u.pn; const int mb = pm < 16 ? 0 : 1 + ((pm - 16) >> 2);
        const float* xb = pm < 16 ? xp + (size_t)pm * 256 * 2048 : xs + (size_t)(pm - 16) * 256 * 2048;
        const float* g1 = mod + mb * 12288 + 2 * 2048; const float* sc2 = mod + mb * 12288 + 4 * 2048;
        f32x4 g1v[2][2], w2v[2][2];
#pragma unroll
        for (int bj = 0; bj < 2; ++bj)
#pragma unroll
            for (int n = 0; n < 2; ++n) { const int col = pn * 256 + bj * 128 + wc * 32 + n * 16 + 4 * fq; g1v[bj][n] = *(const f32x4*)(g1 + col);
                const f32x4 a = *(const f32x4*)(norm2 + col), b = *(const f32x4*)(sc2 + col); w2v[bj][n] = a * (b + 1.0f); }
#pragma unroll
        for (int ai = 0; ai < 2; ++ai)
#pragma unroll
            for (int m = 0; m < 4; ++m) { const int rl = ai * 128 + wr * 64 + m * 16 + fr; const size_t row = (size_t)pm * 256 + rl; float s = 0.f;
#pragma unroll
                for (int bj = 0; bj < 2; ++bj)
#pragma unroll
                    for (int n = 0; n < 2; ++n) { const int col = pn * 256 + bj * 128 + wc * 32 + n * 16 + 4 * fq;
                        const f32x4 xv = *(const f32x4*)(xb + (size_t)rl * 2048 + col); const f32x4 hv = xv + g1v[bj][n] * acc[ai][bj][m][n];
                        *(f32x4*)(y + row * 2048 + col) = hv; s += (hv[0] * hv[0] + hv[1] * hv[1]) + (hv[2] * hv[2] + hv[3] * hv[3]);
                        *(u32x2*)(HW + row * 2048 + col) = pack4(hv * w2v[bj][n]); }
                s += __shfl_xor(s, 16); s += __shfl_xor(s, 32);
                if (fq == 0) PART[row * 32 + pn * 4 + wc] = s; }
    }
};
struct EpiFF1 {
    static constexpr bool PERM = true, AFTER_DRAIN = false;
    const float* c2; bf16_t* FF; const PG8_LAS float* rstd;
    __device__ __forceinline__ void operator()(const f32x4 (&acc)[2][2][4][2], const Unit& u, int ui, int wr, int wc, int fr_, int fq_) const {
        int fr = fr_, fq = fq_; asm volatile("" : "+v"(fr), "+v"(fq));
        const int pm = u.pm, pn = u.pn; const int mb = pm < 16 ? 0 : 1 + ((pm - 16) >> 2);
        f32x4 cv[2][2];
#pragma unroll
        for (int bj = 0; bj < 2; ++bj)
#pragma unroll
            for (int n = 0; n < 2; ++n) cv[bj][n] = *(const f32x4*)(c2 + mb * 8192 + pn * 256 + bj * 128 + wc * 32 + 8 * fq + 4 * n);
#pragma unroll
        for (int ai = 0; ai < 2; ++ai)
#pragma unroll
            for (int m = 0; m < 4; ++m) { const int rl = ai * 128 + wr * 64 + m * 16 + fr; const float r = rstd[ui * 256 + rl];
                bf16_t* rowp = FF + ((size_t)pm * 256 + rl) * 8192 + pn * 256 + wc * 32 + 8 * fq;
#pragma unroll
                for (int bj = 0; bj < 2; ++bj) { f32x4 v0 = acc[ai][bj][m][0] * r + cv[bj][0], v1 = acc[ai][bj][m][1] * r + cv[bj][1];
#pragma unroll
                    for (int e = 0; e < 4; ++e) { const float a = fmaxf(v0[e], 0.f), b = fmaxf(v1[e], 0.f); v0[e] = a * a; v1[e] = b * b; }
                    u32x4 w; w.x = cvt_pk_bf16(v0[0], v0[1]); w.y = cvt_pk_bf16(v0[2], v0[3]); w.z = cvt_pk_bf16(v1[0], v1[1]); w.w = cvt_pk_bf16(v1[2], v1[3]);
                    *(u32x4*)(rowp + bj * 128) = w; } }
    }
};
struct EpiFF2 {
    static constexpr bool PERM = false, AFTER_DRAIN = false;
    const float* mod; float* y; float* PART;
    __device__ __forceinline__ void operator()(const f32x4 (&acc)[2][2][4][2], const Unit& u, int ui, int wr, int wc, int fr_, int fq_) const {
        int fr = fr_, fq = fq_; asm volatile("" : "+v"(fr), "+v"(fq));
        const int pm = u.pm, pn = u.pn; const int mb = pm < 16 ? 0 : 1 + ((pm - 16) >> 2);
        const float* g2 = mod + mb * 12288 + 5 * 2048;
        f32x4 gv[2][2];
#pragma unroll
        for (int bj = 0; bj < 2; ++bj)
#pragma unroll
            for (int n = 0; n < 2; ++n) gv[bj][n] = *(const f32x4*)(g2 + pn * 256 + bj * 128 + wc * 32 + n * 16 + 4 * fq);
#pragma unroll
        for (int ai = 0; ai < 2; ++ai)
#pragma unroll
            for (int m = 0; m < 4; ++m) { const size_t row = (size_t)pm * 256 + ai * 128 + wr * 64 + m * 16 + fr; float s = 0.f;
#pragma unroll
                for (int bj = 0; bj < 2; ++bj)
#pragma unroll
                    for (int n = 0; n < 2; ++n) { float* p = y + row * 2048 + pn * 256 + bj * 128 + wc * 32 + n * 16 + 4 * fq;
                        const f32x4 hv = *(const f32x4*)p; const f32x4 yv = hv + gv[bj][n] * acc[ai][bj][m][n];
                        *(f32x4*)p = yv; s += (yv[0] * yv[0] + yv[1] * yv[1]) + (yv[2] * yv[2] + yv[3] * yv[3]); }
                s += __shfl_xor(s, 16); s += __shfl_xor(s, 32);
                if (fq == 0) PART[row * 32 + pn * 4 + wc] = s; }
    }
};

template <class Epi, class Sched, bool ALIGN_EPI = false, bool SP2 = false>
__device__ __forceinline__ void gemm_phase(PG8_LAS unsigned char* lds, const Gemm g, const Sched& S, const Epi& E) {
    const int tid = threadIdx.x, wid = __builtin_amdgcn_readfirstlane(tid >> 6), lane = tid & 63, wr = wid >> 2, wc = wid & 3, fr = lane & 15, fq = lane >> 4;
    const int K = g.K, nt = K / BK;
    unsigned voffA[2], voffB[2];
#pragma unroll
    for (int i = 0; i < 2; ++i) { int R, C; stage_rc(tid * 16 + i * 8192, R, C); const int Rb = Epi::PERM ? ((R & ~31) + perm32(R & 31)) : R;
        voffA[i] = (unsigned)(R * K + C) * 2u; voffB[i] = (unsigned)(Rb * K + C) * 2u; }
    const size_t kstep = (size_t)(BK * 2);
    const size_t hstep = (size_t)HALF * K * 2;
    const size_t tstep = 2 * hstep;
    const unsigned ldsw = (unsigned)wid * 1024u;
    const int aoff = lds_byte(wr * 64 + fr, fq * 8), boff = lds_byte(wc * 32 + fr, fq * 8);
#define PG8_SA(b, h) (((b) * 2 + (h)) * HTB)
#define PG8_SB(b, h) ((4 + (b) * 2 + (h)) * HTB)
#define PG8_STAGE(bufoff, gbase, voff) do { _Pragma("unroll") for (int _i = 0; _i < 2; ++_i) \
        __builtin_amdgcn_global_load_lds((const unsigned*)((const char*)(gbase) + (voff)[_i]), (PG8_LAS unsigned*)(lds + (bufoff) + ldsw + _i * 8192), 16, 0, 0); } while (0)
#define PG8_LDA(dst, b, h) do { _Pragma("unroll") for (int m = 0; m < 4; ++m) _Pragma("unroll") for (int k = 0; k < 2; ++k) dst[m][k] = *(const PG8_LAS bf16x8*)(lds + PG8_SA(b, h) + aoff + m * 2048 + k * 1024); } while (0)
#define PG8_LDB(dst, b, h) do { _Pragma("unroll") for (int n = 0; n < 2; ++n) _Pragma("unroll") for (int k = 0; k < 2; ++k) dst[n][k] = *(const PG8_LAS bf16x8*)(lds + PG8_SB(b, h) + boff + n * 2048 + k * 1024); } while (0)
#define PG8_MMA(ai, bj, At, Bt) do { __builtin_amdgcn_s_setprio(1); _Pragma("unroll") for (int m = 0; m < 4; ++m) _Pragma("unroll") for (int n = 0; n < 2; ++n) _Pragma("unroll") for (int k = 0; k < 2; ++k) \
        acc[ai][bj][m][n] = __builtin_amdgcn_mfma_f32_16x16x32_bf16(Bt[n][k], At[m][k], acc[ai][bj][m][n], 0, 0, 0); __builtin_amdgcn_s_setprio(0); } while (0)
#define PG8_WAIT_V(n) asm volatile("s_waitcnt vmcnt(" #n ")" ::: "memory")
#define PG8_WAIT_L(n) asm volatile("s_waitcnt lgkmcnt(" #n ")" ::: "memory")
#define PG8_BAR __builtin_amdgcn_s_barrier()
#define PG8_SCHED __builtin_amdgcn_sched_barrier(0)
    Unit cur, nxt; int ui = 0;
    if (!S.next(0, cur)) return;
    f32x4 acc[2][2][4][2];
#pragma unroll
    for (int a = 0; a < 2; ++a)
#pragma unroll
        for (int b = 0; b < 2; ++b)
#pragma unroll
            for (int m = 0; m < 4; ++m)
#pragma unroll
                for (int n = 0; n < 2; ++n) acc[a][b][m][n] = (f32x4){0.f, 0.f, 0.f, 0.f};
    bf16x8 At[4][2], B0[2][2], B1[2][2];
    const char* cA = (const char*)g.A + (size_t)cur.pm * tstep; const char* cB = (const char*)g.Bt + (size_t)cur.pn * tstep;
    S.a_ready(cur);
    if constexpr (SP2) {
        PG8_STAGE(PG8_SB(0, 0), cB, voffB); PG8_STAGE(PG8_SB(0, 1), cB + hstep, voffB); PG8_STAGE(PG8_SA(0, 0), cA, voffA); PG8_STAGE(PG8_SA(0, 1), cA + hstep, voffA);
        if (wr == 1) PG8_BAR;
        PG8_WAIT_V(2); PG8_BAR;
        PG8_STAGE(PG8_SB(1, 0), cB + kstep, voffB); PG8_STAGE(PG8_SA(1, 0), cA + kstep, voffA); PG8_STAGE(PG8_SB(1, 1), cB + hstep + kstep, voffB);
        PG8_WAIT_V(6); PG8_BAR;
    } else {
        PG8_STAGE(PG8_SB(0, 0), cB, voffB); PG8_STAGE(PG8_SA(0, 0), cA, voffA); PG8_STAGE(PG8_SB(0, 1), cB + hstep, voffB); PG8_STAGE(PG8_SA(0, 1), cA + hstep, voffA);
        if (wr == 1) PG8_BAR;
        PG8_WAIT_V(4); PG8_BAR;
        PG8_STAGE(PG8_SB(1, 0), cB + kstep, voffB); PG8_STAGE(PG8_SA(1, 0), cA + kstep, voffA); PG8_STAGE(PG8_SB(1, 1), cB + hstep + kstep, voffB);
        PG8_WAIT_V(6); PG8_BAR;
    }
    for (;;) {
        const bool has_next = S.next(ui + 1, nxt);
        const char* nA = has_next ? (const char*)g.A + (size_t)nxt.pm * tstep : cA; const char* nB = has_next ? (const char*)g.Bt + (size_t)nxt.pn * tstep : cB;
        for (int t = 0; t < nt; t += 2) {
            const bool last = (t == nt - 2);
            const char* a1 = cA + (size_t)(t + 1) * kstep;
            const char* a2 = last ? nA : cA + (size_t)(t + 2) * kstep; const char* b2 = last ? nB : cB + (size_t)(t + 2) * kstep;
            const char* a3 = a2 + kstep; const char* b3 = b2 + kstep;
            if (last && has_next) S.a_ready(nxt);
            if constexpr (SP2) {
            PG8_LDB(B0, 0, 0); PG8_LDB(B1, 0, 1); PG8_SCHED; PG8_LDA(At, 0, 0); PG8_STAGE(PG8_SA(1, 1), a1 + hstep, voffA);
            PG8_WAIT_V(8); PG8_WAIT_L(0); PG8_BAR; PG8_MMA(0, 0, At, B0); PG8_MMA(0, 1, At, B1); PG8_BAR; PG8_SCHED;
            PG8_LDA(At, 0, 1); PG8_STAGE(PG8_SB(0, 0), b2, voffB); PG8_STAGE(PG8_SB(0, 1), b2 + hstep, voffB); PG8_STAGE(PG8_SA(0, 0), a2, voffA);
            PG8_WAIT_V(8); PG8_WAIT_L(0); PG8_BAR; PG8_MMA(1, 0, At, B0); PG8_MMA(1, 1, At, B1); PG8_BAR; PG8_SCHED;
            PG8_LDB(B0, 1, 0); PG8_LDB(B1, 1, 1); PG8_SCHED; PG8_LDA(At, 1, 0); PG8_STAGE(PG8_SA(0, 1), a2 + hstep, voffA);
            PG8_WAIT_V(8); PG8_WAIT_L(0); PG8_BAR; PG8_MMA(0, 0, At, B0); PG8_MMA(0, 1, At, B1); PG8_BAR; PG8_SCHED;
            PG8_LDA(At, 1, 1); PG8_STAGE(PG8_SB(1, 0), b3, voffB); PG8_STAGE(PG8_SB(1, 1), b3 + hstep, voffB); PG8_STAGE(PG8_SA(1, 0), a3, voffA);
            PG8_WAIT_V(8); PG8_WAIT_L(0); PG8_BAR; PG8_MMA(1, 0, At, B0); PG8_MMA(1, 1, At, B1); PG8_BAR; PG8_SCHED;
            } else {
            PG8_LDB(B0, 0, 0); PG8_SCHED; PG8_LDA(At, 0, 0); PG8_STAGE(PG8_SA(1, 1), a1 + hstep, voffA);
            PG8_WAIT_L(8); PG8_BAR; PG8_WAIT_L(0); PG8_MMA(0, 0, At, B0); PG8_BAR; PG8_SCHED;
            PG8_LDB(B1, 0, 1); PG8_STAGE(PG8_SB(0, 0), b2, voffB);
            PG8_BAR; PG8_WAIT_L(0); PG8_MMA(0, 1, At, B1); PG8_BAR;
            PG8_LDA(At, 0, 1); PG8_STAGE(PG8_SA(0, 0), a2, voffA);
            PG8_BAR; PG8_WAIT_L(0); PG8_MMA(1, 0, At, B0); PG8_BAR; PG8_SCHED;
            PG8_STAGE(PG8_SB(0, 1), b2 + hstep, voffB);
            PG8_WAIT_V(6); PG8_BAR; PG8_MMA(1, 1, At, B1); PG8_BAR;
            PG8_LDB(B0, 1, 0); PG8_SCHED; PG8_LDA(At, 1, 0); PG8_STAGE(PG8_SA(0, 1), a2 + hstep, voffA);
            PG8_WAIT_L(8); PG8_BAR; PG8_WAIT_L(0); PG8_MMA(0, 0, At, B0); PG8_BAR; PG8_SCHED;
            PG8_LDB(B1, 1, 1); PG8_STAGE(PG8_SB(1, 0), b3, voffB);
            PG8_BAR; PG8_WAIT_L(0); PG8_MMA(0, 1, At, B1); PG8_BAR;
            PG8_LDA(At, 1, 1); PG8_STAGE(PG8_SA(1, 0), a3, voffA);
            PG8_BAR; PG8_WAIT_L(0); PG8_MMA(1, 0, At, B0); PG8_BAR; PG8_SCHED;
            PG8_STAGE(PG8_SB(1, 1), b3 + hstep, voffB);
            PG8_WAIT_V(6); PG8_BAR; PG8_MMA(1, 1, At, B1); PG8_BAR;
            }
        }
        if constexpr (ALIGN_EPI) { if (wr == 0) PG8_BAR; }
        if constexpr (!Epi::AFTER_DRAIN) { E(acc, cur, ui, wr, wc, fr, fq); S.done(cur); }
        if (!has_next) break;
#pragma unroll
        for (int a = 0; a < 2; ++a)
#pragma unroll
            for (int b = 0; b < 2; ++b)
#pragma unroll
                for (int m = 0; m < 4; ++m)
#pragma unroll
                    for (int n = 0; n < 2; ++n) acc[a][b][m][n] = (f32x4){0.f, 0.f, 0.f, 0.f};
        cur = nxt; cA = nA; cB = nB; ++ui;
        if constexpr (ALIGN_EPI) { if (wr == 1) PG8_BAR; }
    }
    PG8_WAIT_V(0);
    if constexpr (!ALIGN_EPI) { if (wr == 0) PG8_BAR; }
    PG8_BAR;
    if constexpr (Epi::AFTER_DRAIN) { E.fused(acc, cur, wr, wc, fr, fq, lds, wid, lane); S.done(cur); }
#undef PG8_SA
#undef PG8_SB
#undef PG8_STAGE
#undef PG8_LDA
#undef PG8_LDB
#undef PG8_MMA
#undef PG8_WAIT_V
#undef PG8_WAIT_L
#undef PG8_BAR
#undef PG8_SCHED
}
}

#define GAS __attribute__((address_space(1)))
#define LAS __attribute__((address_space(3)))
typedef unsigned short bf16;
typedef unsigned v4u __attribute__((ext_vector_type(4)));
typedef float f32x4 __attribute__((ext_vector_type(4)));
typedef short bf16x8 __attribute__((ext_vector_type(8)));
typedef GAS unsigned gu32;
typedef GAS unsigned long long gu64;
#define RLX_AGENT __ATOMIC_RELAXED, __HIP_MEMORY_SCOPE_AGENT
#define LDS_WAIT() asm volatile("s_waitcnt lgkmcnt(0)" ::: "memory")
#define VM_WAIT() asm volatile("s_waitcnt vmcnt(0)" ::: "memory")
__device__ __forceinline__ unsigned long long rt() { return __builtin_amdgcn_s_memrealtime(); }
__device__ __forceinline__ unsigned f2bf(float f) { unsigned u = __builtin_bit_cast(unsigned, f); return (u + 0x7fffu + ((u >> 16) & 1u)) >> 16; }
__device__ __forceinline__ unsigned pk2(float lo, float hi) { return f2bf(lo) | (f2bf(hi) << 16); }

#define XB_TMO      128
#define XB_XCNT(j)  (256  + 64 * (j))
#define XB_XSUB(j)  (1280 + 64 * (j))
#define XB_XGEN(j)  (2304 + 64 * (j))
#define XB_TOP      3328
#define XB_TOPGEN   3392
#define XCD_BAR_WORDS 3456
#define XB_SPIN_CAP (1u << 18)

__device__ __forceinline__ unsigned xb_ld(unsigned* p)              { return __hip_atomic_load(p, __ATOMIC_RELAXED, __HIP_MEMORY_SCOPE_AGENT); }
__device__ __forceinline__ unsigned xb_add(unsigned* p, unsigned v) { return __hip_atomic_fetch_add(p, v, __ATOMIC_RELAXED, __HIP_MEMORY_SCOPE_AGENT); }
__device__ __forceinline__ unsigned xb_xcc_id() { return (unsigned)__builtin_amdgcn_s_getreg((3 << 11) | 20) & 0xFu; }
#define XB_SPIN(cond, bar) do { unsigned _sp = 0; while (cond) { __builtin_amdgcn_s_sleep(1); \
    if ((++_sp & 255u) == 0u) { if (xb_ld(&(bar)[XB_TMO])) break; if (_sp > XB_SPIN_CAP) { atomicAdd(&(bar)[XB_TMO], 1u); break; } } } } while (0)

struct XcdBarrier {
    unsigned* bar; unsigned x;
    volatile LAS unsigned* st;
};

__device__ __forceinline__ XcdBarrier xcd_barrier_post(unsigned* bar, volatile LAS unsigned* st) {
    XcdBarrier b; b.bar = bar; b.x = xb_xcc_id(); b.st = st;
    if (threadIdx.x == 0) (void)xb_add(&bar[XB_XCNT(b.x)], 1u);
    return b;
}
__device__ __forceinline__ void xcd_barrier_complete(unsigned* bar, unsigned x, unsigned& nloc, unsigned& nx) {
    const unsigned G = gridDim.x * gridDim.y * gridDim.z;
    unsigned sum, cnt, mine, sp = 0u;
    for (;;) {
        sum = 0u; cnt = 0u; mine = 0u;
#pragma unroll
        for (unsigned j = 0; j < 16; ++j) { const unsigned c = xb_ld(&bar[XB_XCNT(j)]); sum += c; cnt += (c > 0u) ? 1u : 0u; mine = (j == x) ? c : mine; }
        if (sum == G) break;
        __builtin_amdgcn_s_sleep(1);
        if ((++sp & 255u) == 0u) { if (xb_ld(&bar[XB_TMO])) break; if (sp > XB_SPIN_CAP) { atomicAdd(&bar[XB_TMO], 1u); break; } }
    }
    nloc = mine > 0u ? mine : 1u; nx = cnt > 0u ? cnt : 1u;
}

__device__ __forceinline__ void xcd_barrier(const XcdBarrier& b) {
    asm volatile("s_waitcnt vmcnt(0)" ::: "memory");
    __syncthreads();
    if (threadIdx.x == 0) {
        unsigned* bar = b.bar;
        __builtin_amdgcn_s_waitcnt(0);
        unsigned nloc = b.st[0], nx = b.st[1];
        if (nloc == 0u) { xcd_barrier_complete(bar, b.x, nloc, nx); b.st[0] = nloc; b.st[1] = nx; }
        const unsigned old = xb_add(&bar[XB_XSUB(b.x)], 1u);
        const unsigned gen = old / nloc;
        if (old + 1u == (gen + 1u) * nloc) {
            __builtin_amdgcn_fence(__ATOMIC_RELEASE, "agent");
            asm volatile("s_waitcnt vmcnt(0)" ::: "memory");
            const unsigned og = xb_add(&bar[XB_TOP], 1u);
            const unsigned tg = og / nx;
            if (og + 1u == (tg + 1u) * nx) xb_add(&bar[XB_TOPGEN], 1u);
            else XB_SPIN(xb_ld(&bar[XB_TOPGEN]) == tg, bar);
            __builtin_amdgcn_fence(__ATOMIC_ACQUIRE, "agent");
            xb_add(&bar[XB_XGEN(b.x)], 1u);
            asm volatile("s_waitcnt vmcnt(0)" ::: "memory");
        } else {
            XB_SPIN(xb_ld(&bar[XB_XGEN(b.x)]) == gen, bar);
            __builtin_amdgcn_fence(__ATOMIC_ACQUIRE, "agent");
            asm volatile("s_waitcnt vmcnt(0)" ::: "memory");
        }
    }
    __syncthreads();
}

constexpr int NWAVES = 8;
constexpr int DM = 2048, NPROMPT = 4096, NSAMPLE = 8192, MROWS = 12288, DFF = 8192, INC = 7200, NMOD = 12288;
constexpr float EPS = 1e-6f;
constexpr size_t MiB = 1u << 20;
constexpr size_t WS_CTL = 0, CTL_ZERO_BYTES = 1 * MiB;
constexpr size_t WS_MOD = 1 * MiB;
constexpr size_t WS_C2 = WS_MOD + 9 * 12288 * 4;
constexpr size_t WS_ROPE = WS_C2 + 9 * 8192 * 4;
constexpr size_t WS_PART = 2 * MiB, WS_PART2 = 4 * MiB, WS_AB = 6 * MiB;
constexpr size_t WS_EVEC = 8 * MiB;
constexpr size_t WS_WOUT = 12 * MiB, WS_WFF1 = 20 * MiB, WS_WFF2 = 52 * MiB, WS_WIN = 84 * MiB;
constexpr size_t WS_QHAT = 84 * MiB;
constexpr size_t WS_KS = 113 * MiB, WS_VS = 137 * MiB;
constexpr size_t WS_QKVB = 161 * MiB;
constexpr size_t WS_HW = 161 * MiB;
constexpr size_t WS_MIX = 233 * MiB;
constexpr size_t WS_KHT = 281 * MiB;
constexpr size_t WS_XN = 305 * MiB;
constexpr size_t WS_NW = 305 * MiB;
constexpr size_t WS_U = 353 * MiB;
constexpr size_t WS_INTRA = 401 * MiB;
constexpr size_t WS_FF = 209 * MiB;
constexpr size_t WS_END = 425 * MiB;
static_assert(WS_ROPE + 2048 * 4 <= WS_PART && WS_EVEC + 3072 * 192 * 4 <= WS_WOUT && WS_WIN + (size_t)INC * DM * 2 <= WS_KS && WS_FF + (size_t)MROWS * DFF * 2 <= WS_INTRA + 24 * MiB, "ws map");
static_assert(WS_HW + 48 * MiB <= WS_FF, "HW below FF");
constexpr size_t YO_QA = 0, YO_GATE = 24 * MiB, YO_KP = 48 * MiB, YO_VP = 56 * MiB, YO_OF = 48 * MiB, YO_OB = 72 * MiB;
constexpr size_t OUT_Y = 0, OUT_K = 25165824, OUT_V = OUT_K + 4194304, OUT_S = OUT_V + 4194304;
constexpr int CW_TMO = 0, CW_BAR = 4096;
constexpr int RING_OFF = 0, RING_BYTES = 131072, LDSCTL_OFF = RING_BYTES, MISC_OFF = LDSCTL_OFF + 320, RSTD_OFF = LDSCTL_OFF + 512, LDS_BYTES = 147456;
static_assert(RSTD_OFF + 6 * 256 * 4 <= LDS_BYTES, "LDS map");

typedef unsigned short bf16;
typedef unsigned u32x2 __attribute__((ext_vector_type(2)));
typedef float f32x16 __attribute__((ext_vector_type(16)));
typedef short s16x4 __attribute__((ext_vector_type(4)));
__device__ __forceinline__ float bf2f(unsigned short v) { return __builtin_bit_cast(float, (unsigned)v << 16); }
__device__ __forceinline__ float bflo(unsigned w) { return __builtin_bit_cast(float, w << 16); }
__device__ __forceinline__ float bfhi(unsigned w) { return __builtin_bit_cast(float, w & 0xffff0000u); }
__device__ __forceinline__ unsigned cvtpk(float lo, float hi) { unsigned r; asm volatile("v_cvt_pk_bf16_f32 %0, %1, %2" : "=v"(r) : "v"(lo), "v"(hi)); return r; }
__device__ __forceinline__ float wave_sum(float v) {
#pragma unroll
    for (int o = 1; o < 64; o <<= 1) v += __shfl_xor(v, o);
    return v;
}
__device__ __forceinline__ int crow(int r, int hi) { return (r & 3) + 8 * (r >> 2) + 4 * hi; }
__device__ __forceinline__ float silu_f(float x) { return x / (1.0f + __expf(-x)); }

struct Frame {
    LAS unsigned char* lds; unsigned char* ldsg;
    volatile LAS unsigned* MISC;
    gu32* ctl;
    int tid, lane, wave, vcu, G;
    const float* const* inp; float* out; unsigned char* ws;
};

__device__ __forceinline__ void p0_transpose_item(const float* W, int K, int N, bf16* WT, LAS float* scr, int item, int lane) {
    const int nblk = (N + 63) / 64, kb = item / nblk, nb = item % nblk, k0 = 64 * kb, n0 = 64 * nb;
    const int c = 4 * (lane & 15);
    const bool cval = (n0 + c) < N;
#pragma unroll 4
    for (int i = 0; i < 16; ++i) { const int kk = 4 * i + (lane >> 4);
        f32x4 v = {0.f, 0.f, 0.f, 0.f}; if (cval) v = *(const f32x4*)(W + (size_t)(k0 + kk) * N + n0 + c);
        LAS float* d = scr + kk * 65 + c; d[0] = v[0]; d[1] = v[1]; d[2] = v[2]; d[3] = v[3]; }
    LDS_WAIT(); asm volatile("" ::: "memory");
    const int c8 = lane & 7;
#pragma unroll
    for (int j = 0; j < 8; ++j) { const int n = (lane >> 3) + 8 * j; const LAS float* s = scr + (8 * c8) * 65 + n;
        v4u o; o.x = cvtpk(s[0 * 65], s[1 * 65]); o.y = cvtpk(s[2 * 65], s[3 * 65]); o.z = cvtpk(s[4 * 65], s[5 * 65]); o.w = cvtpk(s[6 * 65], s[7 * 65]);
        if (n0 + n < N) *(GAS v4u*)(WT + (size_t)(n0 + n) * K + k0 + 8 * c8) = o; }
    LDS_WAIT(); asm volatile("" ::: "memory");
}
__device__ __forceinline__ void p0_phase(Frame& F) {
    const float* c_lat = F.inp[5]; const float* c_ctx = F.inp[6]; const float* w_mod = F.inp[7]; const float* b_mod = F.inp[8];
    float* MOD = (float*)(F.ws + WS_MOD);
    const int bid = F.vcu;
    if (bid < 192) {
        LAS float* sil = (LAS float*)(F.lds);
        LAS float* red = (LAS float*)(F.lds + 9 * 2048 * 4);
        for (int idx = F.tid; idx < 9 * 2048; idx += 512) { const int b = idx >> 11, k = idx & 2047; const float cv = (b == 0) ? c_ctx[k] : c_lat[(b - 1) * 2048 + k]; sil[idx] = silu_f(cv); }
        __syncthreads();
        const int c0 = 64 * bid + 4 * (F.lane & 15);
        f32x4 acc[9];
#pragma unroll
        for (int b = 0; b < 9; ++b) acc[b] = (f32x4){0.f, 0.f, 0.f, 0.f};
        const int kbase = 256 * F.wave + (F.lane >> 4);
#pragma unroll 4
        for (int it = 0; it < 64; ++it) { const int k = kbase + 4 * it; const f32x4 wv = *(const f32x4*)(w_mod + (size_t)k * NMOD + c0);
#pragma unroll
            for (int b = 0; b < 9; ++b) { const float s = sil[b * 2048 + k]; acc[b] += wv * s; } }
#pragma unroll
        for (int b = 0; b < 9; ++b)
#pragma unroll
            for (int e = 0; e < 4; ++e) { float v = acc[b][e]; v += __shfl_xor(v, 16); v += __shfl_xor(v, 32); acc[b][e] = v; }
        if (F.lane < 16) {
#pragma unroll
            for (int b = 0; b < 9; ++b)
#pragma unroll
                for (int e = 0; e < 4; ++e) red[(F.wave * 9 + b) * 64 + 4 * F.lane + e] = acc[b][e]; }
        __syncthreads();
        for (int idx = F.tid; idx < 9 * 64; idx += 512) { const int b = idx >> 6, cc = idx & 63; float s = b_mod[64 * bid + cc];
#pragma unroll
            for (int w = 0; w < 8; ++w) s += red[(w * 9 + b) * 64 + cc];
            MOD[b * NMOD + 64 * bid + cc] = s; }
        __syncthreads();
    } else {
        const float* ck = F.inp[2]; const float* cv = F.inp[3];
        bf16* KS = (bf16*)(F.ws + WS_KS); bf16* VS = (bf16*)(F.ws + WS_VS);
        const int gw = (bid - 192) * NWAVES + F.wave, NGW = 64 * NWAVES;
        for (int it = gw; it < 2 * 8192; it += NGW) { const bool isV = it >= 8192; const int j = isV ? it - 8192 : it;
            const size_t e0 = (size_t)j * 512 + 8 * F.lane; const int bh = (int)(e0 >> 16); const size_t rem = e0 & 65535;
            const float* src = (isV ? cv : ck) + e0; const f32x4 a = *(const f32x4*)src, b = *(const f32x4*)(src + 4);
            v4u o; o.x = cvtpk(a[0], a[1]); o.y = cvtpk(a[2], a[3]); o.z = cvtpk(b[0], b[1]); o.w = cvtpk(b[2], b[3]);
            *(GAS v4u*)((isV ? VS : KS) + (size_t)bh * 1536 * 128 + rem) = o; }
        if (bid == 255) { float* rope = (float*)(F.ws + WS_ROPE);
            for (int idx = F.tid; idx < 1024; idx += 512) { const int pos = idx >> 4, i = idx & 15; const float inv = 1.0f / powf(10000.0f, (float)i * (1.0f / 16.0f)); const float ang = (float)pos * inv;
                rope[idx] = cosf(ang); rope[1024 + idx] = sinf(ang); } }
    }
    {
        LAS float* scr = (LAS float*)(F.lds + F.wave * 16640);
        const int gw = bid * NWAVES + F.wave, NGW = F.G * NWAVES;
        constexpr int I_IN = (DM / 64) * ((INC + 63) / 64), I_OUT = (DM / 64) * (DM / 64), I_F1 = (DM / 64) * (DFF / 64), I_F2 = (DFF / 64) * (DM / 64);
        constexpr int NITEMS = I_IN + I_OUT + I_F1 + I_F2;
        for (int it = gw; it < NITEMS; it += NGW) {
            int r = it;
            if (r < I_IN) { p0_transpose_item(F.inp[10], DM, INC, (bf16*)(F.ws + WS_WIN), scr, r, F.lane); continue; } r -= I_IN;
            if (r < I_OUT) { p0_transpose_item(F.inp[17], DM, DM, (bf16*)(F.ws + WS_WOUT), scr, r, F.lane); continue; } r -= I_OUT;
            if (r < I_F1) { p0_transpose_item(F.inp[19], DM, DFF, (bf16*)(F.ws + WS_WFF1), scr, r, F.lane); continue; } r -= I_F1;
            p0_transpose_item(F.inp[20], DFF, DM, (bf16*)(F.ws + WS_WFF2), scr, r, F.lane);
        }
    }
}
__device__ __forceinline__ void p1_phase(Frame& F) {
    const float* MOD = (const float*)(F.ws + WS_MOD); const float* norm1 = F.inp[9];
    bf16* XN = (bf16*)(F.ws + WS_XN);
    const int gw = F.vcu * NWAVES + F.wave, NGW = F.G * NWAVES;
    for (int row = gw; row < MROWS; row += NGW) {
        const int mb = row < NPROMPT ? 0 : 1 + ((row - NPROMPT) >> 10);
        const float* xr = row < NPROMPT ? F.inp[0] + (size_t)row * DM : F.inp[1] + (size_t)(row - NPROMPT) * DM;
        const float* sh1 = MOD + mb * NMOD; const float* sc1 = sh1 + DM;
        f32x4 v[8]; float ss = 0.f;
#pragma unroll
        for (int j = 0; j < 8; ++j) { v[j] = *(const f32x4*)(xr + 4 * (F.lane + 64 * j)); ss += (v[j][0] * v[j][0] + v[j][1] * v[j][1]) + (v[j][2] * v[j][2] + v[j][3] * v[j][3]); }
        const float rstd = rsqrtf(wave_sum(ss) * (1.0f / DM) + EPS);
#pragma unroll
        for (int j = 0; j < 8; ++j) { const int k = 4 * (F.lane + 64 * j);
            const f32x4 g = *(const f32x4*)(norm1 + k), s = *(const f32x4*)(sc1 + k), b = *(const f32x4*)(sh1 + k);
            const f32x4 o = v[j] * rstd * g * (s + 1.0f) + b;
            u32x2 w; w.x = cvtpk(o[0], o[1]); w.y = cvtpk(o[2], o[3]); *(u32x2*)(XN + (size_t)row * DM + k) = w; }
    }
    const bf16* W1t = (const bf16*)(F.ws + WS_WFF1); float* C2 = (float*)(F.ws + WS_C2);
    for (int f = gw; f < DFF; f += NGW) {
        float wv[32];
#pragma unroll
        for (int j = 0; j < 4; ++j) { const v4u w = *(const GAS v4u*)(W1t + (size_t)f * DM + 8 * (F.lane + 64 * j));
            wv[8 * j + 0] = bflo(w.x); wv[8 * j + 1] = bfhi(w.x); wv[8 * j + 2] = bflo(w.y); wv[8 * j + 3] = bfhi(w.y);
            wv[8 * j + 4] = bflo(w.z); wv[8 * j + 5] = bfhi(w.z); wv[8 * j + 6] = bflo(w.w); wv[8 * j + 7] = bfhi(w.w); }
        for (int mb = 0; mb < 9; ++mb) { const float* sh2 = MOD + mb * NMOD + 3 * DM; float s = 0.f;
#pragma unroll
            for (int j = 0; j < 4; ++j) { const f32x4 a = *(const f32x4*)(sh2 + 8 * (F.lane + 64 * j)), b = *(const f32x4*)(sh2 + 8 * (F.lane + 64 * j) + 4);
                s += a[0] * wv[8 * j] + a[1] * wv[8 * j + 1] + a[2] * wv[8 * j + 2] + a[3] * wv[8 * j + 3] + b[0] * wv[8 * j + 4] + b[1] * wv[8 * j + 5] + b[2] * wv[8 * j + 6] + b[3] * wv[8 * j + 7]; }
            s = wave_sum(s); if (F.lane == 0) C2[mb * DFF + f] = s; }
    }
}

__device__ __forceinline__ void p2_ab(Frame& F) {
    const bf16* XN = (const bf16*)(F.ws + WS_XN); const bf16* Wab = (const bf16*)(F.ws + WS_WIN) + (size_t)7168 * DM; float* AB = (float*)(F.ws + WS_AB);
    const int id = F.wave * F.G + F.vcu;
    if (id >= MROWS / 32) return;
    const int r32 = F.lane & 31, hi = F.lane >> 5;
    const bf16* ap = XN + (size_t)(id * 32 + r32) * DM + 8 * hi; const bf16* bp = Wab + (size_t)r32 * DM + 8 * hi;
    f32x16 acc = {};
#pragma unroll 8
    for (int s = 0; s < DM / 16; ++s) { const bf16x8 a = *(const bf16x8*)(ap + 16 * s), b = *(const bf16x8*)(bp + 16 * s); acc = __builtin_amdgcn_mfma_f32_32x32x16_bf16(a, b, acc, 0, 0, 0); }
#pragma unroll
    for (int r = 0; r < 16; ++r) AB[(size_t)(id * 32 + crow(r, hi)) * 32 + r32] = acc[r];
}

namespace dattn {
using bf16x8 = __attribute__((ext_vector_type(8))) short;
using u32x4 = __attribute__((ext_vector_type(4))) unsigned;
constexpr int KVBLK = 64; constexpr float SCALE = 0.125f; constexpr float THR = 8.f;
constexpr int SHM_V = 64 * 128 * 2, SHM_K = 64 * 128 * 2;
#define KSWZ(row, colB) ((row) * 256 + ((colB) ^ (((row) & 7) << 4)))
#define SBAR() __builtin_amdgcn_sched_barrier(0)
__device__ __forceinline__ void partialSM(f32x16& p0, f32x16& p1, float& m_reg, float& mn, float& alpha) {
  constexpr float C = SCALE * 1.4426950408889634f;
  float pmax = p0[0];
#pragma unroll
  for (int r = 1; r < 16; ++r) pmax = fmaxf(pmax, p0[r]);
#pragma unroll
  for (int r = 0; r < 16; ++r) pmax = fmaxf(pmax, p1[r]);
  { auto rr = __builtin_amdgcn_permlane32_swap(__float_as_uint(pmax), __float_as_uint(pmax), false, false);
    pmax = fmaxf(__uint_as_float(rr[0]), __uint_as_float(rr[1])); }
  if (__builtin_expect(__all(pmax - m_reg <= THR / SCALE), 1)) { mn = m_reg; alpha = 1.f; }
  else { mn = fmaxf(m_reg, pmax); alpha = __builtin_amdgcn_exp2f((m_reg - mn) * C); m_reg = mn; }
  float mnC = -mn * C;
#pragma unroll
  for (int r = 0; r < 16; ++r) p0[r] = fmaf(p0[r], C, mnC);
#pragma unroll
  for (int r = 0; r < 16; ++r) p1[r] = fmaf(p1[r], C, mnC);
#pragma unroll
  for (int r = 0; r < 16; ++r) p0[r] = __builtin_amdgcn_exp2f(p0[r]);
}
__device__ __forceinline__ void finishSM(f32x16& p0, f32x16& p1, float alpha, float& l_reg, bf16x8& pa0, bf16x8& pa1, bf16x8& pa2, bf16x8& pa3) {
#pragma unroll
  for (int r = 0; r < 16; ++r) p1[r] = __builtin_amdgcn_exp2f(p1[r]);
  float ps = 0;
#pragma unroll
  for (int r = 0; r < 16; ++r) ps += p0[r];
#pragma unroll
  for (int r = 0; r < 16; ++r) ps += p1[r];
  { auto rr = __builtin_amdgcn_permlane32_swap(__float_as_uint(ps), __float_as_uint(ps), false, false);
    ps = __uint_as_float(rr[0]) + __uint_as_float(rr[1]); }
  l_reg = l_reg * alpha + ps;
#define PK4(P, BASE, OUT) do { unsigned a0 = cvtpk(P[BASE + 0], P[BASE + 1]), a1 = cvtpk(P[BASE + 2], P[BASE + 3]);   \
    unsigned b0 = cvtpk(P[BASE + 4], P[BASE + 5]), b1 = cvtpk(P[BASE + 6], P[BASE + 7]);                              \
    auto r0 = __builtin_amdgcn_permlane32_swap(a0, b0, false, false); auto r1 = __builtin_amdgcn_permlane32_swap(a1, b1, false, false); \
    u32x4 w = {r0[0], r1[0], r0[1], r1[1]}; OUT = *reinterpret_cast<bf16x8*>(&w); } while (0)
  PK4(p0, 0, pa0); PK4(p0, 8, pa1); PK4(p1, 0, pa2); PK4(p1, 8, pa3);
#undef PK4
}
__device__ __forceinline__ void qkt(f32x16& p0, f32x16& p1, const bf16* Ks, const bf16x8* qr, int r32, int hi, int map) {
  p0 = f32x16{}; p1 = f32x16{};
#pragma unroll
  for (int d0 = 0; d0 < 4; ++d0) { int cb = (map * 64 + d0 * 16 + hi * 8) * 2;
    bf16x8 b0 = *reinterpret_cast<const bf16x8*>((const char*)Ks + KSWZ(r32, cb));
    bf16x8 b1 = *reinterpret_cast<const bf16x8*>((const char*)Ks + KSWZ(32 + r32, cb));
    p0 = __builtin_amdgcn_mfma_f32_32x32x16_bf16(b0, qr[d0], p0, 0, 0, 0);
    p1 = __builtin_amdgcn_mfma_f32_32x32x16_bf16(b1, qr[d0], p1, 0, 0, 0); }
}
__device__ __forceinline__ int v_st(int k, int c) { const int kk = (k & ~0xC) | ((k & 4) << 1) | ((k & 8) >> 1); return ((kk >> 3) * 4 + (c >> 5)) * 512 + ((kk & 7) * 32 + (c & 31)) * 2; }
__device__ __forceinline__ int v_rd_base(int lane) { return ((lane & 3) << 3) | (((lane >> 2) & 3) << 6) | (((lane >> 4) & 1) << 5) | (((lane >> 5) & 1) << 8); }
constexpr int v_rd_off(int d0, int ks, int half) { return d0 * 512 + ks * 4096 + half * 2048; }
template <int OFF> __device__ __forceinline__ s16x4 tr_read(int vb) {
  s16x4 r; asm volatile("ds_read_b64_tr_b16 %0, %1 offset:%2" : "=&v"(r) : "v"(vb), "i"(OFF) : "memory"); return r;
}
template <int D0> __device__ __forceinline__ void pv_one(f32x16& od, int vb, bf16x8 pa0, bf16x8 pa1, bf16x8 pa2, bf16x8 pa3) {
  const s16x4 l0 = tr_read<v_rd_off(D0, 0, 0)>(vb), h0 = tr_read<v_rd_off(D0, 0, 1)>(vb), l1 = tr_read<v_rd_off(D0, 1, 0)>(vb), h1 = tr_read<v_rd_off(D0, 1, 1)>(vb);
  const s16x4 l2 = tr_read<v_rd_off(D0, 2, 0)>(vb), h2 = tr_read<v_rd_off(D0, 2, 1)>(vb), l3 = tr_read<v_rd_off(D0, 3, 0)>(vb), h3 = tr_read<v_rd_off(D0, 3, 1)>(vb);
  asm volatile("s_waitcnt lgkmcnt(0)" ::: "memory"); SBAR();
#define PK(L, H) (bf16x8){L[0], L[1], L[2], L[3], H[0], H[1], H[2], H[3]}
  od = __builtin_amdgcn_mfma_f32_32x32x16_bf16(pa0, PK(l0, h0), od, 0, 0, 0);
  od = __builtin_amdgcn_mfma_f32_32x32x16_bf16(pa1, PK(l1, h1), od, 0, 0, 0);
  od = __builtin_amdgcn_mfma_f32_32x32x16_bf16(pa2, PK(l2, h2), od, 0, 0, 0);
  od = __builtin_amdgcn_mfma_f32_32x32x16_bf16(pa3, PK(l3, h3), od, 0, 0, 0);
#undef PK
}
__device__ __forceinline__ void pv_d0(f32x16* o, int vb, bf16x8 pa0, bf16x8 pa1, bf16x8 pa2, bf16x8 pa3) {
  pv_one<0>(o[0], vb, pa0, pa1, pa2, pa3); pv_one<1>(o[1], vb, pa0, pa1, pa2, pa3); pv_one<2>(o[2], vb, pa0, pa1, pa2, pa3); pv_one<3>(o[3], vb, pa0, pa1, pa2, pa3);
}
__device__ __forceinline__ void attn_unit(const bf16* __restrict__ Qb, const bf16* __restrict__ Kh, const bf16* __restrict__ Vh, bf16* __restrict__ Ob, int seq, float lam, const float* __restrict__ subln, char* lds) {
  constexpr int LDQ = 1024, LDK = 128, LDO = 2048;
  const int tid = threadIdx.x, wid = tid >> 6, lane = tid & 63, r32 = lane & 31, hi = lane >> 5;
  const int map = wid >> 2, qw = wid & 3;
  bf16* V_lds = (bf16*)lds; bf16* K_lds = (bf16*)(lds + 2 * SHM_V);
  float* ws = (float*)(lds + 2 * SHM_V + 2 * SHM_K) + wid * 64; float* li_l = ws; float* al_l = ws + 32;
  float m_reg = -1e30f, l_reg = 0; f32x16 o[4] = {}; bf16x8 qr[4];
  const bf16* Qw = Qb + (long)(qw * 32 + r32) * LDQ + map * 64 + hi * 8;
#pragma unroll
  for (int d0 = 0; d0 < 4; ++d0) qr[d0] = *reinterpret_cast<const bf16x8*>(Qw + d0 * 16);
  const int sr = tid >> 4, sc = (tid & 15) * 8, vst0 = v_st(sr, sc), vst1 = v_st(32 + sr, sc);
  const int vb0 = (int)(uintptr_t)V_lds + v_rd_base(lane);
  struct { bf16x8 vs0, vs1, ks0, ks1; } sr_[2];
#define LD8(p) (*reinterpret_cast<const bf16x8*>(p))
#define SLOAD(i, k0) do { sr_[i].vs0 = LD8(&Vh[(long)((k0) + sr) * LDK + sc]); sr_[i].vs1 = LD8(&Vh[(long)((k0) + 32 + sr) * LDK + sc]); \
    sr_[i].ks0 = LD8(&Kh[(long)((k0) + sr) * LDK + sc]); sr_[i].ks1 = LD8(&Kh[(long)((k0) + 32 + sr) * LDK + sc]); } while (0)
#define SWRITE(b, i) do { *(bf16x8*)((char*)V_lds + (b) * SHM_V + vst0) = sr_[i].vs0;          \
    *(bf16x8*)((char*)V_lds + (b) * SHM_V + vst1) = sr_[i].vs1; int kc = sc * 2;               \
    *(bf16x8*)((char*)K_lds + (b) * SHM_K + KSWZ(sr, kc)) = sr_[i].ks0;                       \
    *(bf16x8*)((char*)K_lds + (b) * SHM_K + KSWZ(32 + sr, kc)) = sr_[i].ks1; } while (0)
#define SWAIT() asm volatile("s_waitcnt vmcnt(4)" ::: "memory")
#define RESC(a) do { if (__any((a) < 1.f)) { if (hi == 0) al_l[r32] = (a); asm volatile("s_waitcnt lgkmcnt(0)" ::: "memory"); \
    _Pragma("unroll") for (int d = 0; d < 4; ++d) _Pragma("unroll") for (int r = 0; r < 16; ++r) o[d][r] *= al_l[crow(r, hi)]; } } while (0)
  f32x16 pA0, pA1, pB0, pB1; float mnA, mnB, alA, alB; bf16x8 pa0, pa1, pa2, pa3; const int NT = seq / KVBLK;
  constexpr int SE = 0, SO = 1;
  SLOAD(SE, 0); asm volatile("s_waitcnt vmcnt(0)" ::: "memory"); SWRITE(0, SE); __syncthreads();
  qkt(pA0, pA1, K_lds, qr, r32, hi, map); partialSM(pA0, pA1, m_reg, mnA, alA);
  SLOAD(SO, KVBLK); if (2 < NT) SLOAD(SE, 2 * KVBLK);
  SWAIT(); SWRITE(1, SO); __syncthreads();
  for (int j = 1; j + 1 < NT; j += 2) {
    SBAR(); qkt(pB0, pB1, (bf16*)((char*)K_lds + SHM_K), qr, r32, hi, map);
    finishSM(pA0, pA1, alA, l_reg, pa0, pa1, pa2, pa3); SBAR();
    SLOAD(SO, (j + 2) * KVBLK); SBAR();
    pv_d0(o, vb0, pa0, pa1, pa2, pa3); partialSM(pB0, pB1, m_reg, mnB, alB);
    __syncthreads(); SWAIT(); SWRITE(0, SE);
    RESC(alB); __syncthreads();
    SBAR(); qkt(pA0, pA1, K_lds, qr, r32, hi, map);
    finishSM(pB0, pB1, alB, l_reg, pa0, pa1, pa2, pa3); SBAR();
    if (j + 3 < NT) SLOAD(SE, (j + 3) * KVBLK); SBAR();
    pv_d0(o, vb0 + (int)SHM_V, pa0, pa1, pa2, pa3); partialSM(pA0, pA1, m_reg, mnA, alA);
    __syncthreads(); SWAIT(); SWRITE(1, SO);
    RESC(alA); __syncthreads();
  }
  SBAR(); qkt(pB0, pB1, (bf16*)((char*)K_lds + SHM_K), qr, r32, hi, map);
  finishSM(pA0, pA1, alA, l_reg, pa0, pa1, pa2, pa3); SBAR();
  pv_d0(o, vb0, pa0, pa1, pa2, pa3); partialSM(pB0, pB1, m_reg, mnB, alB);
  __syncthreads(); RESC(alB);
  finishSM(pB0, pB1, alB, l_reg, pa0, pa1, pa2, pa3); SBAR();
  pv_d0(o, vb0 + (int)SHM_V, pa0, pa1, pa2, pa3);
  if (hi == 0) li_l[r32] = l_reg; asm volatile("s_waitcnt lgkmcnt(0)" ::: "memory");
  float rli[16];
#pragma unroll
  for (int r = 0; r < 16; ++r) rli[r] = __builtin_amdgcn_rcpf(li_l[crow(r, hi)]);
  __syncthreads();
  int r32e = r32, hie = hi; asm volatile("" : "+v"(r32e), "+v"(hie));
  float* X = (float*)lds;
  if (map == 1) {
#pragma unroll
    for (int r = 0; r < 16; ++r)
#pragma unroll
      for (int d0 = 0; d0 < 4; ++d0) X[(qw * 32 + crow(r, hie)) * 128 + d0 * 32 + r32e] = o[d0][r] * rli[r];
  }
  __syncthreads();
  if (map == 0) {
    float sw[4];
#pragma unroll
    for (int d0 = 0; d0 < 4; ++d0) sw[d0] = subln[d0 * 32 + r32e] * 0.8f;
#pragma unroll
    for (int r = 0; r < 16; ++r) { float val[4]; float ss = 0.f;
#pragma unroll
      for (int d0 = 0; d0 < 4; ++d0) { val[d0] = o[d0][r] * rli[r] - lam * X[(qw * 32 + crow(r, hie)) * 128 + d0 * 32 + r32e]; ss += val[d0] * val[d0]; }
      ss += __shfl_xor(ss, 1); ss += __shfl_xor(ss, 2); ss += __shfl_xor(ss, 4); ss += __shfl_xor(ss, 8); ss += __shfl_xor(ss, 16);
      const float rs = rsqrtf(ss * (1.0f / 128.0f) + 1e-6f);
      unsigned short* orow = (unsigned short*)Ob + (long)(qw * 32 + crow(r, hie)) * LDO + r32e;
#pragma unroll
      for (int d0 = 0; d0 < 4; ++d0) orow[d0 * 32] = (unsigned short)(cvtpk(val[d0] * rs * sw[d0], 0.f) & 0xffffu); }
  }
  __syncthreads();
#undef LD8
#undef SLOAD
#undef SWRITE
#undef SWAIT
#undef RESC
}
#undef KSWZ
#undef SBAR
}

namespace gdn {
using bf16x8 = __attribute__((ext_vector_type(8))) short;
constexpr int TS = 272;
constexpr int OFF_Q = 0, OFF_K = 64 * TS, OFF_V = 2 * 64 * TS, OFF_KK = 3 * 64 * TS, OFF_QK = OFF_KK + 64 * 65 * 4, OFF_L = OFF_QK + 64 * 65 * 4, LSTR = 68,
              OFF_VEC = OFF_L + 2 * 64 * LSTR * 4;
static_assert(OFF_VEC + 6 * 64 * 4 <= 131072, "gdn lds");
__device__ __forceinline__ void seq_info(int s, int& rowbase, int& L) { if (s < 16) { rowbase = s * 256; L = 256; } else { rowbase = NPROMPT + (s - 16) * 1024; L = 1024; } }
__device__ __forceinline__ int chunk_id(int s, int h, int c) { return s < 16 ? ((s * 8 + h) * 4 + c) : 512 + (((s - 16) * 8 + h) * 16 + c); }

__device__ __forceinline__ void chunk_local(Frame& F, int s, int h, int c) {
    const bf16* QKVB = (const bf16*)(F.ws + WS_QKVB); const float* AB = (const float*)(F.ws + WS_AB);
    const float* conv_w = F.inp[11]; const float* a_log = F.inp[12]; const float* dt_bias = F.inp[13];
    bf16* QHAT = (bf16*)(F.ws + WS_QHAT); bf16* KHT = (bf16*)(F.ws + WS_KHT); bf16* NWg = (bf16*)(F.ws + WS_NW); bf16* Ug = (bf16*)(F.ws + WS_U); bf16* INTRA = (bf16*)(F.ws + WS_INTRA);
    float* EVEC = (float*)(F.ws + WS_EVEC);
    int rowbase, L; seq_info(s, rowbase, L); const int cid = chunk_id(s, h, c);
    int tid = F.tid, lane = F.lane; const int wid = F.wave; asm volatile("" : "+v"(tid), "+v"(lane));
    LAS unsigned char* lds = F.lds;
    LAS float* vec = (LAS float*)(lds + OFF_VEC);
    {
        const int tok0 = 8 * wid;
        unsigned raw[3][12];
        const bf16* rp = QKVB + ((long)(rowbase + c * 64 + tok0) - 2) * 3072 + h * 128 + 2 * lane;
#pragma unroll
        for (int j = 0; j < 12; ++j) { const int t = c * 64 + tok0 - 2 + j; const bool ok = (t >= 0) && (t < L);
#pragma unroll
            for (int x = 0; x < 3; ++x) raw[x][j] = ok ? *(const unsigned*)(rp + x * 1024) : 0u;
            rp += 3072; asm volatile("" : "+v"(rp)); }
        float cw[3][5][2];
#pragma unroll
        for (int x = 0; x < 3; ++x)
#pragma unroll
            for (int j = 0; j < 5; ++j) { const float* p = conv_w + j * 3072 + x * 1024 + h * 128 + 2 * lane; cw[x][j][0] = p[0]; cw[x][j][1] = p[1]; }
        unsigned kt[2][4];
#pragma unroll
        for (int tt = 0; tt < 8; ++tt) {
            float val[3][2];
#pragma unroll
            for (int x = 0; x < 3; ++x) { float a0 = 0.f, a1 = 0.f;
#pragma unroll
                for (int j = 0; j < 5; ++j) { a0 += cw[x][j][0] * bflo(raw[x][tt + j]); a1 += cw[x][j][1] * bfhi(raw[x][tt + j]); }
                val[x][0] = silu_f(a0); val[x][1] = silu_f(a1); }
            const float sq = wave_sum(val[0][0] * val[0][0] + val[0][1] * val[0][1]);
            const float sk = wave_sum(val[1][0] * val[1][0] + val[1][1] * val[1][1]);
            const float rq = rsqrtf(sq + EPS) * 0.08838834764831845f, rk = rsqrtf(sk + EPS);
            const unsigned qw_ = cvtpk(val[0][0] * rq, val[0][1] * rq), kw_ = cvtpk(val[1][0] * rk, val[1][1] * rk), vw_ = cvtpk(val[2][0], val[2][1]);
            const int tok = tok0 + tt;
            *(LAS unsigned*)(lds + OFF_Q + tok * TS + 4 * lane) = qw_;
            *(LAS unsigned*)(lds + OFF_K + tok * TS + 4 * lane) = kw_;
            *(LAS unsigned*)(lds + OFF_V + tok * TS + 4 * lane) = vw_;
            *(unsigned*)(QHAT + ((size_t)cid * 64 + tok) * 128 + 2 * lane) = qw_;
            if (tt & 1) { kt[0][tt >> 1] |= (kw_ << 16); kt[1][tt >> 1] |= (kw_ & 0xffff0000u); } else { kt[0][tt >> 1] = kw_ & 0xffffu; kt[1][tt >> 1] = kw_ >> 16; }
        }
#pragma unroll
        for (int e = 0; e < 2; ++e) { v4u w; w.x = kt[e][0]; w.y = kt[e][1]; w.z = kt[e][2]; w.w = kt[e][3];
            *(GAS v4u*)(KHT + ((size_t)cid * 128 + 2 * lane + e) * 64 + tok0) = w; }
    }
    if (wid < 2) {
        const int dir = wid, tok = lane; const size_t row = (size_t)rowbase + c * 64 + tok;
        const float a = AB[row * 32 + dir * 8 + h], b = AB[row * 32 + 16 + dir * 8 + h];
        const float xs = a + dt_bias[dir * 8 + h];
        const float sp = xs > 20.f ? xs : log1pf(__expf(xs));
        const float g = -__expf(a_log[dir * 8 + h]) * sp;
        const float beta = 1.0f / (1.0f + __expf(-b));
        float G = g;
        if (dir == 0) {
#pragma unroll
            for (int o = 1; o < 64; o <<= 1) { const float t = __shfl_up(G, o); if (lane >= o) G += t; }
        } else {
#pragma unroll
            for (int o = 1; o < 64; o <<= 1) { const float t = __shfl_down(G, o); if (lane + o < 64) G += t; }
        }
        const float gl = __shfl(G, dir == 0 ? 63 : 0);
        const float eG = __expf(G);
        vec[dir * 64 + tok] = beta; vec[128 + dir * 64 + tok] = G; vec[256 + dir * 64 + tok] = beta * eG;
        float* ev = EVEC + ((size_t)cid * 2 + dir) * 192;
        ev[tok] = eG; ev[64 + tok] = __expf(gl - G); if (lane == 0) ev[128] = __expf(gl);
    }
    __syncthreads();
    {
        const int r32 = lane & 31, hi = lane >> 5; const int mat = wid >> 2, bi = (wid >> 1) & 1, bj = wid & 1;
        const LAS unsigned char* ap = lds + (mat ? OFF_Q : OFF_K) + (32 * bi + r32) * TS + 16 * hi;
        const LAS unsigned char* bp = lds + OFF_K + (32 * bj + r32) * TS + 16 * hi;
        f32x16 acc = {};
#pragma unroll
        for (int st = 0; st < 8; ++st) { const bf16x8 a = *(const LAS bf16x8*)(ap + 32 * st), b = *(const LAS bf16x8*)(bp + 32 * st); acc = __builtin_amdgcn_mfma_f32_32x32x16_bf16(a, b, acc, 0, 0, 0); }
        LAS float* dst = (LAS float*)(lds + (mat ? OFF_QK : OFF_KK));
#pragma unroll
        for (int r = 0; r < 16; ++r) dst[(32 * bi + crow(r, hi)) * 65 + 32 * bj + r32] = acc[r];
    }
    __syncthreads();
    {
        const int dir = tid >> 8, i = (tid >> 2) & 63, j0 = (tid & 3) * 16;
        const LAS float* KKm = (const LAS float*)(lds + OFF_KK); const LAS float* QKm = (const LAS float*)(lds + OFF_QK);
        LAS float* Lm = (LAS float*)(lds + OFF_L) + dir * 64 * LSTR;
        const float bi_ = vec[dir * 64 + i], Gi = vec[128 + dir * 64 + i];
        unsigned iw[8];
#pragma unroll
        for (int jj = 0; jj < 16; ++jj) { const int j = j0 + jj; const float Gj = vec[128 + dir * 64 + j];
            const bool strict = dir ? (j > i) : (j < i); const bool incl = strict || (j == i);
            const float dec = incl ? __expf(Gi - Gj) : 0.f;
            const float lv = strict ? bi_ * KKm[i * 65 + j] * dec : 0.f;
            const float iv = QKm[i * 65 + j] * dec;
            if (dir) Lm[(63 - i) * LSTR + (63 - j)] = lv; else Lm[i * LSTR + j] = lv;
            const unsigned short bv = (unsigned short)(cvtpk(iv, 0.f) & 0xffffu);
            if (jj & 1) iw[jj >> 1] |= ((unsigned)bv << 16); else iw[jj >> 1] = bv; }
        bf16* ip = INTRA + (((size_t)cid * 2 + dir) * 64 + i) * 64 + j0;
        v4u w0, w1; w0.x = iw[0]; w0.y = iw[1]; w0.z = iw[2]; w0.w = iw[3]; w1.x = iw[4]; w1.y = iw[5]; w1.z = iw[6]; w1.w = iw[7];
        *(GAS v4u*)ip = w0; *(GAS v4u*)(ip + 8) = w1;
    }
    __syncthreads();
    {
        const int dir = wid >> 2, col = (wid & 3) * 64 + lane; const bool isK = col >= 128; const int cc = col & 127;
        const LAS float* Lm = (const LAS float*)(lds + OFF_L) + dir * 64 * LSTR;
        const LAS unsigned char* tile = lds + (isK ? OFF_K : OFF_V) + 2 * cc;
        const LAS float* scl = vec + (isK ? 256 : 0) + dir * 64;
        bf16* og = (isK ? NWg : Ug) + ((size_t)cid * 2 + dir) * 64 * 128 + cc;
        const float sgn = isK ? -1.f : 1.f;
        const LAS unsigned char* tp = tile + (dir ? 63 * TS : 0); const int tstep = dir ? -TS : TS;
        const LAS float* sp = scl + (dir ? 63 : 0); const int sstep = dir ? -1 : 1;
        bf16* gp = og + (dir ? 63 * 128 : 0); const int gstep = dir ? -128 : 128;
        float x[64];
#pragma unroll
        for (int p = 0; p < 64; ++p) {
            float a = bf2f(*(const LAS unsigned short*)tp) * (*sp);
#pragma unroll
            for (int q4 = 0; q4 * 4 < p; ++q4) { const f32x4 l = *(const LAS f32x4*)(Lm + p * LSTR + 4 * q4);
#pragma unroll
                for (int e = 0; e < 4; ++e) if (4 * q4 + e < p) a -= l[e] * x[4 * q4 + e]; }
            x[p] = a;
            *gp = (unsigned short)(cvtpk(a * sgn, 0.f) & 0xffffu);
            tp += tstep; sp += sstep; gp += gstep;
            asm volatile("" : "+v"(tp), "+v"(sp), "+v"(gp));
            __builtin_amdgcn_sched_barrier(0);
        }
    }
    __syncthreads();
}
}

namespace gscan {
using bf16x8 = __attribute__((ext_vector_type(8))) short;
constexpr int S128 = 264, S64 = 136;
constexpr int O_NW = 0, O_QH = 64 * S128, O_KHT = 2 * 64 * S128, O_IN = O_KHT + 128 * S64, O_EV = O_IN + 64 * S64, BUF = O_EV + 192 * 4;
static_assert(2 * BUF <= 131072 && (BUF % 8) == 0, "scan lds");
__device__ __forceinline__ bf16x8 afrag(const LAS unsigned char* p) { const u32x2 a = *(const LAS u32x2*)p, b = *(const LAS u32x2*)(p + 16); v4u w; w.x = a.x; w.y = a.y; w.z = b.x; w.w = b.y; return __builtin_bit_cast(bf16x8, w); }
__device__ __forceinline__ bf16x8 pack8(const f32x16& v, int s) { v4u w; w.x = cvtpk(v[8 * s + 0], v[8 * s + 1]); w.y = cvtpk(v[8 * s + 2], v[8 * s + 3]); w.z = cvtpk(v[8 * s + 4], v[8 * s + 5]); w.w = cvtpk(v[8 * s + 6], v[8 * s + 7]); return __builtin_bit_cast(bf16x8, w); }

__device__ __forceinline__ void stage_chunk(LAS unsigned char* lds, int lt_, int cid, int dir, int b, const bf16* NWg, const bf16* QHAT, const bf16* KHT, const bf16* INTRA, const float* EVEC) {
    int lt = lt_; asm volatile("" : "+v"(lt));
    const size_t cid2 = (size_t)cid * 2 + dir;
    LAS unsigned char* B = lds + b * BUF;
    v4u t0[4], t1[4], t2[4], t3[2];
#pragma unroll
    for (int i = 0; i < 4; ++i) { const int q = lt + 256 * i; t0[i] = *(const GAS v4u*)(NWg + cid2 * 8192 + (size_t)q * 8); t1[i] = *(const GAS v4u*)(QHAT + (size_t)cid * 8192 + (size_t)q * 8); t2[i] = *(const GAS v4u*)(KHT + (size_t)cid * 8192 + (size_t)q * 8); }
#pragma unroll
    for (int i = 0; i < 2; ++i) { const int q = lt + 256 * i; t3[i] = *(const GAS v4u*)(INTRA + cid2 * 4096 + (size_t)q * 8); }
    float ev = 0.f; if (lt < 192) ev = EVEC[cid2 * 192 + lt];
#pragma unroll
    for (int i = 0; i < 4; ++i) { const int q = lt + 256 * i; const int r128 = q >> 4, c128 = q & 15, r64 = q >> 3, c64 = q & 7;
        LAS unsigned char* d0 = B + O_NW + r128 * S128 + c128 * 16; *(LAS u32x2*)d0 = (u32x2){t0[i].x, t0[i].y}; *(LAS u32x2*)(d0 + 8) = (u32x2){t0[i].z, t0[i].w};
        LAS unsigned char* d1 = B + O_QH + r128 * S128 + c128 * 16; *(LAS u32x2*)d1 = (u32x2){t1[i].x, t1[i].y}; *(LAS u32x2*)(d1 + 8) = (u32x2){t1[i].z, t1[i].w};
        LAS unsigned char* d2 = B + O_KHT + r64 * S64 + c64 * 16;  *(LAS u32x2*)d2 = (u32x2){t2[i].x, t2[i].y}; *(LAS u32x2*)(d2 + 8) = (u32x2){t2[i].z, t2[i].w}; }
#pragma unroll
    for (int i = 0; i < 2; ++i) { const int q = lt + 256 * i; const int r64 = q >> 3, c64 = q & 7;
        LAS unsigned char* d3 = B + O_IN + r64 * S64 + c64 * 16; *(LAS u32x2*)d3 = (u32x2){t3[i].x, t3[i].y}; *(LAS u32x2*)(d3 + 8) = (u32x2){t3[i].z, t3[i].w}; }
    if (lt < 192) *(LAS float*)(B + O_EV + 4 * lt) = ev;
}

__device__ __forceinline__ void scan_item(Frame& F, int s, int h, int dir) {
    const bf16* QHAT = (const bf16*)(F.ws + WS_QHAT); const bf16* KHT = (const bf16*)(F.ws + WS_KHT); const bf16* NWg = (const bf16*)(F.ws + WS_NW); const bf16* Ug = (const bf16*)(F.ws + WS_U);
    const bf16* INTRA = (const bf16*)(F.ws + WS_INTRA); const float* EVEC = (const float*)(F.ws + WS_EVEC);
    bf16* OS = (bf16*)((unsigned char*)F.out + (dir ? YO_OB : YO_OF));
    int rowbase, L; gdn::seq_info(s, rowbase, L); const int n = L / 64;
    const int tid = F.tid, wid = F.wave, lane = F.lane; int r32_ = lane & 31, hi_ = lane >> 5; asm volatile("" : "+v"(r32_), "+v"(hi_));
    LAS unsigned char* lds = F.lds;
    const bool loader = wid >= 4;
    const int n0 = 32 * (wid & 3);
    f32x16 S[4];
    if (!loader) {
        if (s >= 16) { const float* sd = F.inp[4] + (((size_t)(s - 16) * 2 + dir) * 8 + h) * 16384;
#pragma unroll
            for (int mb = 0; mb < 4; ++mb)
#pragma unroll
                for (int r = 0; r < 16; ++r) S[mb][r] = sd[(32 * mb + crow(r, hi_)) * 128 + n0 + r32_];
        } else {
#pragma unroll
            for (int mb = 0; mb < 4; ++mb) S[mb] = f32x16{};
        }
    }
    if (loader) stage_chunk(lds, tid - 256, gdn::chunk_id(s, h, dir ? n - 1 : 0), dir, 0, NWg, QHAT, KHT, INTRA, EVEC);
    __syncthreads();
    for (int i = 0; i < n; ++i) {
        const int c = dir ? n - 1 - i : i; const int b = i & 1;
        if (loader) { if (i + 1 < n) stage_chunk(lds, tid - 256, gdn::chunk_id(s, h, dir ? n - 2 - i : i + 1), dir, b ^ 1, NWg, QHAT, KHT, INTRA, EVEC); }
        else {
            const LAS unsigned char* B = lds + b * BUF;
            int r32 = r32_, hi = hi_; asm volatile("" : "+v"(r32), "+v"(hi));
            const int cid = gdn::chunk_id(s, h, c); const size_t cid2 = (size_t)cid * 2 + dir;
            unsigned short uraw[2][16];
#pragma unroll
            for (int ib = 0; ib < 2; ++ib)
#pragma unroll
                for (int r = 0; r < 16; ++r) uraw[ib][r] = *(const unsigned short*)(Ug + cid2 * 8192 + (size_t)(32 * ib + crow(r, hi)) * 128 + n0 + r32);
            f32x16 vn[2] = {f32x16{}, f32x16{}}, qs[2] = {f32x16{}, f32x16{}};
#pragma unroll
            for (int mb = 0; mb < 4; ++mb)
#pragma unroll
                for (int st = 0; st < 2; ++st) { const bf16x8 sb = pack8(S[mb], st); const int koff = (32 * mb + 16 * st + 4 * hi) * 2;
#pragma unroll
                    for (int ib = 0; ib < 2; ++ib) {
                        vn[ib] = __builtin_amdgcn_mfma_f32_32x32x16_bf16(afrag(B + O_NW + (32 * ib + r32) * S128 + koff), sb, vn[ib], 0, 0, 0);
                        qs[ib] = __builtin_amdgcn_mfma_f32_32x32x16_bf16(afrag(B + O_QH + (32 * ib + r32) * S128 + koff), sb, qs[ib], 0, 0, 0); }
                    __builtin_amdgcn_sched_barrier(0); }
            const LAS float* ev = (const LAS float*)(B + O_EV);
#pragma unroll
            for (int ib = 0; ib < 2; ++ib)
#pragma unroll
                for (int r = 0; r < 16; ++r) { vn[ib][r] += bf2f(uraw[ib][r]); qs[ib][r] *= ev[32 * ib + crow(r, hi)]; }
#pragma unroll
            for (int jb = 0; jb < 2; ++jb)
#pragma unroll
                for (int st = 0; st < 2; ++st) { const bf16x8 vb = pack8(vn[jb], st); const int koff = (32 * jb + 16 * st + 4 * hi) * 2;
#pragma unroll
                    for (int ib = 0; ib < 2; ++ib) qs[ib] = __builtin_amdgcn_mfma_f32_32x32x16_bf16(afrag(B + O_IN + (32 * ib + r32) * S64 + koff), vb, qs[ib], 0, 0, 0);
                    __builtin_amdgcn_sched_barrier(0); }
            const float egl = ev[128];
#pragma unroll
            for (int mb = 0; mb < 4; ++mb) S[mb] *= egl;
#pragma unroll
            for (int jb = 0; jb < 2; ++jb) {
#pragma unroll
                for (int r = 0; r < 16; ++r) vn[jb][r] *= ev[64 + 32 * jb + crow(r, hi)];
#pragma unroll
                for (int st = 0; st < 2; ++st) { const bf16x8 vb = pack8(vn[jb], st); const int koff = (32 * jb + 16 * st + 4 * hi) * 2;
#pragma unroll
                    for (int mb = 0; mb < 4; ++mb) S[mb] = __builtin_amdgcn_mfma_f32_32x32x16_bf16(afrag(B + O_KHT + (32 * mb + r32) * S64 + koff), vb, S[mb], 0, 0, 0);
                    __builtin_amdgcn_sched_barrier(0); } }
            unsigned short* op = (unsigned short*)OS + (size_t)(rowbase + 64 * c) * 1024 + h * 128 + n0 + r32;
#pragma unroll
            for (int ib = 0; ib < 2; ++ib)
#pragma unroll
                for (int r = 0; r < 16; ++r) op[(size_t)(32 * ib + crow(r, hi)) * 1024] = (unsigned short)(cvtpk(qs[ib][r], 0.f) & 0xffffu);
        }
        __syncthreads();
    }
    if (!loader && s < 16) { float* so = F.out + OUT_S + (((size_t)s * 2 + dir) * 8 + h) * 16384;
#pragma unroll
        for (int mb = 0; mb < 4; ++mb)
#pragma unroll
            for (int r = 0; r < 16; ++r) so[(32 * mb + crow(r, hi_)) * 128 + n0 + r32_] = S[mb][r]; }
}
}

__device__ __forceinline__ void p3c_phase(Frame& F) {
    const bf16* OFw = (const bf16*)((unsigned char*)F.out + YO_OF); const bf16* OBw = (const bf16*)((unsigned char*)F.out + YO_OB); const bf16* GATE = (const bf16*)((unsigned char*)F.out + YO_GATE);
    bf16* MIX = (bf16*)(F.ws + WS_MIX); const float* dn = F.inp[14];
    const int gw = F.vcu * NWAVES + F.wave, NGW = F.G * NWAVES; const int c0 = 16 * F.lane;
    float nw[16];
#pragma unroll
    for (int e = 0; e < 16; ++e) nw[e] = dn[(c0 & 127) + e];
    for (int row = gw; row < MROWS; row += NGW) {
        float o[16], g[16]; float ss = 0.f;
#pragma unroll
        for (int q = 0; q < 2; ++q) { const v4u a = *(const GAS v4u*)(OFw + (size_t)row * 1024 + c0 + 8 * q), b = *(const GAS v4u*)(OBw + (size_t)row * 1024 + c0 + 8 * q), gg = *(const GAS v4u*)(GATE + (size_t)row * 1024 + c0 + 8 * q);
            const unsigned aw[4] = {a.x, a.y, a.z, a.w}, bw[4] = {b.x, b.y, b.z, b.w}, gw_[4] = {gg.x, gg.y, gg.z, gg.w};
#pragma unroll
            for (int e = 0; e < 4; ++e) { o[8 * q + 2 * e] = bflo(aw[e]) + bflo(bw[e]); o[8 * q + 2 * e + 1] = bfhi(aw[e]) + bfhi(bw[e]); g[8 * q + 2 * e] = bflo(gw_[e]); g[8 * q + 2 * e + 1] = bfhi(gw_[e]); } }
#pragma unroll
        for (int e = 0; e < 16; ++e) ss += o[e] * o[e];
        ss += __shfl_xor(ss, 1); ss += __shfl_xor(ss, 2); ss += __shfl_xor(ss, 4);
        const float rs = rsqrtf(ss * (1.0f / 128.0f) + EPS);
        v4u w0, w1; unsigned ww[8];
#pragma unroll
        for (int e = 0; e < 8; ++e) ww[e] = cvtpk(o[2 * e] * rs * nw[2 * e] * silu_f(g[2 * e]), o[2 * e + 1] * rs * nw[2 * e + 1] * silu_f(g[2 * e + 1]));
        w0.x = ww[0]; w0.y = ww[1]; w0.z = ww[2]; w0.w = ww[3]; w1.x = ww[4]; w1.y = ww[5]; w1.z = ww[6]; w1.w = ww[7];
        *(GAS v4u*)(MIX + (size_t)row * 2048 + 1024 + c0) = w0; *(GAS v4u*)(MIX + (size_t)row * 2048 + 1024 + c0 + 8) = w1;
    }
}
__device__ __forceinline__ void p7_phase(Frame& F) {
    const float* PART2 = (const float*)(F.ws + WS_PART2); const float* nf = F.inp[21]; float* y = F.out;
    const int gw = F.vcu * NWAVES + F.wave, NGW = F.G * NWAVES;
    for (int row = gw; row < MROWS; row += NGW) {
        float p = (F.lane < 32) ? PART2[(size_t)row * 32 + F.lane] : 0.f;
        const float rs = rsqrtf(wave_sum(p) * (1.0f / DM) + EPS);
#pragma unroll
        for (int j = 0; j < 8; ++j) { const int k = 4 * (F.lane + 64 * j); f32x4 v = *(const f32x4*)(y + (size_t)row * DM + k); const f32x4 g = *(const f32x4*)(nf + k); v = v * rs * g; *(f32x4*)(y + (size_t)row * DM + k) = v; }
    }
}

constexpr int N_PHASES = 10;
#ifndef MK_N_LAUNCHES
#define MK_N_LAUNCHES 10
#endif
constexpr int N_LAUNCHES = MK_N_LAUNCHES;
struct Args { const float* in[22]; float* out; unsigned char* ws; int ph_lo, ph_hi, li, pad; };
__global__ void __launch_bounds__(NWAVES * 64, 2) mega_fwd(Args args) {
    extern __shared__ __attribute__((aligned(16))) unsigned char lds[];
    Frame F;
    F.lds = (LAS unsigned char*)lds; F.ldsg = lds;
    F.MISC = (volatile LAS unsigned*)(F.lds + MISC_OFF);
    F.tid = threadIdx.x; F.lane = F.tid & 63; F.wave = __builtin_amdgcn_readfirstlane(F.tid >> 6);
    F.G = gridDim.x; { const int bx = blockIdx.x; F.vcu = (F.G % 8 == 0) ? (bx % 8) * (F.G / 8) + bx / 8 : bx; }
    F.ws = args.ws; F.out = args.out; F.ctl = (gu32*)(args.ws + WS_CTL);
    F.inp = args.in;
    for (int u = F.tid; u < (LDS_BYTES - LDSCTL_OFF) / 4; u += NWAVES * 64) ((LAS unsigned*)(F.lds + LDSCTL_OFF))[u] = 0u;
    __syncthreads();
    const int lo = args.ph_lo, hi = args.ph_hi;
    const bool use_bar = (hi - lo) > 1;
    XcdBarrier bar; bar.bar = (unsigned*)(F.ctl + CW_BAR); bar.x = 0; bar.st = nullptr;
    if (use_bar) bar = xcd_barrier_post((unsigned*)(F.ctl + CW_BAR), F.MISC + 8);
#define IN(k) (lo <= (k) && (k) < hi)
#define SEAM(k) do { if (IN(k) && IN((k) + 1)) xcd_barrier(bar); } while (0)
    if (IN(0)) { p0_phase(F); SEAM(0); }
    if (IN(1)) { p1_phase(F); SEAM(1); }
    if (IN(2)) {
        p2_ab(F);
        pg8::Gemm g{(const pg8::bf16_t*)(F.ws + WS_XN), (const pg8::bf16_t*)(F.ws + WS_WIN), MROWS, 7168, DM}; pg8::StaticOrder S; S.init(MROWS, 7168, F.G, (int)blockIdx.x);
        unsigned char* yb = (unsigned char*)F.out;
        pg8::EpiInProj E{(pg8::bf16_t*)(yb + YO_QA), (pg8::bf16_t*)(yb + YO_KP), (pg8::bf16_t*)(yb + YO_VP), (pg8::bf16_t*)(F.ws + WS_KS), (pg8::bf16_t*)(F.ws + WS_VS),
                         (pg8::bf16_t*)(F.ws + WS_QKVB), (pg8::bf16_t*)(yb + YO_GATE), F.out + OUT_K, F.out + OUT_V, (const float*)(F.ws + WS_ROPE)};
        pg8::gemm_phase<pg8::EpiInProj, pg8::StaticOrder, true, true>(F.lds + RING_OFF, g, S, E);
        SEAM(2);
    }
    if (IN(3)) {
        for (int it = F.vcu; it < 1536; it += F.G) {
            int s, h, c; if (it < 512) { s = it >> 5; h = (it >> 2) & 7; c = it & 3; } else { const int j = it - 512; s = 16 + (j >> 7); h = (j >> 4) & 7; c = j & 15; }
            gdn::chunk_local(F, s, h, c);
        }
        const float* lp = F.inp[15];
        const float lam = __expf(wave_sum(lp[F.lane] * lp[64 + F.lane])) - __expf(wave_sum(lp[128 + F.lane] * lp[192 + F.lane])) + 0.2f;
        const bf16* QA = (const bf16*)((unsigned char*)F.out + YO_QA); bf16* MIX = (bf16*)(F.ws + WS_MIX);
        for (int u = F.vcu; u < 768; u += F.G) {
            const bf16 *Qp, *Kp, *Vp; bf16* Op; int nk;
            if (u < 256) { const int qb = u & 1, bh = u >> 1, b = bh >> 3, h = bh & 7; const size_t r0 = (size_t)(b * 256 + qb * 128);
                Qp = QA + r0 * 1024 + h * 128; Kp = (const bf16*)((unsigned char*)F.out + YO_KP) + (size_t)bh * 256 * 128; Vp = (const bf16*)((unsigned char*)F.out + YO_VP) + (size_t)bh * 256 * 128; Op = MIX + r0 * 2048 + h * 128; nk = 256;
            } else { const int su = (u < 512) ? 2 * (u - 256) : 2 * (u - 512) + 1; const int qb = su & 7, bh = su >> 3, b = bh >> 3, h = bh & 7; const size_t r0 = (size_t)(NPROMPT + b * 1024 + qb * 128);
                Qp = QA + r0 * 1024 + h * 128; Kp = (const bf16*)(F.ws + WS_KS) + (size_t)bh * 1536 * 128; Vp = (const bf16*)(F.ws + WS_VS) + (size_t)bh * 1536 * 128; Op = MIX + r0 * 2048 + h * 128; nk = 1536; }
            dattn::attn_unit(Qp, Kp, Vp, Op, nk, lam, F.inp[16], (char*)lds);
        }
        SEAM(3);
    }
    if (IN(4)) {
        for (int k = 0; k < 2; ++k) {
            int s_, h_, d_;
            if (F.vcu < 128) { if (k) break; s_ = 16 + (F.vcu >> 4); h_ = (F.vcu >> 1) & 7; d_ = F.vcu & 1; }
            else { const int p = 2 * (F.vcu - 128) + k; if (p >= 256) break; s_ = p >> 4; h_ = (p >> 1) & 7; d_ = p & 1; }
            gscan::scan_item(F, s_, h_, d_);
        }
        SEAM(4);
    }
    if (IN(5)) { p3c_phase(F); SEAM(5); }
    if (IN(6)) {
        pg8::Gemm g{(const pg8::bf16_t*)(F.ws + WS_MIX), (const pg8::bf16_t*)(F.ws + WS_WOUT), MROWS, DM, DM}; pg8::StaticOrder S; S.init(MROWS, DM, F.G, (int)blockIdx.x);
        pg8::EpiOutProj E{F.inp[0], F.inp[1], (const float*)(F.ws + WS_MOD), F.inp[18], F.out, (pg8::bf16_t*)(F.ws + WS_HW), (float*)(F.ws + WS_PART)};
        pg8::gemm_phase<pg8::EpiOutProj, pg8::StaticOrder, true, true>(F.lds + RING_OFF, g, S, E);
        SEAM(6);
    }
    if (IN(7)) {
        pg8::Gemm g{(const pg8::bf16_t*)(F.ws + WS_HW), (const pg8::bf16_t*)(F.ws + WS_WFF1), MROWS, DFF, DM}; pg8::StaticOrder S; S.init(MROWS, DFF, F.G, (int)blockIdx.x);
        LAS float* rt = (LAS float*)(F.lds + RSTD_OFF); const float* PART = (const float*)(F.ws + WS_PART);
        for (int i = 0; i < 6; ++i) { pg8::Unit u; if (!S.next(i, u)) break;
            if (F.tid < 256) { const float* p = PART + ((size_t)u.pm * 256 + F.tid) * 32; float s = 0.f;
#pragma unroll
                for (int q = 0; q < 8; ++q) { const f32x4 v = *(const f32x4*)(p + 4 * q); s += (v[0] + v[1]) + (v[2] + v[3]); }
                rt[i * 256 + F.tid] = rsqrtf(s * (1.0f / DM) + EPS); } }
        __syncthreads();
        pg8::EpiFF1 E{(const float*)(F.ws + WS_C2), (pg8::bf16_t*)(F.ws + WS_FF), (const LAS float*)rt};
        pg8::gemm_phase<pg8::EpiFF1, pg8::StaticOrder, true, true>(F.lds + RING_OFF, g, S, E);
        SEAM(7);
    }
    if (IN(8)) {
        pg8::Gemm g{(const pg8::bf16_t*)(F.ws + WS_FF), (const pg8::bf16_t*)(F.ws + WS_WFF2), MROWS, DM, DFF}; pg8::StaticOrder S; S.init(MROWS, DM, F.G, (int)blockIdx.x);
        pg8::EpiFF2 E{(const float*)(F.ws + WS_MOD), F.out, (float*)(F.ws + WS_PART2)};
        pg8::gemm_phase<pg8::EpiFF2, pg8::StaticOrder, true, true>(F.lds + RING_OFF, g, S, E);
        SEAM(8);
    }
    if (IN(9)) { p7_phase(F); }
#undef IN
#undef SEAM
}

extern "C" void kernel_launch(void* const* d_in, const int* in_sizes, int n_in, void* d_out, int out_size, void* d_ws, size_t ws_size, hipStream_t stream) {
    static int grid = 0;
    if (grid == 0) {
        if (n_in != 22 || out_size != 37748736 || ws_size < WS_END) { fprintf(stderr, "kernel_launch: unexpected shapes: n_in %d out %d ws %zu (need %zu)\n", n_in, out_size, ws_size, (size_t)WS_END); grid = -1; return; }
        if (hipFuncSetAttribute((const void*)mega_fwd, hipFuncAttributeMaxDynamicSharedMemorySize, LDS_BYTES) != hipSuccess) { fprintf(stderr, "kernel_launch: hipFuncSetAttribute failed\n"); grid = -1; return; }
        int per_cu = 0; (void)hipOccupancyMaxActiveBlocksPerMultiprocessor(&per_cu, (const void*)mega_fwd, NWAVES * 64, LDS_BYTES); (void)hipGetLastError();
        if (per_cu < 1) fprintf(stderr, "kernel_launch: occupancy query reports %d blocks per CU\n", per_cu);
        grid = 256;
    }
    if (grid < 0) return;
    if (hipMemsetAsync((char*)d_ws + WS_CTL, 0, CTL_ZERO_BYTES, stream) != hipSuccess) { fprintf(stderr, "kernel_launch: memset failed\n"); return; }
    Args a{};
    for (int i = 0; i < 22; ++i) a.in[i] = (const float*)d_in[i];
    a.out = (float*)d_out; a.ws = (unsigned char*)d_ws;
    if (N_LAUNCHES == 1) { a.ph_lo = 0; a.ph_hi = N_PHASES; a.li = 0; hipLaunchKernelGGL(mega_fwd, dim3(grid), dim3(NWAVES * 64), LDS_BYTES, stream, a); }
    else { for (int li = 0; li < N_PHASES; ++li) { a.ph_lo = li; a.ph_hi = li + 1; a.li = li; hipLaunchKernelGGL(mega_fwd, dim3(grid), dim3(NWAVES * 64), LDS_BYTES, stream, a); } }
    const hipError_t le = hipPeekAtLastError();
    if (le != hipSuccess) fprintf(stderr, "kernel_launch: launch failed: %s\n", hipGetErrorName(le));
}
```

```cpp
#include <hip/hip_runtime.h>
#include <hip/hip_bf16.h>
#include <cstdio>
#include <cstdint>
#include <cmath>

namespace pg8 {
#define PG8_LAS __attribute__((address_space(3)))
typedef unsigned short bf16_t;
typedef short bf16x8 __attribute__((ext_vector_type(8)));
typedef float f32x4 __attribute__((ext_vector_type(4)));
typedef unsigned u32x4 __attribute__((ext_vector_type(4)));
constexpr int BM = 256, BK = 64, HALF = 128, HTB = HALF * BK * 2  , STAGE_BYTES = 8 * HTB, NXCD = 8, WGM = 8;

__host__ __device__ __forceinline__ int lds_byte(int r, int c) { const int st = (r >> 4) * 2 + (c >> 5), rr = r & 15, cc = c & 31, ob = rr * 64 + cc * 2; return st * 1024 + (ob ^ (((ob >> 9) & 1) << 5)); }
__host__ __device__ __forceinline__ int blk_byte(int r, int c) { return ((r >> 4) * 2 + (c >> 5)) * 1024 + (r & 15) * 64 + (c & 31) * 2; }
__host__ __device__ __forceinline__ void stage_rc(int b, int& R, int& C) { const int st = b / 1024, sb = b % 1024, swz = sb ^ (((sb >> 9) & 1) << 5); R = (st >> 1) * 16 + swz / 64; C = (st & 1) * 32 + (swz % 64) / 2; }
__host__ __device__ __forceinline__ int perm32inv(int v) { return 16 * ((v >> 2) & 1) + 4 * (v >> 3) + (v & 3); }
__host__ __device__ __forceinline__ int perm32(int rho) { const int n = rho >> 4, i = rho & 15; return 8 * (i >> 2) + 4 * n + (i & 3); }

struct Unit { int pm, pn, k0, nt, mode, slot, npart; };
struct Gemm { const bf16_t* A; const bf16_t* Bt; int M, N, K; int atiled; };

struct StaticOrder {
    int nM, nN, nwg, G, c, ntk;
    __host__ __device__ __forceinline__ void init(int M, int N, int K, int G_, int c_) { nM = M / BM; nN = N / BM; nwg = nM * nN; G = G_; c = c_; ntk = K / BK; }
    __host__ __device__ __forceinline__ bool next(int i, Unit& u) const {
        const long L = (long)i * G + c; if (L >= nwg) return false;
        int wgid = (int)L; { const int q = nwg / NXCD, r = nwg % NXCD, xcd = wgid % NXCD, off = wgid / NXCD; wgid = (xcd < r ? xcd * (q + 1) : r * (q + 1) + (xcd - r) * q) + off; }
        const int nig = WGM * nN, gid = wgid / nig, fm = gid * WGM, gsz = (nM - fm) < WGM ? (nM - fm) : WGM;
        u.pm = fm + ((wgid % nig) % gsz); u.pn = (wgid % nig) / gsz; u.k0 = 0; u.nt = ntk; u.mode = 0; u.slot = 0; u.npart = 0; return true;
    }
    __device__ __forceinline__ void a_ready(const Unit&) const {}
    __device__ __forceinline__ void done(const Unit&) const {}
};


typedef float cvt_f32x2 __attribute__((ext_vector_type(2))); typedef __bf16 cvt_bf16x2 __attribute__((ext_vector_type(2)));
__device__ __forceinline__ unsigned cvt_pk_bf16(float lo, float hi) { cvt_f32x2 v = {lo, hi}; cvt_bf16x2 b = __builtin_convertvector(v, cvt_bf16x2); return __builtin_bit_cast(unsigned, b); }

struct PairOrder {
    int c, ntk, G, ntp;
    __host__ __device__ __forceinline__ void init(int M, int N, int K, int G_, int c_, int ntp_) { c = c_; ntk = K / BK; G = G_; ntp = ntp_; }
    __host__ __device__ __forceinline__ bool next(int i, Unit& u) const {
        if (i >= 2 || G != 256) return false;
        const int x = c & 7, lc = c >> 3, jp = lc >> 1, j = x * 16 + jp, role = lc & 1;
        int T, k0 = 0, nt = ntk, mode = 0;
        if (role == 0) { if (i == 0) { T = 48 * x + 32 + jp; nt = ntp; mode = 1; } else T = 48 * x + 16 + jp; }
        else           { if (i == 0) T = 48 * x + jp; else { T = 48 * x + 32 + jp; k0 = ntp; nt = ntk - ntp; mode = 2; } }
        u.pm = T >> 3; u.pn = T & 7; u.k0 = k0; u.nt = nt; u.mode = mode; u.slot = j; u.npart = 1; return true;
    }
    __device__ __forceinline__ void a_ready(const Unit&) const {}
    __device__ __forceinline__ void done(const Unit&) const {}
};

struct QuadOrder {
    StaticOrder base; int c, ntk;
    __host__ __device__ __forceinline__ void init(int M, int N, int K, int G_, int c_) { base.init(M, N, K, G_, c_); c = c_; ntk = K / BK; }
    __host__ __device__ __forceinline__ bool next(int i, Unit& u) const {
        if (base.G != 256 || base.nwg != 1344) return base.next(i, u);
        const int role = c >> 6, t = c & 63, q = (ntk == 32) ? 10 : ntk / 4;
        if (i > 5) return false;
        const bool split = (role < 3) ? (i == 0) : (i == 5);
        if (!split) return base.next(role < 3 ? i - 1 : i, u);
        StaticOrder b2 = base; b2.c = t; b2.next(5, u);
        u.k0 = role * q; u.nt = (role < 3) ? q : ntk - 3 * q; u.mode = (role < 3) ? 1 : 2; u.slot = (role < 3) ? t * 3 + role : t * 3; u.npart = 3; return true;
    }
    __device__ __forceinline__ void a_ready(const Unit&) const {}
    __device__ __forceinline__ void done(const Unit&) const {}
};

typedef float f32x2 __attribute__((ext_vector_type(2)));
typedef unsigned u32x2 __attribute__((ext_vector_type(2)));
__device__ __forceinline__ u32x2 pack4(const f32x4 v) { u32x2 w; w.x = cvt_pk_bf16(v[0], v[1]); w.y = cvt_pk_bf16(v[2], v[3]); return w; }
struct EpiInProj {
    static constexpr bool PERM = true, AFTER_DRAIN = false;
    bf16_t *QA, *KP, *VP, *KS, *VS, *QKVB, *GATE; float *outK, *outV; const float* rope;
    __device__ __forceinline__ void operator()(const f32x4 (&acc)[2][2][4][2], const Unit& u, int ui, int wr, int wc, int fr_, int fq_) const {
        int fr = fr_, fq = fq_; asm volatile("" : "+v"(fr), "+v"(fq));
        const int pm = u.pm, pn = u.pn; const bool sample = pm >= 16;
        const int tq = (pm - 16) & 3, bs = (pm - 16) >> 2;
        if (pn >= 12) {
            const bool blocked = pn < 24; const int blk0 = pm * 48 + (pn - 12) * 4;
#pragma unroll
            for (int ai = 0; ai < 2; ++ai)
#pragma unroll
                for (int m = 0; m < 4; ++m) { const int ib = blk_byte(wr * 64 + m * 16 + fr, (wc & 1) * 32 + 8 * fq) >> 1; const size_t row = (size_t)pm * 256 + ai * 128 + wr * 64 + m * 16 + fr;
#pragma unroll
                    for (int bj = 0; bj < 2; ++bj) { const u32x2 lo = pack4(acc[ai][bj][m][0]), hi = pack4(acc[ai][bj][m][1]); u32x4 w; w.x = lo.x; w.y = lo.y; w.z = hi.x; w.w = hi.y;
                        bf16_t* dp = blocked ? QKVB + (size_t)(blk0 + bj * 2 + (wc >> 1)) * 16384 + ai * 8192 + ib : GATE + row * 1024 + (pn - 24) * 256 + bj * 128 + wc * 32 + 8 * fq;
                        *(u32x4*)dp = w; } }
        } else if (pn >= 8) {
#pragma unroll
            for (int bj = 0; bj < 2; ++bj) { const int h = 2 * (pn - 8) + bj;
#pragma unroll
                for (int ai = 0; ai < 2; ++ai)
#pragma unroll
                    for (int m = 0; m < 4; ++m) { const int tl = ai * 128 + wr * 64 + m * 16 + fr; const int d = wc * 32 + 8 * fq;
                        const f32x4 v0 = acc[ai][bj][m][0], v1 = acc[ai][bj][m][1];
                        const u32x2 lo = pack4(v0), hi = pack4(v1); u32x4 w; w.x = lo.x; w.y = lo.y; w.z = hi.x; w.w = hi.y;
                        if (!sample) { const size_t idx = ((size_t)(pm * 8 + h) * 256 + tl) * 128 + d; *(f32x4*)(outV + idx) = v0; *(f32x4*)(outV + idx + 4) = v1; *(u32x4*)(VP + idx) = w; }
                        else { const size_t idx = ((size_t)(bs * 8 + h) * 1536 + 512 + tq * 256 + tl) * 128 + d; *(u32x4*)(VS + idx) = w; } } }
        } else {
            const bool isK = pn >= 4; const bool colrot = (wc & 1) != 0; const bool upper = fq >= 2;
            const int i0 = 8 * (fq & 1);
            const float sgn = upper ? 1.f : -1.f;
#pragma unroll
            for (int ai = 0; ai < 2; ++ai) {
                f32x4 cr0 = {1.f, 1.f, 1.f, 1.f}, cr1 = cr0, sr0 = {0.f, 0.f, 0.f, 0.f}, sr1 = sr0;
                if (sample && !colrot) { const int pos = tq * 4 + ai * 2 + wr; cr0 = *(const f32x4*)(rope + pos * 16 + i0); cr1 = *(const f32x4*)(rope + pos * 16 + i0 + 4); sr0 = *(const f32x4*)(rope + 1024 + pos * 16 + i0); sr1 = *(const f32x4*)(rope + 1024 + pos * 16 + i0 + 4); }
#pragma unroll
                for (int m = 0; m < 4; ++m) { const int tl = ai * 128 + wr * 64 + m * 16 + fr;
                    f32x4 c0v = cr0, c1v = cr1, s0v = sr0, s1v = sr1;
                    if (sample && colrot) { const int pos = m * 16 + fr; c0v = *(const f32x4*)(rope + pos * 16 + i0); c1v = *(const f32x4*)(rope + pos * 16 + i0 + 4); s0v = *(const f32x4*)(rope + 1024 + pos * 16 + i0); s1v = *(const f32x4*)(rope + 1024 + pos * 16 + i0 + 4); }
#pragma unroll
                    for (int bj = 0; bj < 2; ++bj) { f32x4 o0 = acc[ai][bj][m][0], o1 = acc[ai][bj][m][1];
                        if (sample) {
                            f32x4 p0, p1;
#pragma unroll
                            for (int e = 0; e < 4; ++e) { p0[e] = __shfl_xor(o0[e], 32); p1[e] = __shfl_xor(o1[e], 32); }
                            o0 = o0 * c0v + p0 * s0v * sgn; o1 = o1 * c1v + p1 * s1v * sgn; }
                        const int d = wc * 32 + 8 * fq;
                        const u32x2 lo = pack4(o0), hi = pack4(o1); u32x4 w; w.x = lo.x; w.y = lo.y; w.z = hi.x; w.w = hi.y;
                        if (!isK) { *(u32x4*)(QA + ((size_t)pm * 256 + tl) * 1024 + pn * 256 + bj * 128 + d) = w; }
                        else { const int h = 2 * (pn - 4) + bj;
                            if (!sample) { const size_t idx = ((size_t)(pm * 8 + h) * 256 + tl) * 128 + d; *(f32x4*)(outK + idx) = o0; *(f32x4*)(outK + idx + 4) = o1; *(u32x4*)(KP + idx) = w; }
                            else { const size_t idx = ((size_t)(bs * 8 + h) * 1536 + 512 + tq * 256 + tl) * 128 + d; *(u32x4*)(KS + idx) = w; } } } } }
        }
    }
};
struct EpiOutProj {
    static constexpr bool PERM = true, AFTER_DRAIN = false;
    const float *xp, *xs, *mod, *norm2; bf16_t* HB; bf16_t* HW; float* PART;
    __device__ __forceinline__ void operator()(const f32x4 (&acc)[2][2][4][2], const Unit& u, int ui, int wr, int wc, int fr_, int fq_) const {
        int fr = fr_, fq = fq_; asm volatile("" : "+v"(fr), "+v"(fq));
        const int pm = u.pm, pn = u.pn; const int mb = pm < 16 ? 0 : 1 + ((pm - 16) >> 2);
        const float* xb = pm < 16 ? xp + (size_t)pm * 256 * 2048 : xs + (size_t)(pm - 16) * 256 * 2048;
        const float* g1 = mod + mb * 12288 + 2 * 2048; const float* sc2 = mod + mb * 12288 + 4 * 2048;
        bf16_t* hbt = HB + (size_t)(pm * 8 + pn) * 65536 + (((wr * 4 + wc) * 4 + fq) * 16 + fr) * 8;
        f32x4 g1v[2][2], w2v[2][2];
#pragma unroll
        for (int bj = 0; bj < 2; ++bj)
#pragma unroll
            for (int n = 0; n < 2; ++n) { const int col = pn * 256 + bj * 128 + wc * 32 + 8 * fq + 4 * n; g1v[bj][n] = *(const f32x4*)(g1 + col);
                const f32x4 a = *(const f32x4*)(norm2 + col), b = *(const f32x4*)(sc2 + col); w2v[bj][n] = a * (b + 1.0f); }
#pragma unroll
        for (int am = 0; am < 4; ++am) { const int ai = am >> 1, m0 = (am & 1) * 2;
            f32x4 xin[2][2][2];
#pragma unroll
            for (int mm = 0; mm < 2; ++mm)
#pragma unroll
                for (int bj = 0; bj < 2; ++bj)
#pragma unroll
                    for (int n = 0; n < 2; ++n) xin[mm][bj][n] = __builtin_nontemporal_load((const f32x4*)(xb + (size_t)(ai * 128 + wr * 64 + (m0 + mm) * 16 + fr) * 2048 + pn * 256 + bj * 128 + wc * 32 + 8 * fq + 4 * n));
#pragma unroll
            for (int mm = 0; mm < 2; ++mm) { const int m = m0 + mm; const int rl = ai * 128 + wr * 64 + m * 16 + fr; const size_t row = (size_t)pm * 256 + rl; float s = 0.f;
#pragma unroll
                for (int bj = 0; bj < 2; ++bj) { const int col = pn * 256 + bj * 128 + wc * 32 + 8 * fq;
                    const f32x4 h0 = xin[mm][bj][0] + g1v[bj][0] * acc[ai][bj][m][0], h1 = xin[mm][bj][1] + g1v[bj][1] * acc[ai][bj][m][1];
                    s += (h0[0] * h0[0] + h0[1] * h0[1]) + (h0[2] * h0[2] + h0[3] * h0[3]) + (h1[0] * h1[0] + h1[1] * h1[1]) + (h1[2] * h1[2] + h1[3] * h1[3]);
                    { const u32x2 lo = pack4(h0), hi = pack4(h1); u32x4 w; w.x = lo.x; w.y = lo.y; w.z = hi.x; w.w = hi.y; *(u32x4*)(hbt + ((ai * 2 + bj) * 4 + m) * 4096) = w; }
                    { const u32x2 lo = pack4(h0 * w2v[bj][0]), hi = pack4(h1 * w2v[bj][1]); u32x4 w; w.x = lo.x; w.y = lo.y; w.z = hi.x; w.w = hi.y; *(u32x4*)(HW + (size_t)(pm * 32 + pn * 4 + bj * 2 + (wc >> 1)) * 16384 + ai * 8192 + (lds_byte(wr * 64 + m * 16 + fr, (wc & 1) * 32 + 8 * fq) >> 1)) = w; } }
                s += __shfl_xor(s, 16); s += __shfl_xor(s, 32);
                if (fq == 0) PART[row * 32 + pn * 4 + wc] = s; }
            asm volatile("" ::: "memory"); }
    }
};
struct EpiFF1 {
    static constexpr bool PERM = true, AFTER_DRAIN = false;
    const float* c2; bf16_t* FF; const PG8_LAS float* rstd;
    __device__ __forceinline__ void operator()(const f32x4 (&acc)[2][2][4][2], const Unit& u, int ui, int wr, int wc, int fr_, int fq_) const {
        int fr = fr_, fq = fq_; asm volatile("" : "+v"(fr), "+v"(fq));
        const int pm = u.pm, pn = u.pn; const int mb = pm < 16 ? 0 : 1 + ((pm - 16) >> 2);
        f32x4 cv[2][2];
#pragma unroll
        for (int bj = 0; bj < 2; ++bj)
#pragma unroll
            for (int n = 0; n < 2; ++n) cv[bj][n] = *(const f32x4*)(c2 + mb * 8192 + pn * 256 + bj * 128 + wc * 32 + 8 * fq + 4 * n);
#pragma unroll
        for (int ai = 0; ai < 2; ++ai)
#pragma unroll
            for (int m = 0; m < 4; ++m) { const int rl = ai * 128 + wr * 64 + m * 16 + fr; const float r = rstd[ui * 256 + rl];
                bf16_t* rowp = FF + (size_t)(pm * 128 + pn * 4 + (wc >> 1)) * 16384 + ai * 8192 + (lds_byte(wr * 64 + m * 16 + fr, (wc & 1) * 32 + 8 * fq) >> 1);
#pragma unroll
                for (int bj = 0; bj < 2; ++bj) { f32x4 v0 = acc[ai][bj][m][0] * r + cv[bj][0], v1 = acc[ai][bj][m][1] * r + cv[bj][1];
#pragma unroll
                    for (int e = 0; e < 4; ++e) { const float a = fmaxf(v0[e], 0.f), b = fmaxf(v1[e], 0.f); v0[e] = a * a; v1[e] = b * b; }
                    u32x4 w; w.x = cvt_pk_bf16(v0[0], v0[1]); w.y = cvt_pk_bf16(v0[2], v0[3]); w.z = cvt_pk_bf16(v1[0], v1[1]); w.w = cvt_pk_bf16(v1[2], v1[3]);
                    *(u32x4*)(rowp + bj * 2 * 16384) = w; } }
    }
};
struct EpiFF2 {
    static constexpr bool PERM = true, AFTER_DRAIN = false;
    const float* mod; const bf16_t* HB; float* out; float* PART; const float* nf; unsigned* cnt;
    __device__ __forceinline__ void operator()(const f32x4 (&acc)[2][2][4][2], const Unit& u, int ui, int wr, int wc, int fr_, int fq_) const {
        int fr = fr_, fq = fq_; asm volatile("" : "+v"(fr), "+v"(fq));
        const int pm = u.pm, pn = u.pn; const int mb = pm < 16 ? 0 : 1 + ((pm - 16) >> 2);
        const __amdgpu_buffer_rsrc_t pr = __builtin_amdgcn_make_buffer_rsrc(PART, 0, 0x7fffffff, 0x00020000);
        const float* g2 = mod + mb * 12288 + 5 * 2048;
        f32x4 gv[2][2];
#pragma unroll
        for (int bj = 0; bj < 2; ++bj)
#pragma unroll
            for (int n = 0; n < 2; ++n) gv[bj][n] = *(const f32x4*)(g2 + pn * 256 + bj * 128 + wc * 32 + 8 * fq + 4 * n);
#define FF2_H(hw_) const f32x4 h0 = {__builtin_bit_cast(float, hw_.x << 16), __builtin_bit_cast(float, hw_.x & 0xffff0000u), __builtin_bit_cast(float, hw_.y << 16), __builtin_bit_cast(float, hw_.y & 0xffff0000u)}; \
                   const f32x4 h1 = {__builtin_bit_cast(float, hw_.z << 16), __builtin_bit_cast(float, hw_.z & 0xffff0000u), __builtin_bit_cast(float, hw_.w << 16), __builtin_bit_cast(float, hw_.w & 0xffff0000u)}
#pragma unroll
        for (int ai = 0; ai < 2; ++ai) {
            u32x4 hin[4][2];
#pragma unroll
            for (int m = 0; m < 4; ++m)
#pragma unroll
                for (int bj = 0; bj < 2; ++bj) hin[m][bj] = *(const u32x4*)(HB + (size_t)(pm * 8 + pn) * 65536 + (((wr * 4 + wc) * 4 + fq) * 16 + fr) * 8 + ((ai * 2 + bj) * 4 + m) * 4096);
#pragma unroll
            for (int m = 0; m < 4; ++m) { const int row = pm * 256 + ai * 128 + wr * 64 + m * 16 + fr; float s = 0.f;
#pragma unroll
                for (int bj = 0; bj < 2; ++bj) { const u32x4 hw_ = hin[m][bj]; FF2_H(hw_);
                    const f32x4 y0 = h0 + gv[bj][0] * acc[ai][bj][m][0], y1 = h1 + gv[bj][1] * acc[ai][bj][m][1];
                    s += (y0[0] * y0[0] + y0[1] * y0[1]) + (y0[2] * y0[2] + y0[3] * y0[3]) + (y1[0] * y1[0] + y1[1] * y1[1]) + (y1[2] * y1[2] + y1[3] * y1[3]); }
                s += __shfl_xor(s, 16); s += __shfl_xor(s, 32);
                if (fq == 0) __builtin_amdgcn_raw_buffer_store_b32(__builtin_bit_cast(unsigned, s), pr, (unsigned)(row * 32 + pn * 4 + wc) * 4u, 0, 16); }
            asm volatile("" ::: "memory"); }
        asm volatile("s_waitcnt vmcnt(0)" ::: "memory");
        unsigned* pc = cnt + pm * 64;
        if (fr == 0 && fq == 0) __hip_atomic_fetch_add(pc, 1u, __ATOMIC_RELAXED, __HIP_MEMORY_SCOPE_AGENT);
        { unsigned spins = 0;
          while ((unsigned)__builtin_amdgcn_readfirstlane((int)__hip_atomic_load(pc, __ATOMIC_RELAXED, __HIP_MEMORY_SCOPE_AGENT)) < 64u) { __builtin_amdgcn_s_sleep(2); if (++spins > (1u << 22)) break; } }
        asm volatile("" : "+v"(fr), "+v"(fq) :: "memory");
        asm volatile("" : "+v"(gv[0][0]), "+v"(gv[0][1]), "+v"(gv[1][0]), "+v"(gv[1][1]));
        float rs[2][4];
#pragma unroll
        for (int ai = 0; ai < 2; ++ai) { u32x4 pa[4][2];
#pragma unroll
            for (int m = 0; m < 4; ++m) { const int row = pm * 256 + ai * 128 + wr * 64 + m * 16 + fr;
#pragma unroll
                for (int q = 0; q < 2; ++q) pa[m][q] = __builtin_amdgcn_raw_buffer_load_b128(pr, (unsigned)(row * 32 + fq * 8 + 4 * q) * 4u, 0, 16); }
#pragma unroll
            for (int m = 0; m < 4; ++m) { const f32x4 a = __builtin_bit_cast(f32x4, pa[m][0]), b = __builtin_bit_cast(f32x4, pa[m][1]);
                float s = (a[0] + a[1]) + (a[2] + a[3]) + (b[0] + b[1]) + (b[2] + b[3]);
                s += __shfl_xor(s, 16); s += __shfl_xor(s, 32);
                rs[ai][m] = __builtin_amdgcn_rsqf(s * (1.0f / 2048.0f) + 1e-6f); }
            asm volatile("" ::: "memory"); }
        f32x4 nv[2][2];
#pragma unroll
        for (int bj = 0; bj < 2; ++bj)
#pragma unroll
            for (int n = 0; n < 2; ++n) nv[bj][n] = *(const f32x4*)(nf + pn * 256 + bj * 128 + wc * 32 + 8 * fq + 4 * n);
#pragma unroll
        for (int ai = 0; ai < 2; ++ai) { u32x4 hin[4][2];
#pragma unroll
            for (int m = 0; m < 4; ++m)
#pragma unroll
                for (int bj = 0; bj < 2; ++bj) hin[m][bj] = *(const u32x4*)(HB + (size_t)(pm * 8 + pn) * 65536 + (((wr * 4 + wc) * 4 + fq) * 16 + fr) * 8 + ((ai * 2 + bj) * 4 + m) * 4096);
#pragma unroll
            for (int m = 0; m < 4; ++m) { const size_t row = (size_t)pm * 256 + ai * 128 + wr * 64 + m * 16 + fr; const float r = rs[ai][m];
#pragma unroll
                for (int bj = 0; bj < 2; ++bj) { const u32x4 hw_ = hin[m][bj]; FF2_H(hw_);
                    const f32x4 y0 = h0 + gv[bj][0] * acc[ai][bj][m][0], y1 = h1 + gv[bj][1] * acc[ai][bj][m][1];
                    float* p = out + row * 2048 + pn * 256 + bj * 128 + wc * 32 + 8 * fq;
                    *(f32x4*)p = y0 * r * nv[bj][0]; *(f32x4*)(p + 4) = y1 * r * nv[bj][1]; } }
            asm volatile("" ::: "memory"); }
#undef FF2_H
    }
};

template <class Epi, class Sched, bool ALIGN_EPI = false, bool SP2 = false, int NPART = 1, int NSLOTS = 128>
__device__ __forceinline__ void gemm_phase(PG8_LAS unsigned char* lds, const Gemm g, const Sched& S, const Epi& E, float* partial = nullptr, unsigned* flags = nullptr, int pslot_split = 1 << 30, unsigned pslot_gap = 0u) {
    const int tid = threadIdx.x, wid = __builtin_amdgcn_readfirstlane(tid >> 6), lane = tid & 63, wr = wid >> 2, wc = wid & 3, fr = lane & 15, fq = lane >> 4;
    const int K = g.K;
    unsigned voffA[2], voffB[2];
    static_assert(Epi::PERM, "the weight images are stored with the perm32 row order");
#pragma unroll
    for (int i = 0; i < 2; ++i) { int R, C; stage_rc(tid * 16 + i * 8192, R, C);
        voffA[i] = g.atiled ? (unsigned)(tid * 16 + i * 8192) : (unsigned)(R * K + C) * 2u; voffB[i] = (unsigned)(tid * 16 + i * 8192); }
    const size_t kstep = (size_t)(BK * 2);
    const size_t hstep = (size_t)HALF * K * 2;
    const size_t tstep = 2 * hstep;
    const size_t kstepA = g.atiled ? (size_t)(BM * BK * 2) : kstep;
    const size_t hstepA = g.atiled ? (size_t)(HALF * BK * 2) : hstep;
    const size_t kstepB = (size_t)(BM * BK * 2), hstepB = (size_t)(HALF * BK * 2);
    const unsigned ldsw = (unsigned)wid * 1024u;
    const int aoff = lds_byte(wr * 64 + fr, fq * 8), boff = lds_byte(wc * 32 + fr, fq * 8);
#define PG8_SA(b, h) (((b) * 2 + (h)) * HTB)
#define PG8_SB(b, h) ((4 + (b) * 2 + (h)) * HTB)
#define PG8_STAGE(bufoff, gbase, voff) do { _Pragma("unroll") for (int _i = 0; _i < 2; ++_i) \
        __builtin_amdgcn_global_load_lds((const unsigned*)((const char*)(gbase) + (voff)[_i]), (PG8_LAS unsigned*)(lds + (bufoff) + ldsw + _i * 8192), 16, 0, 0); } while (0)
#define PG8_LDA(dst, b, h) do { _Pragma("unroll") for (int m = 0; m < 4; ++m) _Pragma("unroll") for (int k = 0; k < 2; ++k) dst[m][k] = *(const PG8_LAS bf16x8*)(lds + PG8_SA(b, h) + aoff + m * 2048 + k * 1024); } while (0)
#define PG8_LDB(dst, b, h) do { _Pragma("unroll") for (int n = 0; n < 2; ++n) _Pragma("unroll") for (int k = 0; k < 2; ++k) dst[n][k] = *(const PG8_LAS bf16x8*)(lds + PG8_SB(b, h) + boff + n * 2048 + k * 1024); } while (0)
#define PG8_MMA(ai, bj, At, Bt) do { __builtin_amdgcn_s_setprio(1); _Pragma("unroll") for (int m = 0; m < 4; ++m) _Pragma("unroll") for (int n = 0; n < 2; ++n) _Pragma("unroll") for (int k = 0; k < 2; ++k) \
        acc[ai][bj][m][n] = __builtin_amdgcn_mfma_f32_16x16x32_bf16(Bt[n][k], At[m][k], acc[ai][bj][m][n], 0, 0, 0); __builtin_amdgcn_s_setprio(0); } while (0)
#define PG8_WAIT_V(n) asm volatile("s_waitcnt vmcnt(" #n ")" ::: "memory")
#define PG8_WAIT_L(n) asm volatile("s_waitcnt lgkmcnt(" #n ")" ::: "memory")
#define PG8_BAR __builtin_amdgcn_s_barrier()
#define PG8_SCHED __builtin_amdgcn_sched_barrier(0)
    Unit cur, nxt; int ui = 0;
    if (!S.next(0, cur)) return;
    f32x4 acc[2][2][4][2];
#pragma unroll
    for (int a = 0; a < 2; ++a)
#pragma unroll
        for (int b = 0; b < 2; ++b)
#pragma unroll
            for (int m = 0; m < 4; ++m)
#pragma unroll
                for (int n = 0; n < 2; ++n) acc[a][b][m][n] = (f32x4){0.f, 0.f, 0.f, 0.f};
    bf16x8 At[4][2], B0[2][2], B1[2][2];
    const char* cA = (const char*)g.A + (size_t)cur.pm * tstep + (size_t)cur.k0 * kstepA; const char* cB = (const char*)g.Bt + (size_t)cur.pn * tstep + (size_t)cur.k0 * kstepB;
    S.a_ready(cur);
    if constexpr (SP2) {
        PG8_STAGE(PG8_SB(0, 0), cB, voffB); PG8_STAGE(PG8_SB(0, 1), cB + hstepB, voffB); PG8_STAGE(PG8_SA(0, 0), cA, voffA); PG8_STAGE(PG8_SA(0, 1), cA + hstepA, voffA);
        if (wr == 1) PG8_BAR;
        PG8_WAIT_V(2); PG8_BAR;
        PG8_STAGE(PG8_SB(1, 0), cB + kstepB, voffB); PG8_STAGE(PG8_SA(1, 0), cA + kstepA, voffA); PG8_STAGE(PG8_SB(1, 1), cB + hstepB + kstepB, voffB);
        PG8_WAIT_V(6); PG8_BAR;
    } else {
        PG8_STAGE(PG8_SB(0, 0), cB, voffB); PG8_STAGE(PG8_SA(0, 0), cA, voffA); PG8_STAGE(PG8_SB(0, 1), cB + hstepB, voffB); PG8_STAGE(PG8_SA(0, 1), cA + hstepA, voffA);
        if (wr == 1) PG8_BAR;
        PG8_WAIT_V(4); PG8_BAR;
        PG8_STAGE(PG8_SB(1, 0), cB + kstepB, voffB); PG8_STAGE(PG8_SA(1, 0), cA + kstepA, voffA); PG8_STAGE(PG8_SB(1, 1), cB + hstepB + kstepB, voffB);
        PG8_WAIT_V(6); PG8_BAR;
    }
    for (;;) {
        const bool has_next = S.next(ui + 1, nxt);
        const char* nA = has_next ? (const char*)g.A + (size_t)nxt.pm * tstep + (size_t)nxt.k0 * kstepA : cA; const char* nB = has_next ? (const char*)g.Bt + (size_t)nxt.pn * tstep + (size_t)nxt.k0 * kstepB : cB;
        const int nt = cur.nt;
        for (int t = 0; t < nt; t += 2) {
            const bool last = (t == nt - 2);
            const char* a1 = cA + (size_t)(t + 1) * kstepA;
            const char* a2 = last ? nA : cA + (size_t)(t + 2) * kstepA; const char* b2 = last ? nB : cB + (size_t)(t + 2) * kstepB;
            const char* a3 = a2 + kstepA; const char* b3 = b2 + kstepB;
            if (last && has_next) S.a_ready(nxt);
            if constexpr (SP2) {
            PG8_LDB(B0, 0, 0); PG8_LDB(B1, 0, 1); PG8_SCHED; PG8_LDA(At, 0, 0); PG8_STAGE(PG8_SA(1, 1), a1 + hstepA, voffA);
            PG8_WAIT_V(8); PG8_WAIT_L(0); PG8_BAR; PG8_MMA(0, 0, At, B0); PG8_MMA(0, 1, At, B1); PG8_BAR; PG8_SCHED;
            PG8_LDA(At, 0, 1); PG8_STAGE(PG8_SB(0, 0), b2, voffB); PG8_STAGE(PG8_SB(0, 1), b2 + hstepB, voffB); PG8_STAGE(PG8_SA(0, 0), a2, voffA);
            PG8_WAIT_V(8); PG8_WAIT_L(0); PG8_BAR; PG8_MMA(1, 0, At, B0); PG8_MMA(1, 1, At, B1); PG8_BAR; PG8_SCHED;
            PG8_LDB(B0, 1, 0); PG8_LDB(B1, 1, 1); PG8_SCHED; PG8_LDA(At, 1, 0); PG8_STAGE(PG8_SA(0, 1), a2 + hstepA, voffA);
            PG8_WAIT_V(8); PG8_WAIT_L(0); PG8_BAR; PG8_MMA(0, 0, At, B0); PG8_MMA(0, 1, At, B1); PG8_BAR; PG8_SCHED;
            PG8_LDA(At, 1, 1); PG8_STAGE(PG8_SB(1, 0), b3, voffB); PG8_STAGE(PG8_SB(1, 1), b3 + hstepB, voffB); PG8_STAGE(PG8_SA(1, 0), a3, voffA);
            PG8_WAIT_V(8); PG8_WAIT_L(0); PG8_BAR; PG8_MMA(1, 0, At, B0); PG8_MMA(1, 1, At, B1); PG8_BAR; PG8_SCHED;
            } else {
            PG8_LDB(B0, 0, 0); PG8_SCHED; PG8_LDA(At, 0, 0); PG8_STAGE(PG8_SA(1, 1), a1 + hstepA, voffA);
            PG8_WAIT_L(8); PG8_BAR; PG8_WAIT_L(0); PG8_MMA(0, 0, At, B0); PG8_BAR; PG8_SCHED;
            PG8_LDB(B1, 0, 1); PG8_STAGE(PG8_SB(0, 0), b2, voffB);
            PG8_BAR; PG8_WAIT_L(0); PG8_MMA(0, 1, At, B1); PG8_BAR;
            PG8_LDA(At, 0, 1); PG8_STAGE(PG8_SA(0, 0), a2, voffA);
            PG8_BAR; PG8_WAIT_L(0); PG8_MMA(1, 0, At, B0); PG8_BAR; PG8_SCHED;
            PG8_STAGE(PG8_SB(0, 1), b2 + hstepB, voffB);
            PG8_WAIT_V(6); PG8_BAR; PG8_MMA(1, 1, At, B1); PG8_BAR;
            PG8_LDB(B0, 1, 0); PG8_SCHED; PG8_LDA(At, 1, 0); PG8_STAGE(PG8_SA(0, 1), a2 + hstepA, voffA);
            PG8_WAIT_L(8); PG8_BAR; PG8_WAIT_L(0); PG8_MMA(0, 0, At, B0); PG8_BAR; PG8_SCHED;
            PG8_LDB(B1, 1, 1); PG8_STAGE(PG8_SB(1, 0), b3, voffB);
            PG8_BAR; PG8_WAIT_L(0); PG8_MMA(0, 1, At, B1); PG8_BAR;
            PG8_LDA(At, 1, 1); PG8_STAGE(PG8_SA(1, 0), a3, voffA);
            PG8_BAR; PG8_WAIT_L(0); PG8_MMA(1, 0, At, B0); PG8_BAR; PG8_SCHED;
            PG8_STAGE(PG8_SB(1, 1), b3 + hstepB, voffB);
            PG8_WAIT_V(6); PG8_BAR; PG8_MMA(1, 1, At, B1); PG8_BAR;
            }
        }
        if constexpr (ALIGN_EPI) { if (wr == 0) PG8_BAR; }
        if constexpr (!Epi::AFTER_DRAIN) {
            if (partial != nullptr) {
                int tid_o = tid; asm volatile("" : "+v"(tid_o));
                const unsigned pb = (unsigned)cur.slot * 262144u + (cur.slot >= pslot_split ? pslot_gap : 0u) + (unsigned)tid_o * 16u;
                const bool m2 = cur.mode == 2;
                if (m2) {
                    unsigned spins = 0;
                    for (;;) { unsigned ok = 1u;
#pragma unroll
                        for (int p = 0; p < NPART; ++p) if (p < cur.npart) ok &= (__hip_atomic_load(flags + (cur.slot + p) * 8 + wid, __ATOMIC_RELAXED, __HIP_MEMORY_SCOPE_AGENT) != 0u) ? 1u : 0u;
                        if (__builtin_amdgcn_readfirstlane(ok) != 0u) break;
                        __builtin_amdgcn_s_sleep(8); if (++spins > (1u << 22)) break; }
                }
#pragma unroll 1
                for (int p = 0; p < (m2 ? cur.npart : 0); ++p) {
                    const __amdgpu_buffer_rsrc_t prl = __builtin_amdgcn_make_buffer_rsrc(partial, 0, 0x7fffffff, 0x00020000);
                    const unsigned pbp = pb + (unsigned)p * 262144u;
#pragma unroll
                    for (int a = 0; a < 2; ++a) { u32x4 pv_[2][4];
#pragma unroll
                        for (int b = 0; b < 2; ++b)
#pragma unroll
                            for (int m = 0; m < 4; ++m) pv_[b][m] = __builtin_amdgcn_raw_buffer_load_b128(prl, pbp, ((a * 2 + b) * 4 + m) * 8192, 16);
#pragma unroll
                        for (int b = 0; b < 2; ++b)
#pragma unroll
                            for (int m = 0; m < 4; ++m) { const u32x4 w = pv_[b][m];
                                acc[a][b][m][0] += (f32x4){__builtin_bit_cast(float, w.x << 16), __builtin_bit_cast(float, w.x & 0xffff0000u), __builtin_bit_cast(float, w.y << 16), __builtin_bit_cast(float, w.y & 0xffff0000u)};
                                acc[a][b][m][1] += (f32x4){__builtin_bit_cast(float, w.z << 16), __builtin_bit_cast(float, w.z & 0xffff0000u), __builtin_bit_cast(float, w.w << 16), __builtin_bit_cast(float, w.w & 0xffff0000u)}; }
                        asm volatile("" ::: "memory"); }
                }
            }
            {
                if (partial != nullptr && cur.mode == 1) {
                    int tid_o = tid; asm volatile("" : "+v"(tid_o));
                    const unsigned pb = (unsigned)cur.slot * 262144u + (cur.slot >= pslot_split ? pslot_gap : 0u) + (unsigned)tid_o * 16u;
                    const __amdgpu_buffer_rsrc_t pr_ = __builtin_amdgcn_make_buffer_rsrc(partial, 0, 0x7fffffff, 0x00020000);
#pragma unroll
                    for (int a = 0; a < 2; ++a)
#pragma unroll
                        for (int b = 0; b < 2; ++b)
#pragma unroll
                            for (int m = 0; m < 4; ++m) { const u32x2 lo = pack4(acc[a][b][m][0]), hi = pack4(acc[a][b][m][1]); u32x4 w; w.x = lo.x; w.y = lo.y; w.z = hi.x; w.w = hi.y;
                                __builtin_amdgcn_raw_buffer_store_b128(w, pr_, pb, ((a * 2 + b) * 4 + m) * 8192, 16); }
                    asm volatile("s_waitcnt vmcnt(0)" ::: "memory");
                    if (lane == 0) __hip_atomic_store(flags + cur.slot * 8 + wid, 1u, __ATOMIC_RELAXED, __HIP_MEMORY_SCOPE_AGENT);
                } else E(acc, cur, ui, wr, wc, fr, fq);
            }
            S.done(cur);
        }
        if (!has_next) break;
#pragma unroll
        for (int a = 0; a < 2; ++a)
#pragma unroll
            for (int b = 0; b < 2; ++b)
#pragma unroll
                for (int m = 0; m < 4; ++m)
#pragma unroll
                    for (int n = 0; n < 2; ++n) acc[a][b][m][n] = (f32x4){0.f, 0.f, 0.f, 0.f};
        cur = nxt; cA = nA; cB = nB; ++ui;
        if constexpr (ALIGN_EPI) { if (wr == 1) PG8_BAR; }
    }
    PG8_WAIT_V(0);
    if constexpr (!ALIGN_EPI) { if (wr == 0) PG8_BAR; }
    PG8_BAR;
    if constexpr (Epi::AFTER_DRAIN) { E.fused(acc, cur, wr, wc, fr, fq, lds, wid, lane); S.done(cur); }
#undef PG8_SA
#undef PG8_SB
#undef PG8_STAGE
#undef PG8_LDA
#undef PG8_LDB
#undef PG8_MMA
#undef PG8_WAIT_V
#undef PG8_WAIT_L
#undef PG8_BAR
#undef PG8_SCHED
}
}

#define GAS __attribute__((address_space(1)))
#define LAS __attribute__((address_space(3)))
typedef unsigned short bf16;
typedef unsigned v4u __attribute__((ext_vector_type(4)));
typedef float f32x4 __attribute__((ext_vector_type(4)));
typedef short bf16x8 __attribute__((ext_vector_type(8)));
typedef GAS unsigned gu32;
typedef GAS unsigned long long gu64;
#define RLX_AGENT __ATOMIC_RELAXED, __HIP_MEMORY_SCOPE_AGENT
#define LBAR() asm volatile("s_waitcnt lgkmcnt(0)\n\ts_barrier" ::: "memory")
#define LDS_WAIT() asm volatile("s_waitcnt lgkmcnt(0)" ::: "memory")
#define VM_WAIT() asm volatile("s_waitcnt vmcnt(0)" ::: "memory")
__device__ __forceinline__ unsigned long long rt() { return __builtin_amdgcn_s_memrealtime(); }
__device__ __forceinline__ unsigned f2bf(float f) { unsigned u = __builtin_bit_cast(unsigned, f); return (u + 0x7fffu + ((u >> 16) & 1u)) >> 16; }
__device__ __forceinline__ unsigned pk2(float lo, float hi) { return f2bf(lo) | (f2bf(hi) << 16); }

#define XB_TMO      128
#define XB_XCNT(j)  (256  + 64 * (j))
#define XB_XSUB(j)  (1280 + 64 * (j))
#define XB_XGEN(j)  (2304 + 64 * (j))
#define XB_TOP      3328
#define XB_TOPGEN   3392
#define XCD_BAR_WORDS 3456
#define XB_SPIN_CAP (1u << 18)

__device__ __forceinline__ unsigned xb_ld(unsigned* p)              { return __hip_atomic_load(p, __ATOMIC_RELAXED, __HIP_MEMORY_SCOPE_AGENT); }
__device__ __forceinline__ unsigned xb_add(unsigned* p, unsigned v) { return __hip_atomic_fetch_add(p, v, __ATOMIC_RELAXED, __HIP_MEMORY_SCOPE_AGENT); }
__device__ __forceinline__ unsigned xb_xcc_id() { return (unsigned)__builtin_amdgcn_s_getreg((3 << 11) | 20) & 0xFu; }
#define XB_SPIN(cond, bar) do { unsigned _sp = 0; while (cond) { __builtin_amdgcn_s_sleep(1); \
    if ((++_sp & 255u) == 0u) { if (xb_ld(&(bar)[XB_TMO])) break; if (_sp > XB_SPIN_CAP) { atomicAdd(&(bar)[XB_TMO], 1u); break; } } } } while (0)

struct XcdBarrier {
    unsigned* bar; unsigned x;
    volatile LAS unsigned* st;
};

__device__ __forceinline__ XcdBarrier xcd_barrier_post(unsigned* bar, volatile LAS unsigned* st) {
    XcdBarrier b; b.bar = bar; b.x = xb_xcc_id(); b.st = st;
    if (threadIdx.x == 0) (void)xb_add(&bar[XB_XCNT(b.x)], 1u);
    return b;
}
__device__ __forceinline__ void xcd_barrier_complete(unsigned* bar, unsigned x, unsigned& nloc, unsigned& nx) {
    const unsigned G = gridDim.x * gridDim.y * gridDim.z;
    unsigned sum, cnt, mine, sp = 0u;
    for (;;) {
        sum = 0u; cnt = 0u; mine = 0u;
#pragma unroll
        for (unsigned j = 0; j < 16; ++j) { const unsigned c = xb_ld(&bar[XB_XCNT(j)]); sum += c; cnt += (c > 0u) ? 1u : 0u; mine = (j == x) ? c : mine; }
        if (sum == G) break;
        __builtin_amdgcn_s_sleep(1);
        if ((++sp & 255u) == 0u) { if (xb_ld(&bar[XB_TMO])) break; if (sp > XB_SPIN_CAP) { atomicAdd(&bar[XB_TMO], 1u); break; } }
    }
    nloc = mine > 0u ? mine : 1u; nx = cnt > 0u ? cnt : 1u;
}

__device__ __forceinline__ void xcd_barrier(const XcdBarrier& b) {
    asm volatile("s_waitcnt vmcnt(0)" ::: "memory");
    __syncthreads();
    if (threadIdx.x == 0) {
        unsigned* bar = b.bar;
        __builtin_amdgcn_s_waitcnt(0);
        unsigned nloc = b.st[0], nx = b.st[1];
        if (nloc == 0u) { xcd_barrier_complete(bar, b.x, nloc, nx); b.st[0] = nloc; b.st[1] = nx; }
        const unsigned old = xb_add(&bar[XB_XSUB(b.x)], 1u);
        const unsigned gen = old / nloc;
        if (old + 1u == (gen + 1u) * nloc) {
            __builtin_amdgcn_fence(__ATOMIC_RELEASE, "agent");
            asm volatile("s_waitcnt vmcnt(0)" ::: "memory");
            const unsigned og = xb_add(&bar[XB_TOP], 1u);
            const unsigned tg = og / nx;
            if (og + 1u == (tg + 1u) * nx) xb_add(&bar[XB_TOPGEN], 1u);
            else XB_SPIN(xb_ld(&bar[XB_TOPGEN]) == tg, bar);
            __builtin_amdgcn_fence(__ATOMIC_ACQUIRE, "agent");
            xb_add(&bar[XB_XGEN(b.x)], 1u);
            asm volatile("s_waitcnt vmcnt(0)" ::: "memory");
        } else {
            XB_SPIN(xb_ld(&bar[XB_XGEN(b.x)]) == gen, bar);
            __builtin_amdgcn_fence(__ATOMIC_ACQUIRE, "agent");
            asm volatile("s_waitcnt vmcnt(0)" ::: "memory");
        }
    }
    __syncthreads();
}

constexpr int NWAVES = 8;
constexpr int DM = 2048, NPROMPT = 4096, NSAMPLE = 8192, MROWS = 12288, DFF = 8192, INC = 7200, NMOD = 12288;
constexpr float EPS = 1e-6f;
constexpr size_t MiB = 1u << 20;
constexpr size_t WS_CTL = 0, CTL_ZERO_BYTES = 128 * 1024;
constexpr size_t WS_MOD = 1 * MiB;
constexpr size_t WS_C2 = WS_MOD + 9 * 12288 * 4;
constexpr size_t WS_ROPE = WS_C2 + 9 * 8192 * 4;
constexpr size_t WS_PART = 2 * MiB, WS_PART2 = 4 * MiB, WS_AB = 6 * MiB;
constexpr size_t WS_EVEC = 8 * MiB;
constexpr size_t WS_WOUT = 12 * MiB, WS_WFF1 = 20 * MiB, WS_WFF2 = 52 * MiB, WS_WIN = 84 * MiB;
constexpr size_t WS_QHAT = 84 * MiB;
constexpr size_t WS_KS = 113 * MiB, WS_VS = 137 * MiB;
constexpr size_t WS_QKVB = 161 * MiB;
constexpr size_t WS_HB = 113 * MiB;
constexpr size_t WS_OF = 161 * MiB;
constexpr size_t WS_HW = 161 * MiB;
constexpr size_t WS_MIX = 233 * MiB;
constexpr size_t WS_KHT = 281 * MiB;
constexpr size_t WS_XN = 305 * MiB;
constexpr size_t WS_NW = 305 * MiB;
constexpr size_t WS_U = 353 * MiB;
constexpr size_t WS_INTRA = 401 * MiB;
constexpr size_t WS_FF = 209 * MiB;
constexpr size_t WS_END = 425 * MiB;
static_assert(WS_ROPE + 2048 * 4 <= WS_PART && WS_EVEC + 3072 * 192 * 4 <= WS_WOUT && WS_WIN + (size_t)INC * DM * 2 <= WS_KS && WS_FF + (size_t)MROWS * DFF * 2 <= WS_INTRA + 24 * MiB, "ws map");
static_assert(WS_HW + 48 * MiB <= WS_FF, "HW below FF");
constexpr size_t YO_QA = 0, YO_GATE = 24 * MiB, YO_KP = 48 * MiB, YO_VP = 56 * MiB, YO_OF = 48 * MiB, YO_OB = 72 * MiB;
constexpr size_t OUT_Y = 0, OUT_K = 25165824, OUT_V = OUT_K + 4194304, OUT_S = OUT_V + 4194304;
constexpr int CW_TMO = 0, CW_BAR = 4096, CW_FLAG = 16384, CW_PANEL = 20480, CW_PAIR = 24576;
constexpr int RING_OFF = 0, RING_BYTES = 131072, P0_SCR_BYTES = 8 * 16640, RSTD_OFF = 135168, LDSCTL_OFF = 146432, MISC_OFF = LDSCTL_OFF + 320, LDS_BYTES = 147456;
static_assert(P0_SCR_BYTES <= RSTD_OFF && RSTD_OFF + 6 * 256 * 4 <= LDSCTL_OFF && MISC_OFF + 128 <= LDS_BYTES, "LDS map");

typedef unsigned short bf16;
typedef unsigned u32x2 __attribute__((ext_vector_type(2)));
typedef float f32x16 __attribute__((ext_vector_type(16)));
typedef short s16x4 __attribute__((ext_vector_type(4)));
__device__ __forceinline__ float bf2f(unsigned short v) { return __builtin_bit_cast(float, (unsigned)v << 16); }
__device__ __forceinline__ float bflo(unsigned w) { return __builtin_bit_cast(float, w << 16); }
__device__ __forceinline__ float bfhi(unsigned w) { return __builtin_bit_cast(float, w & 0xffff0000u); }
__device__ __forceinline__ unsigned cvtpk(float lo, float hi) { return pg8::cvt_pk_bf16(lo, hi); }
__device__ __forceinline__ float wave_sum(float v) {
#pragma unroll
    for (int o = 1; o < 64; o <<= 1) v += __shfl_xor(v, o);
    return v;
}
__device__ __forceinline__ int crow(int r, int hi) { return (r & 3) + 8 * (r >> 2) + 4 * hi; }
__device__ __forceinline__ float silu_f(float x) { return x * __builtin_amdgcn_rcpf(1.0f + __expf(-x)); }

struct Frame {
    LAS unsigned char* lds; unsigned char* ldsg;
    volatile LAS unsigned* MISC;
    gu32* ctl;
    int tid, lane, wave, vcu, G;
    const float* const* inp; float* out; unsigned char* ws;
};

struct TileSrc { const float* src; bf16* dst; int K, N, n0; bool cval; };
__device__ __forceinline__ TileSrc p0_tile(Frame& F, int it, int lane) {
    constexpr int I_IN = (DM / 64) * ((INC + 63) / 64), I_OUT = (DM / 64) * (DM / 64), I_F1 = (DM / 64) * (DFF / 64);
    const float* W; bf16* WT; int K, N; int r = it;
    if (r < I_IN) { W = F.inp[10]; WT = (bf16*)(F.ws + WS_WIN); K = DM; N = INC; }
    else if ((r -= I_IN) < I_OUT) { W = F.inp[17]; WT = (bf16*)(F.ws + WS_WOUT); K = DM; N = DM; }
    else if ((r -= I_OUT) < I_F1) { W = F.inp[19]; WT = (bf16*)(F.ws + WS_WFF1); K = DM; N = DFF; }
    else { r -= I_F1; W = F.inp[20]; WT = (bf16*)(F.ws + WS_WFF2); K = DFF; N = DM; }
    const int nblk = (N + 63) / 64, kb = r / nblk, nb = r % nblk, k0 = 64 * kb, n0 = 64 * nb; const int c = 4 * (lane & 15);
    TileSrc t; t.src = W + (size_t)(k0 + (lane >> 4)) * N + n0 + c; t.dst = WT + (size_t)((n0 >> 8) * (K >> 6) + kb) * 16384; t.K = K;     t.N = N; t.n0 = n0; t.cval = (n0 + c) < N; return t;
}
__device__ __forceinline__ void p0_tile_load(Frame& F, int it, int lane, f32x4 (&v)[16]) {
    const TileSrc t = p0_tile(F, it, lane);
    const float* p = t.src; const size_t step = (size_t)4 * t.N;
#pragma unroll
    for (int i = 0; i < 16; ++i) { v[i] = (f32x4){0.f, 0.f, 0.f, 0.f}; if (t.cval) v[i] = __builtin_nontemporal_load((const f32x4*)p); p += step; asm volatile("" : "+v"(p)); }
}
__device__ __forceinline__ void p0_tile_store(Frame& F, int it, const f32x4 (&v)[16], LAS float* scr, int lane) {
    const TileSrc t = p0_tile(F, it, lane);
    const int c = 4 * (lane & 15);
#pragma unroll
    for (int i = 0; i < 16; ++i) { LAS float* d = scr + (4 * i + (lane >> 4)) * 65 + c; d[0] = v[i][0]; d[1] = v[i][1]; d[2] = v[i][2]; d[3] = v[i][3]; }
    LDS_WAIT(); asm volatile("" ::: "memory");
    const int c8 = lane & 7;
#pragma unroll
    for (int j = 0; j < 8; ++j) { const int n = (lane >> 3) + 8 * j; const LAS float* s_ = scr + (8 * c8) * 65 + n;
        v4u o; o.x = cvtpk(s_[0 * 65], s_[1 * 65]); o.y = cvtpk(s_[2 * 65], s_[3 * 65]); o.z = cvtpk(s_[4 * 65], s_[5 * 65]); o.w = cvtpk(s_[6 * 65], s_[7 * 65]);
        const int nb_ = (t.n0 & 255) + n, ri_ = (nb_ & 96) + pg8::perm32inv(nb_ & 31);
        bf16* dp_ = t.dst + (nb_ >> 7) * 8192 + (pg8::lds_byte(ri_, 8 * c8) >> 1);
        if (t.n0 + n < t.N) { if (t.N == INC) *(GAS v4u*)dp_ = o; else __builtin_nontemporal_store(o, (GAS v4u*)dp_); }
        if (j & 1) __builtin_amdgcn_sched_barrier(0); }
    LDS_WAIT(); asm volatile("" ::: "memory");
}
__device__ __forceinline__ void p0_phase(Frame& F) {
    const float* c_lat = F.inp[5]; const float* c_ctx = F.inp[6]; const float* w_mod = F.inp[7]; const float* b_mod = F.inp[8];
    float* MOD = (float*)(F.ws + WS_MOD);
    const int bid = F.vcu;
    if (bid < 192) {
        LAS float* sil = (LAS float*)(F.lds);
        LAS float* red = (LAS float*)(F.lds + 9 * 2048 * 4);
        for (int idx = F.tid; idx < 9 * 2048; idx += 512) { const int b = idx >> 11, k = idx & 2047; const float cv = (b == 0) ? c_ctx[k] : c_lat[(b - 1) * 2048 + k]; sil[idx] = silu_f(cv); }
        __syncthreads();
        const int c0 = 64 * bid + 4 * (F.lane & 15);
        f32x4 acc[9];
#pragma unroll
        for (int b = 0; b < 9; ++b) acc[b] = (f32x4){0.f, 0.f, 0.f, 0.f};
        const int kbase = 256 * F.wave + (F.lane >> 4);
        for (int it0 = 0; it0 < 64; it0 += 16) {
            f32x4 wv[16];
#pragma unroll
            for (int u = 0; u < 16; ++u) wv[u] = __builtin_nontemporal_load((const f32x4*)(w_mod + (size_t)(kbase + 4 * (it0 + u)) * NMOD + c0));
#pragma unroll
            for (int u = 0; u < 16; ++u) { const int k = kbase + 4 * (it0 + u);
#pragma unroll
                for (int b = 0; b < 9; ++b) { const float s_ = sil[b * 2048 + k]; acc[b] += wv[u] * s_; }
                if ((u & 1) == 1) __builtin_amdgcn_sched_barrier(0); }
        }
#pragma unroll
        for (int b = 0; b < 9; ++b)
#pragma unroll
            for (int e = 0; e < 4; ++e) { float v = acc[b][e]; v += __shfl_xor(v, 16); v += __shfl_xor(v, 32); acc[b][e] = v; }
        if (F.lane < 16) {
#pragma unroll
            for (int b = 0; b < 9; ++b)
#pragma unroll
                for (int e = 0; e < 4; ++e) red[(F.wave * 9 + b) * 64 + 4 * F.lane + e] = acc[b][e]; }
        __syncthreads();
        for (int idx = F.tid; idx < 9 * 64; idx += 512) { const int b = idx >> 6, cc = idx & 63; float s_ = b_mod[64 * bid + cc];
#pragma unroll
            for (int w = 0; w < 8; ++w) s_ += red[(w * 9 + b) * 64 + cc];
            MOD[b * NMOD + 64 * bid + cc] = s_; }
        __syncthreads();
    } else if (bid == 255) { float* rope = (float*)(F.ws + WS_ROPE);
        for (int idx = F.tid; idx < 1024; idx += 512) { const int pos = idx >> 4, i = idx & 15; const float inv = 1.0f / powf(10000.0f, (float)i * (1.0f / 16.0f)); const float ang = (float)pos * inv;
            rope[idx] = cosf(ang); rope[1024 + idx] = sinf(ang); } }
    const int myslots = (bid < 192) ? 5 : 7;
    const int slot0 = (bid < 192) ? (bid * NWAVES + F.wave) * 5 : 192 * NWAVES * 5 + ((bid - 192) * NWAVES + F.wave) * 7;
    constexpr int NSLOT = 192 * NWAVES * 5 + 64 * NWAVES * 7;
    {
        LAS float* scr = (LAS float*)(F.lds + F.wave * 16640);
        constexpr int NITEMS = (DM / 64) * ((INC + 63) / 64) + (DM / 64) * (DM / 64) + (DM / 64) * (DFF / 64) + (DFF / 64) * (DM / 64);
        f32x4 ta[16], tb[16];
        const int gw_ = bid * NWAVES + F.wave, NGW_ = F.G * NWAVES;
#define P0_ITEM(q) (gw_ + NGW_ * (q))
        int q = 0; int ia = P0_ITEM(0);
        if (ia < NITEMS) { p0_tile_load(F, ia, F.lane, ta);
            for (;;) {
                const int ib = P0_ITEM(q + 1); const bool hb = ib < NITEMS;
                if (hb) p0_tile_load(F, ib, F.lane, tb);
                p0_tile_store(F, ia, ta, scr, F.lane);
                if (!hb) break;
                const int ic = P0_ITEM(q + 2); const bool hc = ic < NITEMS;
                if (hc) p0_tile_load(F, ic, F.lane, ta);
                p0_tile_store(F, ib, tb, scr, F.lane);
                if (!hc) break;
                q += 2; ia = ic;
            }
        }
#undef P0_ITEM
    }
    {
        const float* ck = F.inp[2]; const float* cv = F.inp[3];
        bf16* KS = (bf16*)(F.ws + WS_KS); bf16* VS = (bf16*)(F.ws + WS_VS);
        for (int s_ = 0; s_ < myslots; ++s_)
            for (int base = slot0 + s_; base < 2 * 8192; base += 4 * NSLOT) {
                f32x4 a[4], b[4];
#pragma unroll
                for (int u = 0; u < 4; ++u) { const int it = base + u * NSLOT; if (it < 2 * 8192) { const bool isV = it >= 8192; const int j = isV ? it - 8192 : it; const float* src = (isV ? cv : ck) + (size_t)j * 512 + 8 * F.lane; a[u] = __builtin_nontemporal_load((const f32x4*)src); b[u] = __builtin_nontemporal_load((const f32x4*)(src + 4)); } }
#pragma unroll
                for (int u = 0; u < 4; ++u) { const int it = base + u * NSLOT; if (it < 2 * 8192) { const bool isV = it >= 8192; const int j = isV ? it - 8192 : it;
                    const size_t e0 = (size_t)j * 512 + 8 * F.lane; const int bh = (int)(e0 >> 16); const size_t rem = e0 & 65535;
                    v4u o; o.x = cvtpk(a[u][0], a[u][1]); o.y = cvtpk(a[u][2], a[u][3]); o.z = cvtpk(b[u][0], b[u][1]); o.w = cvtpk(b[u][2], b[u][3]);
                    __builtin_nontemporal_store(o, (GAS v4u*)((isV ? VS : KS) + (size_t)bh * 1536 * 128 + rem)); } }
            }
    }
}
__device__ __forceinline__ float wsum64(float v) {
    v += __builtin_bit_cast(float, __builtin_amdgcn_update_dpp(0, __builtin_bit_cast(int, v), 0xB1, 0xf, 0xf, true));
    v += __builtin_bit_cast(float, __builtin_amdgcn_update_dpp(0, __builtin_bit_cast(int, v), 0x4E, 0xf, 0xf, true));
    v += __builtin_bit_cast(float, __builtin_amdgcn_update_dpp(0, __builtin_bit_cast(int, v), 0x141, 0xf, 0xf, true));
    v += __builtin_bit_cast(float, __builtin_amdgcn_update_dpp(0, __builtin_bit_cast(int, v), 0x140, 0xf, 0xf, true));
    const int b = __builtin_bit_cast(int, v);
    return __builtin_bit_cast(float, __builtin_amdgcn_readlane(b, 0)) + __builtin_bit_cast(float, __builtin_amdgcn_readlane(b, 16)) + __builtin_bit_cast(float, __builtin_amdgcn_readlane(b, 32)) + __builtin_bit_cast(float, __builtin_amdgcn_readlane(b, 48));
}
__device__ __forceinline__ void p1_phase(Frame& F) {
    const float* MOD = (const float*)(F.ws + WS_MOD); const float* norm1 = F.inp[9];
    bf16* XN = (bf16*)(F.ws + WS_XN);
    const int gw = F.vcu * NWAVES + F.wave, NGW = F.G * NWAVES;
    {
        const bf16* W1t = (const bf16*)(F.ws + WS_WFF1); float* C2 = (float*)(F.ws + WS_C2);
        const int n = F.lane & 15, g = F.lane >> 4;
        LAS float* red = (LAS float*)F.lds;
        for (int id = F.vcu; id < DFF / 16; id += F.G) {
            const int f_ = id * 16 + n;
            const int fb_ = f_ & 255, fri_ = (fb_ & 96) + pg8::perm32inv(fb_ & 31);
            const bf16* bp = W1t + (size_t)((f_ >> 8) * 32 + 4 * F.wave) * 16384 + (fb_ >> 7) * 8192;
            const float* ap = MOD + (size_t)(n < 9 ? n : 0) * NMOD + 3 * DM + 256 * F.wave + 8 * g;
            f32x4 acc = {0.f, 0.f, 0.f, 0.f};
#pragma unroll
            for (int st = 0; st < 8; ++st) {
                const bf16x8 bfr = *(const bf16x8*)(bp + (st >> 1) * 16384 + (pg8::lds_byte(fri_, 32 * (st & 1) + 8 * g) >> 1));
                f32x4 a0 = *(const f32x4*)(ap + 32 * st), a1 = *(const f32x4*)(ap + 32 * st + 4);
                if (n >= 9) { a0 = (f32x4){0.f, 0.f, 0.f, 0.f}; a1 = a0; }
                v4u aw; aw.x = cvtpk(a0[0], a0[1]); aw.y = cvtpk(a0[2], a0[3]); aw.z = cvtpk(a1[0], a1[1]); aw.w = cvtpk(a1[2], a1[3]);
                acc = __builtin_amdgcn_mfma_f32_16x16x32_bf16(__builtin_bit_cast(bf16x8, aw), bfr, acc, 0, 0, 0);
            }
#pragma unroll
            for (int r = 0; r < 4; ++r) red[(F.wave * 16 + 4 * g + r) * 17 + n] = acc[r];
            __syncthreads();
            if (F.tid < 9 * 16) { const int mb = F.tid >> 4, cc = F.tid & 15; float v = 0.f;
#pragma unroll
                for (int w = 0; w < 8; ++w) v += red[(w * 16 + mb) * 17 + cc];
                C2[mb * DFF + id * 16 + cc] = v; }
            __syncthreads();
        }
    }
    {
        const int rpw = (MROWS + NGW - 1) / NGW; const int row0 = gw * rpw; const int rend = (row0 + rpw) < MROWS ? (row0 + rpw) : MROWS;
        int lane = F.lane; asm volatile("" : "+v"(lane));
        f32x4 v[8], vn[8], gsv[8], bv[8]; int cmb = -1;
        if (row0 < rend) { const float* xr = (row0 < NPROMPT ? F.inp[0] + (size_t)row0 * DM : F.inp[1] + (size_t)(row0 - NPROMPT) * DM) + 8 * lane;
#pragma unroll
            for (int j = 0; j < 4; ++j) { v[2 * j] = __builtin_nontemporal_load((const f32x4*)(xr + 512 * j)); v[2 * j + 1] = __builtin_nontemporal_load((const f32x4*)(xr + 512 * j + 4)); } }
        for (int row = row0; row < rend; ++row) {
            const int nrow = row + 1;
            if (nrow < rend) { const float* xr = (nrow < NPROMPT ? F.inp[0] + (size_t)nrow * DM : F.inp[1] + (size_t)(nrow - NPROMPT) * DM) + 8 * lane;
#pragma unroll
                for (int j = 0; j < 4; ++j) { vn[2 * j] = __builtin_nontemporal_load((const f32x4*)(xr + 512 * j)); vn[2 * j + 1] = __builtin_nontemporal_load((const f32x4*)(xr + 512 * j + 4)); } }
            const int mb = row < NPROMPT ? 0 : 1 + ((row - NPROMPT) >> 10);
            if (mb != cmb) { cmb = mb; const float* sh1 = MOD + mb * NMOD + 8 * lane; const float* sc1 = sh1 + DM; const float* n1 = norm1 + 8 * lane;
#pragma unroll
                for (int j = 0; j < 8; ++j) { const int k = 512 * (j >> 1) + 4 * (j & 1); const f32x4 g = *(const f32x4*)(n1 + k), s_ = *(const f32x4*)(sc1 + k); gsv[j] = g * (s_ + 1.0f); bv[j] = *(const f32x4*)(sh1 + k); } }
            float ss = 0.f;
#pragma unroll
            for (int j = 0; j < 8; ++j) ss += (v[j][0] * v[j][0] + v[j][1] * v[j][1]) + (v[j][2] * v[j][2] + v[j][3] * v[j][3]);
            const float rstd = rsqrtf(wsum64(ss) * (1.0f / DM) + EPS);
            bf16* xo = XN + (size_t)row * DM + 8 * lane;
#pragma unroll
            for (int j = 0; j < 4; ++j) { const f32x4 o0 = v[2 * j] * rstd * gsv[2 * j] + bv[2 * j], o1 = v[2 * j + 1] * rstd * gsv[2 * j + 1] + bv[2 * j + 1];
                v4u w; w.x = cvtpk(o0[0], o0[1]); w.y = cvtpk(o0[2], o0[3]); w.z = cvtpk(o1[0], o1[1]); w.w = cvtpk(o1[2], o1[3]); *(GAS v4u*)(xo + 512 * j) = w; }
#pragma unroll
            for (int j = 0; j < 8; ++j) v[j] = vn[j];
        }
    }
}
__device__ __forceinline__ void p2_ab(Frame& F) {
    const bf16* XN = (const bf16*)(F.ws + WS_XN); const bf16* Wab = (const bf16*)(F.ws + WS_WIN) + (size_t)28 * 32 * 16384;   float* AB = (float*)(F.ws + WS_AB);
    const int r32 = F.lane & 31, hi = F.lane >> 5;
    LAS float* red = (LAS float*)F.lds;
    for (int rb = F.vcu; rb < MROWS / 32; rb += F.G) {
        const bf16* ap = XN + (size_t)(rb * 32 + r32) * DM + 256 * F.wave + 8 * hi; const bf16* bp = Wab + (size_t)(4 * F.wave) * 16384; const int bri = pg8::perm32inv(r32);
        f32x16 acc = {};
#pragma unroll
        for (int s_ = 0; s_ < 16; ++s_) { const bf16x8 a = *(const bf16x8*)(ap + 16 * s_), b = *(const bf16x8*)(bp + (s_ >> 2) * 16384 + (pg8::lds_byte(bri, 16 * (s_ & 3) + 8 * hi) >> 1)); acc = __builtin_amdgcn_mfma_f32_32x32x16_bf16(a, b, acc, 0, 0, 0); }
#pragma unroll
        for (int r = 0; r < 16; ++r) red[(F.wave * 32 + crow(r, hi)) * 33 + r32] = acc[r];
        __syncthreads();
        for (int o = F.tid; o < 1024; o += 512) { const int row = o >> 5, col = o & 31; float v = 0.f;
#pragma unroll
            for (int w = 0; w < 8; ++w) v += red[(w * 32 + row) * 33 + col];
            AB[(size_t)(rb * 32 + row) * 32 + col] = v; }
        __syncthreads();
    }
}
namespace dattn {
using bf16x8 = __attribute__((ext_vector_type(8))) short;
using u32x4 = __attribute__((ext_vector_type(4))) unsigned;
constexpr int KVBLK = 64; constexpr float SCALE = 0.125f; constexpr float THR = 8.f;
constexpr int SHM_V = 64 * 128 * 2, SHM_K = 64 * 128 * 2;
#define KSWZ(row, colB) ((row) * 256 + ((colB) ^ (((row) & 7) << 4)))
#define SBAR() __builtin_amdgcn_sched_barrier(0)
__device__ __forceinline__ void partialSM(f32x16& p0, f32x16& p1, float& m_reg, float& mn, float& alpha) {
  constexpr float C = SCALE * 1.4426950408889634f;
  float pmax = p0[0];
#pragma unroll
  for (int r = 1; r < 16; ++r) pmax = fmaxf(pmax, p0[r]);
#pragma unroll
  for (int r = 0; r < 16; ++r) pmax = fmaxf(pmax, p1[r]);
  { auto rr = __builtin_amdgcn_permlane32_swap(__float_as_uint(pmax), __float_as_uint(pmax), false, false);
    pmax = fmaxf(__uint_as_float(rr[0]), __uint_as_float(rr[1])); }
  if (__builtin_expect(__all(pmax - m_reg <= THR / SCALE), 1)) { mn = m_reg; alpha = 1.f; }
  else { mn = fmaxf(m_reg, pmax); alpha = __builtin_amdgcn_exp2f((m_reg - mn) * C); m_reg = mn; }
  float mnC = -mn * C;
#pragma unroll
  for (int r = 0; r < 16; ++r) p0[r] = fmaf(p0[r], C, mnC);
#pragma unroll
  for (int r = 0; r < 16; ++r) p1[r] = fmaf(p1[r], C, mnC);
#pragma unroll
  for (int r = 0; r < 16; ++r) p0[r] = __builtin_amdgcn_exp2f(p0[r]);
}
__device__ __forceinline__ void finishSM(f32x16& p0, f32x16& p1, float alpha, float& l_reg, bf16x8& pa0, bf16x8& pa1, bf16x8& pa2, bf16x8& pa3) {
#pragma unroll
  for (int r = 0; r < 16; ++r) p1[r] = __builtin_amdgcn_exp2f(p1[r]);
  float ps = 0;
#pragma unroll
  for (int r = 0; r < 16; ++r) ps += p0[r];
#pragma unroll
  for (int r = 0; r < 16; ++r) ps += p1[r];
  { auto rr = __builtin_amdgcn_permlane32_swap(__float_as_uint(ps), __float_as_uint(ps), false, false);
    ps = __uint_as_float(rr[0]) + __uint_as_float(rr[1]); }
  l_reg = l_reg * alpha + ps;
#define PK4(P, BASE, OUT) do { unsigned a0 = cvtpk(P[BASE + 0], P[BASE + 1]), a1 = cvtpk(P[BASE + 2], P[BASE + 3]);   \
    unsigned b0 = cvtpk(P[BASE + 4], P[BASE + 5]), b1 = cvtpk(P[BASE + 6], P[BASE + 7]);                              \
    auto r0 = __builtin_amdgcn_permlane32_swap(a0, b0, false, false); auto r1 = __builtin_amdgcn_permlane32_swap(a1, b1, false, false); \
    u32x4 w = {r0[0], r1[0], r0[1], r1[1]}; OUT = *reinterpret_cast<bf16x8*>(&w); } while (0)
  PK4(p0, 0, pa0); PK4(p0, 8, pa1); PK4(p1, 0, pa2); PK4(p1, 8, pa3);
#undef PK4
}
__device__ __forceinline__ void qkt(f32x16& p0, f32x16& p1, const bf16* Ks, const bf16x8* qr, int r32, int hi, int map) {
  p0 = f32x16{}; p1 = f32x16{};
#pragma unroll
  for (int d0 = 0; d0 < 4; ++d0) { int cb = (map * 64 + d0 * 16 + hi * 8) * 2;
    bf16x8 b0 = *reinterpret_cast<const bf16x8*>((const char*)Ks + KSWZ(r32, cb));
    bf16x8 b1 = *reinterpret_cast<const bf16x8*>((const char*)Ks + KSWZ(32 + r32, cb));
    p0 = __builtin_amdgcn_mfma_f32_32x32x16_bf16(b0, qr[d0], p0, 0, 0, 0);
    p1 = __builtin_amdgcn_mfma_f32_32x32x16_bf16(b1, qr[d0], p1, 0, 0, 0); }
}
__device__ __forceinline__ int v_st(int k, int c) { const int kk = (k & ~0xC) | ((k & 4) << 1) | ((k & 8) >> 1); return ((kk >> 3) * 4 + (c >> 5)) * 512 + ((kk & 7) * 32 + (c & 31)) * 2; }
__device__ __forceinline__ int v_rd_base(int lane) { return ((lane & 3) << 3) | (((lane >> 2) & 3) << 6) | (((lane >> 4) & 1) << 5) | (((lane >> 5) & 1) << 8); }
constexpr int v_rd_off(int d0, int ks, int half) { return d0 * 512 + ks * 4096 + half * 2048; }
template <int OFF> __device__ __forceinline__ s16x4 tr_read(int vb) {
  s16x4 r; asm volatile("ds_read_b64_tr_b16 %0, %1 offset:%2" : "=&v"(r) : "v"(vb), "i"(OFF) : "memory"); return r;
}
template <int D0> __device__ __forceinline__ void pv_one(f32x16& od, int vb, bf16x8 pa0, bf16x8 pa1, bf16x8 pa2, bf16x8 pa3) {
  const s16x4 l0 = tr_read<v_rd_off(D0, 0, 0)>(vb), h0 = tr_read<v_rd_off(D0, 0, 1)>(vb), l1 = tr_read<v_rd_off(D0, 1, 0)>(vb), h1 = tr_read<v_rd_off(D0, 1, 1)>(vb);
  const s16x4 l2 = tr_read<v_rd_off(D0, 2, 0)>(vb), h2 = tr_read<v_rd_off(D0, 2, 1)>(vb), l3 = tr_read<v_rd_off(D0, 3, 0)>(vb), h3 = tr_read<v_rd_off(D0, 3, 1)>(vb);
  asm volatile("s_waitcnt lgkmcnt(0)" ::: "memory"); SBAR();
#define PK(L, H) (bf16x8){L[0], L[1], L[2], L[3], H[0], H[1], H[2], H[3]}
  od = __builtin_amdgcn_mfma_f32_32x32x16_bf16(pa0, PK(l0, h0), od, 0, 0, 0);
  od = __builtin_amdgcn_mfma_f32_32x32x16_bf16(pa1, PK(l1, h1), od, 0, 0, 0);
  od = __builtin_amdgcn_mfma_f32_32x32x16_bf16(pa2, PK(l2, h2), od, 0, 0, 0);
  od = __builtin_amdgcn_mfma_f32_32x32x16_bf16(pa3, PK(l3, h3), od, 0, 0, 0);
#undef PK
}
__device__ __forceinline__ void pv_d0(f32x16* o, int vb, bf16x8 pa0, bf16x8 pa1, bf16x8 pa2, bf16x8 pa3) {
  pv_one<0>(o[0], vb, pa0, pa1, pa2, pa3); pv_one<1>(o[1], vb, pa0, pa1, pa2, pa3); pv_one<2>(o[2], vb, pa0, pa1, pa2, pa3); pv_one<3>(o[3], vb, pa0, pa1, pa2, pa3);
}
__device__ __forceinline__ void attn_unit(const bf16* __restrict__ Qb, const bf16* __restrict__ Kh, const bf16* __restrict__ Vh, bf16* __restrict__ Ob, int seq, float lam, const float* __restrict__ subln, char* lds) {
  constexpr int LDQ = 1024, LDK = 128;
  const int tid = threadIdx.x, wid = tid >> 6, lane = tid & 63, r32 = lane & 31, hi = lane >> 5;
  const int map = wid >> 2, qw = wid & 3;
  bf16* V_lds = (bf16*)lds; bf16* K_lds = (bf16*)(lds + 2 * SHM_V);
  float* ws = (float*)(lds + 2 * SHM_V + 2 * SHM_K) + wid * 64; float* li_l = ws; float* al_l = ws + 32;
  float m_reg = -1e30f, l_reg = 0; f32x16 o[4] = {}; bf16x8 qr[4];
  const bf16* Qw = Qb + (long)(qw * 32 + r32) * LDQ + map * 64 + hi * 8;
#pragma unroll
  for (int d0 = 0; d0 < 4; ++d0) qr[d0] = *reinterpret_cast<const bf16x8*>(Qw + d0 * 16);
  const int sr = tid >> 4, sc = (tid & 15) * 8, vst0 = v_st(sr, sc), vst1 = v_st(32 + sr, sc);
  const int vb0 = (int)(uintptr_t)V_lds + v_rd_base(lane);
  struct { bf16x8 vs0, vs1, ks0, ks1; } sr_[2];
#define LD8(p) (*reinterpret_cast<const bf16x8*>(p))
#define SLOAD(i, k0) do { sr_[i].vs0 = LD8(&Vh[(long)((k0) + sr) * LDK + sc]); sr_[i].vs1 = LD8(&Vh[(long)((k0) + 32 + sr) * LDK + sc]); \
    sr_[i].ks0 = LD8(&Kh[(long)((k0) + sr) * LDK + sc]); sr_[i].ks1 = LD8(&Kh[(long)((k0) + 32 + sr) * LDK + sc]); } while (0)
#define SWRITE(b, i) do { *(bf16x8*)((char*)V_lds + (b) * SHM_V + vst0) = sr_[i].vs0;          \
    *(bf16x8*)((char*)V_lds + (b) * SHM_V + vst1) = sr_[i].vs1; int kc = sc * 2;               \
    *(bf16x8*)((char*)K_lds + (b) * SHM_K + KSWZ(sr, kc)) = sr_[i].ks0;                       \
    *(bf16x8*)((char*)K_lds + (b) * SHM_K + KSWZ(32 + sr, kc)) = sr_[i].ks1; } while (0)
#define SWAIT() asm volatile("s_waitcnt vmcnt(4)" ::: "memory")
#define RESC(a) do { if (__any((a) < 1.f)) { if (hi == 0) al_l[r32] = (a); asm volatile("s_waitcnt lgkmcnt(0)" ::: "memory"); \
    _Pragma("unroll") for (int d = 0; d < 4; ++d) _Pragma("unroll") for (int r = 0; r < 16; ++r) o[d][r] *= al_l[crow(r, hi)]; } } while (0)
  f32x16 pA0, pA1, pB0, pB1; float mnA, mnB, alA, alB; bf16x8 pa0, pa1, pa2, pa3; const int NT = seq / KVBLK;
  constexpr int SE = 0, SO = 1;
  SLOAD(SE, 0); asm volatile("s_waitcnt vmcnt(0)" ::: "memory"); SWRITE(0, SE); __syncthreads();
  qkt(pA0, pA1, K_lds, qr, r32, hi, map); partialSM(pA0, pA1, m_reg, mnA, alA);
  SLOAD(SO, KVBLK); if (2 < NT) SLOAD(SE, 2 * KVBLK);
  SWAIT(); SWRITE(1, SO); __syncthreads();
  for (int j = 1; j + 1 < NT; j += 2) {
    SBAR(); qkt(pB0, pB1, (bf16*)((char*)K_lds + SHM_K), qr, r32, hi, map);
    finishSM(pA0, pA1, alA, l_reg, pa0, pa1, pa2, pa3); SBAR();
    SLOAD(SO, (j + 2) * KVBLK); SBAR();
    pv_d0(o, vb0, pa0, pa1, pa2, pa3); partialSM(pB0, pB1, m_reg, mnB, alB);
    __syncthreads(); SWAIT(); SWRITE(0, SE);
    RESC(alB); __syncthreads();
    SBAR(); qkt(pA0, pA1, K_lds, qr, r32, hi, map);
    finishSM(pB0, pB1, alB, l_reg, pa0, pa1, pa2, pa3); SBAR();
    if (j + 3 < NT) SLOAD(SE, (j + 3) * KVBLK); SBAR();
    pv_d0(o, vb0 + (int)SHM_V, pa0, pa1, pa2, pa3); partialSM(pA0, pA1, m_reg, mnA, alA);
    __syncthreads(); SWAIT(); SWRITE(1, SO);
    RESC(alA); __syncthreads();
  }
  SBAR(); qkt(pB0, pB1, (bf16*)((char*)K_lds + SHM_K), qr, r32, hi, map);
  finishSM(pA0, pA1, alA, l_reg, pa0, pa1, pa2, pa3); SBAR();
  pv_d0(o, vb0, pa0, pa1, pa2, pa3); partialSM(pB0, pB1, m_reg, mnB, alB);
  __syncthreads(); RESC(alB);
  finishSM(pB0, pB1, alB, l_reg, pa0, pa1, pa2, pa3); SBAR();
  pv_d0(o, vb0 + (int)SHM_V, pa0, pa1, pa2, pa3);
  if (hi == 0) li_l[r32] = l_reg; asm volatile("s_waitcnt lgkmcnt(0)" ::: "memory");
  float rli[16];
#pragma unroll
  for (int r = 0; r < 16; ++r) rli[r] = __builtin_amdgcn_rcpf(li_l[crow(r, hi)]);
  __syncthreads();
  int r32e = r32, hie = hi; asm volatile("" : "+v"(r32e), "+v"(hie));
  float* X = (float*)lds;
  if (map == 1) {
#pragma unroll
    for (int r = 0; r < 16; ++r)
#pragma unroll
      for (int d0 = 0; d0 < 4; ++d0) X[(qw * 32 + crow(r, hie)) * 128 + d0 * 32 + r32e] = o[d0][r] * rli[r];
  }
  __syncthreads();
  if (map == 0) {
    float sw[4];
#pragma unroll
    for (int d0 = 0; d0 < 4; ++d0) sw[d0] = subln[d0 * 32 + r32e] * 0.8f;
#pragma unroll
    for (int r = 0; r < 16; ++r) { float val[4]; float ss = 0.f;
#pragma unroll
      for (int d0 = 0; d0 < 4; ++d0) { val[d0] = o[d0][r] * rli[r] - lam * X[(qw * 32 + crow(r, hie)) * 128 + d0 * 32 + r32e]; ss += val[d0] * val[d0]; }
      ss += __shfl_xor(ss, 1); ss += __shfl_xor(ss, 2); ss += __shfl_xor(ss, 4); ss += __shfl_xor(ss, 8); ss += __shfl_xor(ss, 16);
      const float rs = rsqrtf(ss * (1.0f / 128.0f) + 1e-6f);
#pragma unroll
      for (int d0 = 0; d0 < 4; ++d0) ((unsigned short*)Ob)[(d0 >> 1) * 16384 + (pg8::lds_byte(qw * 32 + crow(r, hie), (d0 & 1) * 32 + r32e) >> 1)] = (unsigned short)(cvtpk(val[d0] * rs * sw[d0], 0.f) & 0xffffu); }
  }
  __syncthreads();
#undef LD8
#undef SLOAD
#undef SWRITE
#undef SWAIT
#undef RESC
}
#undef KSWZ
#undef SBAR
}

template <int CTRL> __device__ __forceinline__ float dppf(float v) { return __builtin_bit_cast(float, __builtin_amdgcn_update_dpp(0, __builtin_bit_cast(int, v), CTRL, 0xf, 0xf, true)); }
__device__ __forceinline__ float wave_sum_dpp(float v) {
    v += dppf<0xB1>(v); v += dppf<0x4E>(v); v += dppf<0x141>(v); v += dppf<0x140>(v);
    const int b = __builtin_bit_cast(int, v);
    return __builtin_bit_cast(float, __builtin_amdgcn_readlane(b, 0)) + __builtin_bit_cast(float, __builtin_amdgcn_readlane(b, 16)) + __builtin_bit_cast(float, __builtin_amdgcn_readlane(b, 32)) + __builtin_bit_cast(float, __builtin_amdgcn_readlane(b, 48));
}
namespace gdn {
using bf16x8 = __attribute__((ext_vector_type(8))) short;
constexpr int TS = 272;
constexpr int OFF_Q = 0, OFF_K = 64 * TS, OFF_V = 2 * 64 * TS, OFF_KK = 3 * 64 * TS, OFF_QK = OFF_KK + 64 * 65 * 4, OFF_L = OFF_QK + 64 * 65 * 4, LSTR = 68,
              OFF_VEC = OFF_L + 2 * 64 * LSTR * 4,
              OFF_D = OFF_KK, DSTR = 20;
static_assert(8 * 16 * DSTR * 4 <= 64 * 65 * 4 && OFF_VEC + 6 * 64 * 4 <= 131072, "gdn lds");
__device__ __forceinline__ void seq_info(int s, int& rowbase, int& L) { if (s < 16) { rowbase = s * 256; L = 256; } else { rowbase = NPROMPT + (s - 16) * 1024; L = 1024; } }
__device__ __forceinline__ int chunk_id(int s, int h, int c) { return s < 16 ? ((s * 8 + h) * 4 + c) : 512 + (((s - 16) * 8 + h) * 16 + c); }

__device__ __forceinline__ void cl_load(Frame& F, int s, int h, int c, unsigned (&raw)[3][12], float (&abv)[2]) {
    const bf16* QKVB = (const bf16*)(F.ws + WS_QKVB); const float* AB = (const float*)(F.ws + WS_AB);
    int rowbase, L; seq_info(s, rowbase, L);
    int lane = F.lane; asm volatile("" : "+v"(lane)); const int wid = F.wave; const int tok0 = 8 * wid;
    const unsigned lo = (unsigned)(lane >> 5) * 32768u + (unsigned)((lane >> 4) & 1) * 1024u + 4u * (unsigned)(lane & 15);
#pragma unroll
    for (int j = 0; j < 12; ++j) { const int t = c * 64 + tok0 - 2 + j; const bool ok = (t >= 0) && (t < L); const int R = rowbase + (ok ? t : 0);
        const unsigned char* ubp = (const unsigned char*)QKVB + ((size_t)(R >> 8) * 48 + 2 * h) * 32768 + ((R >> 7) & 1) * 16384 + ((R & 127) >> 4) * 2048 + (R & 15) * 64;
#pragma unroll
        for (int x = 0; x < 3; ++x) raw[x][j] = ok ? *(const unsigned*)(ubp + (size_t)x * 16 * 32768 + lo) : 0u; }
    abv[0] = 0.f; abv[1] = 0.f;
    if (wid < 2) { const size_t row = (size_t)rowbase + c * 64 + lane; abv[0] = AB[row * 32 + wid * 8 + h]; abv[1] = AB[row * 32 + 16 + wid * 8 + h]; }
}
__device__ __forceinline__ void chunk_local(Frame& F, int s, int h, int c, unsigned (&raw)[3][12], float (&abv)[2], bool has_next, int ns, int nh, int nc) {
    const bf16* QKVB = (const bf16*)(F.ws + WS_QKVB); const float* AB = (const float*)(F.ws + WS_AB);
    const float* conv_w = F.inp[11]; const float* a_log = F.inp[12]; const float* dt_bias = F.inp[13];
    bf16* QHAT = (bf16*)(F.ws + WS_QHAT); bf16* KHT = (bf16*)(F.ws + WS_KHT); bf16* NWg = (bf16*)(F.ws + WS_NW); bf16* Ug = (bf16*)(F.ws + WS_U); bf16* INTRA = (bf16*)(F.ws + WS_INTRA);
    float* EVEC = (float*)(F.ws + WS_EVEC);
    int rowbase, L; seq_info(s, rowbase, L); const int cid = chunk_id(s, h, c);
    int tid = F.tid, lane = F.lane; const int wid = F.wave; asm volatile("" : "+v"(tid), "+v"(lane));
    LAS unsigned char* lds = F.lds;
    LAS float* vec = (LAS float*)(lds + OFF_VEC);
    {
        const int tok0 = 8 * wid;
        float cw[3][5][2];
#pragma unroll
        for (int x = 0; x < 3; ++x)
#pragma unroll
            for (int j = 0; j < 5; ++j) { const float* p = conv_w + j * 3072 + x * 1024 + h * 128 + 2 * lane; cw[x][j][0] = p[0]; cw[x][j][1] = p[1]; }
        unsigned kt[2][4];
        float val[8][3][2]; float sv[16];
#pragma unroll
        for (int tt = 0; tt < 8; ++tt) {
#pragma unroll
            for (int x = 0; x < 3; ++x) { pg8::f32x2 a2 = {0.f, 0.f};
#pragma unroll
                for (int j = 0; j < 5; ++j) { const pg8::f32x2 w2_ = {cw[x][j][0], cw[x][j][1]}; const pg8::f32x2 r2_ = {bflo(raw[x][tt + j]), bfhi(raw[x][tt + j])}; a2 = __builtin_elementwise_fma(w2_, r2_, a2); }
                val[tt][x][0] = silu_f(a2.x); val[tt][x][1] = silu_f(a2.y); }
            sv[tt] = val[tt][0][0] * val[tt][0][0] + val[tt][0][1] * val[tt][0][1];
            sv[8 + tt] = val[tt][1][0] * val[tt][1][0] + val[tt][1][1] * val[tt][1][1];
        }
        float tot[16];
        {
            float w8[8], u4[4];
#pragma unroll
            for (int i = 0; i < 8; ++i) { const auto r = __builtin_amdgcn_permlane32_swap(__builtin_bit_cast(unsigned, sv[i]), __builtin_bit_cast(unsigned, sv[i + 8]), false, false);
                const unsigned r0 = r[0], r1 = r[1]; w8[i] = __builtin_bit_cast(float, r0) + __builtin_bit_cast(float, r1); }
#pragma unroll
            for (int i = 0; i < 4; ++i) { const auto r = __builtin_amdgcn_permlane16_swap(__builtin_bit_cast(unsigned, w8[i]), __builtin_bit_cast(unsigned, w8[i + 4]), false, false);
                const unsigned r0 = r[0], r1 = r[1]; float v = __builtin_bit_cast(float, r0) + __builtin_bit_cast(float, r1);
                v += dppf<0xB1>(v); v += dppf<0x4E>(v); v += dppf<0x141>(v); v += dppf<0x140>(v); u4[i] = v; }
#pragma unroll
            for (int r = 0; r < 4; ++r)
#pragma unroll
                for (int i = 0; i < 4; ++i) tot[i + 4 * (r & 1) + 8 * (r >> 1)] = __builtin_bit_cast(float, __builtin_amdgcn_readlane(__builtin_bit_cast(int, u4[i]), 16 * r));
        }
#pragma unroll
        for (int tt = 0; tt < 8; ++tt) {
            const float rq = rsqrtf(tot[tt] + EPS) * 0.08838834764831845f, rk = rsqrtf(tot[8 + tt] + EPS);
            const unsigned qw_ = cvtpk(val[tt][0][0] * rq, val[tt][0][1] * rq), kw_ = cvtpk(val[tt][1][0] * rk, val[tt][1][1] * rk), vw_ = cvtpk(val[tt][2][0], val[tt][2][1]);
            const int tok = tok0 + tt;
            *(LAS unsigned*)(lds + OFF_Q + tok * TS + 4 * lane) = qw_;
            *(LAS unsigned*)(lds + OFF_K + tok * TS + 4 * lane) = kw_;
            *(LAS unsigned*)(lds + OFF_V + tok * TS + 4 * lane) = vw_;
            *(unsigned*)(QHAT + ((size_t)cid * 64 + tok) * 128 + 2 * lane) = qw_;
            if (tt & 1) { kt[0][tt >> 1] |= (kw_ << 16); kt[1][tt >> 1] |= (kw_ & 0xffff0000u); } else { kt[0][tt >> 1] = kw_ & 0xffffu; kt[1][tt >> 1] = kw_ >> 16; }
        }
#pragma unroll
        for (int e = 0; e < 2; ++e) { v4u w; w.x = kt[e][0]; w.y = kt[e][1]; w.z = kt[e][2]; w.w = kt[e][3];
            *(GAS v4u*)(KHT + ((size_t)cid * 128 + 2 * lane + e) * 64 + tok0) = w; }
    }
    if (wid < 2) {
        const int dir = wid, tok = lane; const size_t row = (size_t)rowbase + c * 64 + tok;
        const float a = abv[0], b = abv[1];
        const float xs = a + dt_bias[dir * 8 + h];
        const float sp = xs > 20.f ? xs : log1pf(__expf(xs));
        const float g = -__expf(a_log[dir * 8 + h]) * sp;
        const float beta = 1.0f / (1.0f + __expf(-b));
        float G = g;
        if (dir == 0) {
#pragma unroll
            for (int o = 1; o < 64; o <<= 1) { const float t = __shfl_up(G, o); if (lane >= o) G += t; }
        } else {
#pragma unroll
            for (int o = 1; o < 64; o <<= 1) { const float t = __shfl_down(G, o); if (lane + o < 64) G += t; }
        }
        const float gl = __shfl(G, dir == 0 ? 63 : 0);
        const float eG = __expf(G);
        vec[dir * 64 + tok] = beta; vec[128 + dir * 64 + tok] = G; vec[256 + dir * 64 + tok] = beta * eG;
        float* ev = EVEC + ((size_t)cid * 2 + dir) * 192;
        ev[tok] = eG; ev[64 + tok] = __expf(gl - G); if (lane == 0) ev[128] = __expf(gl);
    }
    if (has_next) cl_load(F, ns, nh, nc, raw, abv);
    LBAR();
    {
        const int r32 = lane & 31, hi = lane >> 5; const int mat = wid >> 2, bi = (wid >> 1) & 1, bj = wid & 1;
        const LAS unsigned char* ap = lds + (mat ? OFF_Q : OFF_K) + (32 * bi + r32) * TS + 16 * hi;
        const LAS unsigned char* bp = lds + OFF_K + (32 * bj + r32) * TS + 16 * hi;
        f32x16 acc = {};
#pragma unroll
        for (int st = 0; st < 8; ++st) { const bf16x8 a = *(const LAS bf16x8*)(ap + 32 * st), b = *(const LAS bf16x8*)(bp + 32 * st); acc = __builtin_amdgcn_mfma_f32_32x32x16_bf16(a, b, acc, 0, 0, 0); }
        LAS float* dst = (LAS float*)(lds + (mat ? OFF_QK : OFF_KK));
#pragma unroll
        for (int r = 0; r < 16; ++r) dst[(32 * bi + crow(r, hi)) * 65 + 32 * bj + r32] = acc[r];
    }
    LBAR();
    {
        const int dir = tid >> 8, i = (tid >> 2) & 63, j0 = (tid & 3) * 16;
        const LAS float* KKm = (const LAS float*)(lds + OFF_KK); const LAS float* QKm = (const LAS float*)(lds + OFF_QK);
        LAS float* Lm = (LAS float*)(lds + OFF_L) + dir * 64 * LSTR;
        const float bi_ = vec[dir * 64 + i], Gi = vec[128 + dir * 64 + i];
        unsigned iw[8];
#pragma unroll
        for (int jj = 0; jj < 16; ++jj) { const int j = j0 + jj; const float Gj = vec[128 + dir * 64 + j];
            const bool strict = dir ? (j > i) : (j < i); const bool incl = strict || (j == i);
            const float dec = incl ? __expf(Gi - Gj) : 0.f;
            const float lv = strict ? bi_ * KKm[i * 65 + j] * dec : 0.f;
            const float iv = QKm[i * 65 + j] * dec;
            if (dir) Lm[(63 - i) * LSTR + (63 - j)] = lv; else Lm[i * LSTR + j] = lv;
            const unsigned short bv = (unsigned short)(cvtpk(iv, 0.f) & 0xffffu);
            if (jj & 1) iw[jj >> 1] |= ((unsigned)bv << 16); else iw[jj >> 1] = bv; }
        bf16* ip = INTRA + (((size_t)cid * 2 + dir) * 64 + i) * 64 + j0;
        v4u w0, w1; w0.x = iw[0]; w0.y = iw[1]; w0.z = iw[2]; w0.w = iw[3]; w1.x = iw[4]; w1.y = iw[5]; w1.z = iw[6]; w1.w = iw[7];
        *(GAS v4u*)ip = w0; *(GAS v4u*)(ip + 8) = w1;
    }
    LBAR();
    if (tid < 128) {
        const int dir = tid >> 6, b = (tid >> 4) & 3, cidx = tid & 15;
        const LAS float* Lb = (const LAS float*)(lds + OFF_L) + dir * 64 * LSTR + (16 * b) * LSTR + 16 * b;
        LAS float* Dm = (LAS float*)(lds + OFF_D) + (dir * 4 + b) * 16 * DSTR;
        float d[16];
#pragma unroll
        for (int i = 0; i < 16; ++i) { float a = (i == cidx) ? 1.f : 0.f;
#pragma unroll
            for (int j = 0; j < i; ++j) a -= Lb[i * LSTR + j] * d[j];
            d[i] = a; Dm[i * DSTR + cidx] = a; }
    }
    LBAR();
    {
        const int dir = wid >> 2, wq = wid & 3; const bool isK = wq >= 2; const int cb = (wq & 1) * 64;
        const int n = lane & 15, g = lane >> 4;
        const LAS float* Lm = (const LAS float*)(lds + OFF_L) + dir * 64 * LSTR;
        const LAS float* Dall = (const LAS float*)(lds + OFF_D) + dir * 4 * 16 * DSTR;
        const LAS unsigned char* tile = lds + (isK ? OFF_K : OFF_V);
        const LAS float* scl = vec + (isK ? 256 : 0) + dir * 64;
        bf16* og = (isK ? NWg : Ug) + ((size_t)cid * 2 + dir) * 64 * 128;
        const float sgn = isK ? -1.f : 1.f;
        LAS unsigned char* stg = lds + OFF_Q + wid * 2176;
        u32x2 Xf[3][4];
#pragma unroll
        for (int b = 0; b < 4; ++b) {
            f32x4 R[4];
#pragma unroll
            for (int r = 0; r < 4; ++r) { const int p = 16 * b + 4 * g + r; const int tok = dir ? 63 - p : p; const float sc_ = scl[tok];
#pragma unroll
                for (int nt = 0; nt < 4; ++nt) R[nt][r] = bf2f(*(const LAS unsigned short*)(tile + tok * TS + 2 * (cb + 16 * nt + n))) * sc_; }
#pragma unroll
            for (int pr = 0; pr < 2; ++pr) if (2 * pr < b) {
                const int a0 = 2 * pr, a1 = 2 * pr + 1; const bool two = a1 < b;
                const f32x4 l0 = *(const LAS f32x4*)(Lm + (16 * b + n) * LSTR + 16 * a0 + 4 * g);
                f32x4 l1 = {0.f, 0.f, 0.f, 0.f}; if (two) l1 = *(const LAS f32x4*)(Lm + (16 * b + n) * LSTR + 16 * a1 + 4 * g);
                v4u aw; aw.x = cvtpk(-l0[0], -l0[1]); aw.y = cvtpk(-l0[2], -l0[3]); aw.z = cvtpk(-l1[0], -l1[1]); aw.w = cvtpk(-l1[2], -l1[3]);
                const bf16x8 af = __builtin_bit_cast(bf16x8, aw);
#pragma unroll
                for (int nt = 0; nt < 4; ++nt) { v4u bw; bw.x = Xf[a0][nt].x; bw.y = Xf[a0][nt].y; bw.z = two ? Xf[a1 < 3 ? a1 : 2][nt].x : 0u; bw.w = two ? Xf[a1 < 3 ? a1 : 2][nt].y : 0u;
                    R[nt] = __builtin_amdgcn_mfma_f32_16x16x32_bf16(af, __builtin_bit_cast(bf16x8, bw), R[nt], 0, 0, 0); }
            }
            const f32x4 df = *(const LAS f32x4*)(Dall + b * 16 * DSTR + n * DSTR + 4 * g);
            v4u dw; dw.x = cvtpk(df[0], df[1]); dw.y = cvtpk(df[2], df[3]); dw.z = 0u; dw.w = 0u;
            const bf16x8 dfr = __builtin_bit_cast(bf16x8, dw);
#pragma unroll
            for (int nt = 0; nt < 4; ++nt) {
                v4u rw; rw.x = cvtpk(R[nt][0], R[nt][1]); rw.y = cvtpk(R[nt][2], R[nt][3]); rw.z = 0u; rw.w = 0u;
                const f32x4 xb = __builtin_amdgcn_mfma_f32_16x16x32_bf16(dfr, __builtin_bit_cast(bf16x8, rw), (f32x4){0.f, 0.f, 0.f, 0.f}, 0, 0, 0);
                if (b < 3) { Xf[b][nt].x = cvtpk(xb[0], xb[1]); Xf[b][nt].y = cvtpk(xb[2], xb[3]); }
#pragma unroll
                for (int r = 0; r < 4; ++r) *(LAS unsigned short*)(stg + (4 * g + r) * 136 + 2 * (16 * nt + n)) = (unsigned short)(cvtpk(xb[r] * sgn, 0.f) & 0xffffu);
            }
            asm volatile("s_waitcnt lgkmcnt(0)" ::: "memory");
#pragma unroll
            for (int q = 0; q < 2; ++q) { const int piece = lane + 64 * q, lr = piece >> 3, ch = piece & 7; const int p = 16 * b + lr; const int tok = dir ? 63 - p : p;
                const u32x2 lo_ = *(const LAS u32x2*)(stg + lr * 136 + 16 * ch), hi_ = *(const LAS u32x2*)(stg + lr * 136 + 16 * ch + 8);
                v4u w; w.x = lo_.x; w.y = lo_.y; w.z = hi_.x; w.w = hi_.y;
                *(GAS v4u*)(og + tok * 128 + cb + 8 * ch) = w; }
            asm volatile("s_waitcnt lgkmcnt(0)" ::: "memory");
        }
    }
    LBAR();
}
}

namespace gscan {
using bf16x8 = __attribute__((ext_vector_type(8))) short;
constexpr int S128 = 264, S64 = 136;
constexpr int O_NW = 0, O_QH = 64 * S128, O_KHT = 2 * 64 * S128, O_IN = O_KHT + 128 * S64, O_EV = O_IN + 64 * S64, BUF = O_EV + 192 * 4;
static_assert(2 * BUF <= 131072 && (BUF % 8) == 0, "scan lds");
__device__ __forceinline__ bf16x8 afrag(const LAS unsigned char* p) { const u32x2 a = *(const LAS u32x2*)p, b = *(const LAS u32x2*)(p + 16); v4u w; w.x = a.x; w.y = a.y; w.z = b.x; w.w = b.y; return __builtin_bit_cast(bf16x8, w); }
__device__ __forceinline__ bf16x8 pack8(const f32x16& v, int s) { v4u w; w.x = cvtpk(v[8 * s + 0], v[8 * s + 1]); w.y = cvtpk(v[8 * s + 2], v[8 * s + 3]); w.z = cvtpk(v[8 * s + 4], v[8 * s + 5]); w.w = cvtpk(v[8 * s + 6], v[8 * s + 7]); return __builtin_bit_cast(bf16x8, w); }

#define SC_LOAD(T0, T1, T2, T3, EV, cid_) do { const int cidl_ = (cid_); const size_t cid2l_ = (size_t)cidl_ * 2 + dir; \
    _Pragma("unroll") for (int i_ = 0; i_ < 4; ++i_) { const int q_ = lt + 256 * i_; T0[i_] = *(const GAS v4u*)(NWg + cid2l_ * 8192 + (size_t)q_ * 8); T1[i_] = *(const GAS v4u*)(QHAT + (size_t)cidl_ * 8192 + (size_t)q_ * 8); T2[i_] = *(const GAS v4u*)(KHT + (size_t)cidl_ * 8192 + (size_t)q_ * 8); } \
    _Pragma("unroll") for (int i_ = 0; i_ < 2; ++i_) { const int q_ = lt + 256 * i_; T3[i_] = *(const GAS v4u*)(INTRA + cid2l_ * 4096 + (size_t)q_ * 8); } \
    EV = 0.f; if (lt < 192) EV = EVEC[cid2l_ * 192 + lt]; } while (0)
#define SC_WRITE(T0, T1, T2, T3, EV, b_) do { LAS unsigned char* Bw_ = lds + (b_) * BUF; \
    _Pragma("unroll") for (int i_ = 0; i_ < 4; ++i_) { const int q_ = lt + 256 * i_; const int r128_ = q_ >> 4, c128_ = q_ & 15, r64_ = q_ >> 3, c64_ = q_ & 7; \
        LAS unsigned char* d0_ = Bw_ + O_NW + r128_ * S128 + c128_ * 16; *(LAS u32x2*)d0_ = (u32x2){T0[i_].x, T0[i_].y}; *(LAS u32x2*)(d0_ + 8) = (u32x2){T0[i_].z, T0[i_].w}; \
        LAS unsigned char* d1_ = Bw_ + O_QH + r128_ * S128 + c128_ * 16; *(LAS u32x2*)d1_ = (u32x2){T1[i_].x, T1[i_].y}; *(LAS u32x2*)(d1_ + 8) = (u32x2){T1[i_].z, T1[i_].w}; \
        LAS unsigned char* d2_ = Bw_ + O_KHT + r64_ * S64 + c64_ * 16;  *(LAS u32x2*)d2_ = (u32x2){T2[i_].x, T2[i_].y}; *(LAS u32x2*)(d2_ + 8) = (u32x2){T2[i_].z, T2[i_].w}; } \
    _Pragma("unroll") for (int i_ = 0; i_ < 2; ++i_) { const int q_ = lt + 256 * i_; const int r64_ = q_ >> 3, c64_ = q_ & 7; \
        LAS unsigned char* d3_ = Bw_ + O_IN + r64_ * S64 + c64_ * 16; *(LAS u32x2*)d3_ = (u32x2){T3[i_].x, T3[i_].y}; *(LAS u32x2*)(d3_ + 8) = (u32x2){T3[i_].z, T3[i_].w}; } \
    if (lt < 192) *(LAS float*)(Bw_ + O_EV + 4 * lt) = EV; } while (0)
#define SC_ULOAD(UR, cid_) do { const unsigned short* up_ = (const unsigned short*)Ug + ((size_t)(cid_) * 2 + dir) * 8192 + (size_t)(4 * hi * 128 + n0 + r32); \
    _Pragma("unroll") for (int ib_ = 0; ib_ < 2; ++ib_) _Pragma("unroll") for (int r_ = 0; r_ < 16; ++r_) UR[ib_][r_] = up_[(32 * ib_ + (r_ & 3) + 8 * (r_ >> 2)) * 128]; } while (0)
#define SC_STEP(UR, b_, c_) do { const LAS unsigned char* B = lds + (b_) * BUF; \
    const LAS float* ev = (const LAS float*)(B + O_EV); \
    f32x16 vn[2] = {f32x16{}, f32x16{}}, qs[2] = {f32x16{}, f32x16{}}; \
    bf16x8 fa[4], fb[4]; \
      \
    _Pragma("unroll") for (int ib = 0; ib < 2; ++ib) { fa[ib] = afrag(B + O_NW + (32 * ib + r32) * S128 + (4 * hi) * 2); fa[2 + ib] = afrag(B + O_QH + (32 * ib + r32) * S128 + (4 * hi) * 2); } \
    _Pragma("unroll") for (int it = 0; it < 8; ++it) { const int mb = it >> 1, st = it & 1; \
        if (it + 1 < 8) { const int koffn = (32 * ((it + 1) >> 1) + 16 * ((it + 1) & 1) + 4 * hi) * 2; \
            _Pragma("unroll") for (int ib = 0; ib < 2; ++ib) { fb[ib] = afrag(B + O_NW + (32 * ib + r32) * S128 + koffn); fb[2 + ib] = afrag(B + O_QH + (32 * ib + r32) * S128 + koffn); } } \
        const bf16x8 sb = pack8(S[mb], st); \
        __builtin_amdgcn_sched_barrier(0); \
        _Pragma("unroll") for (int ib = 0; ib < 2; ++ib) { vn[ib] = __builtin_amdgcn_mfma_f32_32x32x16_bf16(fa[ib], sb, vn[ib], 0, 0, 0); qs[ib] = __builtin_amdgcn_mfma_f32_32x32x16_bf16(fa[2 + ib], sb, qs[ib], 0, 0, 0); } \
        __builtin_amdgcn_sched_barrier(0); \
        _Pragma("unroll") for (int q_ = 0; q_ < 4; ++q_) fa[q_] = fb[q_]; } \
      \
    _Pragma("unroll") for (int ib = 0; ib < 2; ++ib) fa[ib] = afrag(B + O_IN + (32 * ib + r32) * S64 + (4 * hi) * 2); \
    _Pragma("unroll") for (int ib = 0; ib < 2; ++ib) _Pragma("unroll") for (int r = 0; r < 16; ++r) { vn[ib][r] += bf2f(UR[ib][r]); qs[ib][r] *= ev[32 * ib + crow(r, hi)]; } \
      \
    _Pragma("unroll") for (int it = 0; it < 4; ++it) { const int jb = it >> 1, st = it & 1; \
        if (it + 1 < 4) { const int koffn = (32 * ((it + 1) >> 1) + 16 * ((it + 1) & 1) + 4 * hi) * 2; \
            _Pragma("unroll") for (int ib = 0; ib < 2; ++ib) fb[ib] = afrag(B + O_IN + (32 * ib + r32) * S64 + koffn); } \
        else { _Pragma("unroll") for (int mb = 0; mb < 4; ++mb) fb[mb] = afrag(B + O_KHT + (32 * mb + r32) * S64 + (4 * hi) * 2); }     \
        const bf16x8 vb = pack8(vn[jb], st); \
        __builtin_amdgcn_sched_barrier(0); \
        _Pragma("unroll") for (int ib = 0; ib < 2; ++ib) qs[ib] = __builtin_amdgcn_mfma_f32_32x32x16_bf16(fa[ib], vb, qs[ib], 0, 0, 0); \
        __builtin_amdgcn_sched_barrier(0); \
        if (it + 1 < 4) { fa[0] = fb[0]; fa[1] = fb[1]; } else { _Pragma("unroll") for (int q_ = 0; q_ < 4; ++q_) fa[q_] = fb[q_]; } } \
      \
    const float egl = ev[128]; \
    _Pragma("unroll") for (int mb = 0; mb < 4; ++mb) S[mb] *= egl; \
    _Pragma("unroll") for (int jb = 0; jb < 2; ++jb) _Pragma("unroll") for (int r = 0; r < 16; ++r) vn[jb][r] *= ev[64 + 32 * jb + crow(r, hi)]; \
    _Pragma("unroll") for (int it = 0; it < 4; ++it) { const int jb = it >> 1, st = it & 1; \
        if (it + 1 < 4) { const int koffn = (32 * ((it + 1) >> 1) + 16 * ((it + 1) & 1) + 4 * hi) * 2; \
            _Pragma("unroll") for (int mb = 0; mb < 4; ++mb) fb[mb] = afrag(B + O_KHT + (32 * mb + r32) * S64 + koffn); } \
        const bf16x8 vb = pack8(vn[jb], st); \
        __builtin_amdgcn_sched_barrier(0); \
        _Pragma("unroll") for (int mb = 0; mb < 4; ++mb) S[mb] = __builtin_amdgcn_mfma_f32_32x32x16_bf16(fa[mb], vb, S[mb], 0, 0, 0); \
        __builtin_amdgcn_sched_barrier(0); \
        _Pragma("unroll") for (int q_ = 0; q_ < 4; ++q_) fa[q_] = fb[q_]; } \
    unsigned short* op = (unsigned short*)OS + (size_t)(rowbase + 64 * (c_)) * 1024 + (size_t)(4 * hi * 1024 + h * 128 + n0 + r32); \
    _Pragma("unroll") for (int ib = 0; ib < 2; ++ib) _Pragma("unroll") for (int r = 0; r < 16; ++r) op[(32 * ib + (r & 3) + 8 * (r >> 2)) * 1024] = (unsigned short)(cvtpk(qs[ib][r], 0.f) & 0xffffu); } while (0)

__device__ __forceinline__ void scan_item(Frame& F, int s, int h, int dir) {
    const bf16* QHAT = (const bf16*)(F.ws + WS_QHAT); const bf16* KHT = (const bf16*)(F.ws + WS_KHT); const bf16* NWg = (const bf16*)(F.ws + WS_NW); const bf16* Ug = (const bf16*)(F.ws + WS_U);
    const bf16* INTRA = (const bf16*)(F.ws + WS_INTRA); const float* EVEC = (const float*)(F.ws + WS_EVEC);
    bf16* OS = dir ? (bf16*)((unsigned char*)F.out + YO_OB) : (bf16*)(F.ws + WS_OF);
    int rowbase, L; gdn::seq_info(s, rowbase, L); const int n = L / 64;
    const int wid = F.wave; int tid = F.tid, lane = F.lane; asm volatile("" : "+v"(tid), "+v"(lane));
    const int r32 = lane & 31, hi = lane >> 5; const int lt = tid - 256;
    LAS unsigned char* lds = F.lds;
    const bool loader = wid >= 4;
    const int n0 = 32 * (wid & 3);
#define SC_CID(j_) gdn::chunk_id(s, h, dir ? n - 1 - (j_) : (j_))
    if (loader) {
        v4u a0[4], a1[4], a2[4], a3[2], b0[4], b1[4], b2[4], b3[2]; float aev, bev;
        SC_LOAD(a0, a1, a2, a3, aev, SC_CID(0)); SC_WRITE(a0, a1, a2, a3, aev, 0);
        SC_LOAD(a0, a1, a2, a3, aev, SC_CID(1)); SC_LOAD(b0, b1, b2, b3, bev, SC_CID(2));
        LBAR();
        for (int i = 0; i < n; i += 2) {
            SC_WRITE(a0, a1, a2, a3, aev, 1);
            SC_LOAD(a0, a1, a2, a3, aev, SC_CID(i + 3 < n ? i + 3 : n - 1));
            LBAR();
            SC_WRITE(b0, b1, b2, b3, bev, 0);
            SC_LOAD(b0, b1, b2, b3, bev, SC_CID(i + 4 < n ? i + 4 : n - 1));
            LBAR();
        }
    } else {
        f32x16 S[4];
        if (s >= 16) { const float* sd = F.inp[4] + (((size_t)(s - 16) * 2 + dir) * 8 + h) * 16384 + (size_t)(4 * hi * 128 + n0 + r32);
#pragma unroll
            for (int mb = 0; mb < 4; ++mb)
#pragma unroll
                for (int r = 0; r < 16; ++r) S[mb][r] = sd[(32 * mb + (r & 3) + 8 * (r >> 2)) * 128];
        } else {
#pragma unroll
            for (int mb = 0; mb < 4; ++mb) S[mb] = f32x16{};
        }
        unsigned short ua[2][16], ub[2][16];
        SC_ULOAD(ua, SC_CID(0)); SC_ULOAD(ub, SC_CID(1));
        LBAR();
        for (int i = 0; i < n; i += 2) {
            SC_STEP(ua, 0, dir ? n - 1 - i : i);
            SC_ULOAD(ua, SC_CID(i + 2 < n ? i + 2 : n - 1));
            LBAR();
            SC_STEP(ub, 1, dir ? n - 2 - i : i + 1);
            SC_ULOAD(ub, SC_CID(i + 3 < n ? i + 3 : n - 1));
            LBAR();
        }
        if (s < 16) { float* so = F.out + OUT_S + (((size_t)s * 2 + dir) * 8 + h) * 16384 + (size_t)(4 * hi * 128 + n0 + r32);
#pragma unroll
            for (int mb = 0; mb < 4; ++mb)
#pragma unroll
                for (int r = 0; r < 16; ++r) so[(32 * mb + (r & 3) + 8 * (r >> 2)) * 128] = S[mb][r]; }
    }
#undef SC_CID
}
}

__device__ __forceinline__ void gdn_finalize(Frame& F, int row0, int nrows, int h) {
    const bf16* OFw = (const bf16*)(F.ws + WS_OF); const bf16* OBw = (const bf16*)((unsigned char*)F.out + YO_OB); const bf16* GATE = (const bf16*)((unsigned char*)F.out + YO_GATE);
    bf16* MIX = (bf16*)(F.ws + WS_MIX); const float* dn = F.inp[14];
    int lane = F.lane; asm volatile("" : "+v"(lane));
    const int tg = lane >> 3, cs = lane & 7; const int c0 = h * 128 + 16 * cs;
    float nw[16];
#pragma unroll
    for (int e = 0; e < 16; ++e) nw[e] = dn[16 * cs + e];
    const int npass = nrows >> 6;
    int row = row0 + 8 * F.wave + tg;
    for (int it0 = 0; it0 < npass; it0 += 4, row += 256) {
        v4u va[4][2], vb[4][2], vg[4][2];
#pragma unroll
        for (int u = 0; u < 4; ++u)
#pragma unroll
            for (int q = 0; q < 2; ++q) { const size_t off = (size_t)(row + 64 * u) * 1024 + c0 + 8 * q; va[u][q] = *(const GAS v4u*)(OFw + off); vb[u][q] = *(const GAS v4u*)(OBw + off); vg[u][q] = *(const GAS v4u*)(GATE + off); }
#pragma unroll
        for (int u = 0; u < 4; ++u) {
            float o[16], g[16]; float ss = 0.f;
#pragma unroll
            for (int q = 0; q < 2; ++q) { const unsigned aw[4] = {va[u][q].x, va[u][q].y, va[u][q].z, va[u][q].w}, bw[4] = {vb[u][q].x, vb[u][q].y, vb[u][q].z, vb[u][q].w}, gw_[4] = {vg[u][q].x, vg[u][q].y, vg[u][q].z, vg[u][q].w};
#pragma unroll
                for (int e = 0; e < 4; ++e) { o[8 * q + 2 * e] = bflo(aw[e]) + bflo(bw[e]); o[8 * q + 2 * e + 1] = bfhi(aw[e]) + bfhi(bw[e]); g[8 * q + 2 * e] = bflo(gw_[e]); g[8 * q + 2 * e + 1] = bfhi(gw_[e]); } }
#pragma unroll
            for (int e = 0; e < 16; ++e) ss += o[e] * o[e];
            ss += __shfl_xor(ss, 1); ss += __shfl_xor(ss, 2); ss += __shfl_xor(ss, 4);
            const float rs = rsqrtf(ss * (1.0f / 128.0f) + EPS);
            v4u w0, w1; unsigned ww[8];
#pragma unroll
            for (int e = 0; e < 8; ++e) ww[e] = cvtpk(o[2 * e] * rs * nw[2 * e] * silu_f(g[2 * e]), o[2 * e + 1] * rs * nw[2 * e + 1] * silu_f(g[2 * e + 1]));
            w0.x = ww[0]; w0.y = ww[1]; w0.z = ww[2]; w0.w = ww[3]; w1.x = ww[4]; w1.y = ww[5]; w1.z = ww[6]; w1.w = ww[7];
            const int rg_ = row + 64 * u;
            bf16* mo = MIX + (size_t)((rg_ >> 8) * 32 + 16 + 2 * h + (cs >> 2)) * 16384 + ((rg_ >> 7) & 1) * 8192;
            *(GAS v4u*)(mo + (pg8::lds_byte(rg_ & 127, 16 * (cs & 3)) >> 1)) = w0; *(GAS v4u*)(mo + (pg8::lds_byte(rg_ & 127, 16 * (cs & 3) + 8) >> 1)) = w1;
        }
    }
}
__device__ __forceinline__ void pair_sync(unsigned* mine, unsigned* theirs) {
    asm volatile("s_waitcnt vmcnt(0)" ::: "memory");
    __syncthreads();
    if (threadIdx.x == 0) {
        const bool same_xcc = __hip_atomic_load(theirs + 1, __ATOMIC_RELAXED, __HIP_MEMORY_SCOPE_AGENT) == xb_xcc_id() + 1u;
        if (!same_xcc) { __builtin_amdgcn_fence(__ATOMIC_RELEASE, "agent"); asm volatile("s_waitcnt vmcnt(0)" ::: "memory"); }
        __hip_atomic_store(mine, 1u, __ATOMIC_RELAXED, __HIP_MEMORY_SCOPE_AGENT);
        unsigned sp = 0u;
        while (__hip_atomic_load(theirs, __ATOMIC_RELAXED, __HIP_MEMORY_SCOPE_AGENT) == 0u) { __builtin_amdgcn_s_sleep(1); if (++sp > (1u << 22)) break; }
        __builtin_amdgcn_fence(__ATOMIC_ACQUIRE, "agent"); asm volatile("s_waitcnt vmcnt(0)" ::: "memory");
    }
    __syncthreads();
}
constexpr int N_PHASES = 10;
#ifndef MK_N_LAUNCHES
#define MK_N_LAUNCHES 1
#endif
constexpr int N_LAUNCHES = MK_N_LAUNCHES;
struct Args { const float* in[22]; float* out; unsigned char* ws; int ph_lo, ph_hi, li, pad; };
__global__ void __launch_bounds__(NWAVES * 64, 2) mega_fwd(Args args) {
    extern __shared__ __attribute__((aligned(16))) unsigned char lds[];
    Frame F;
    F.lds = (LAS unsigned char*)lds; F.ldsg = lds;
    F.MISC = (volatile LAS unsigned*)(F.lds + MISC_OFF);
    F.tid = threadIdx.x; F.lane = F.tid & 63; F.wave = __builtin_amdgcn_readfirstlane(F.tid >> 6);
    F.G = gridDim.x; { const int bx = blockIdx.x; F.vcu = (F.G % 8 == 0) ? (bx % 8) * (F.G / 8) + bx / 8 : bx; }
    F.ws = args.ws; F.out = args.out; F.ctl = (gu32*)(args.ws + WS_CTL);
    F.inp = args.in;
    for (int u = F.tid; u < (LDS_BYTES - LDSCTL_OFF) / 4; u += NWAVES * 64) ((LAS unsigned*)(F.lds + LDSCTL_OFF))[u] = 0u;
    __syncthreads();
    const int lo = args.ph_lo, hi = args.ph_hi;
    const bool use_bar = (hi - lo) > 1;
    XcdBarrier bar; bar.bar = (unsigned*)(F.ctl + CW_BAR); bar.x = 0; bar.st = nullptr;
    if (use_bar) bar = xcd_barrier_post((unsigned*)(F.ctl + CW_BAR), F.MISC + 8);
#define IN(k) (lo <= (k) && (k) < hi)
#define SEAM(k) do { if (IN(k) && IN((k) + 1)) xcd_barrier(bar); } while (0)
    if (IN(0)) { p0_phase(F); SEAM(0); }
    if (IN(1)) { p1_phase(F); SEAM(1); }
    if (IN(2)) {
        p2_ab(F);
        pg8::Gemm g{(const pg8::bf16_t*)(F.ws + WS_XN), (const pg8::bf16_t*)(F.ws + WS_WIN), MROWS, 7168, DM, 0}; pg8::QuadOrder S; S.init(MROWS, 7168, DM, F.G, (int)blockIdx.x);
        unsigned char* yb = (unsigned char*)F.out;
        pg8::EpiInProj E{(pg8::bf16_t*)(yb + YO_QA), (pg8::bf16_t*)(yb + YO_KP), (pg8::bf16_t*)(yb + YO_VP), (pg8::bf16_t*)(F.ws + WS_KS), (pg8::bf16_t*)(F.ws + WS_VS),
                         (pg8::bf16_t*)(F.ws + WS_QKVB), (pg8::bf16_t*)(yb + YO_GATE), F.out + OUT_K, F.out + OUT_V, (const float*)(F.ws + WS_ROPE)};
        pg8::gemm_phase<pg8::EpiInProj, pg8::QuadOrder, true, true, 3, 192>(F.lds + RING_OFF, g, S, E, (float*)(F.ws + WS_MIX), (unsigned*)(F.ctl + CW_FLAG + 2048));
        SEAM(2);
    }
    if (IN(3)) {
        const float* lp = F.inp[15];
        const float lam = __expf(wave_sum(lp[F.lane] * lp[64 + F.lane])) - __expf(wave_sum(lp[128 + F.lane] * lp[192 + F.lane])) + 0.2f;
        const bf16* QA = (const bf16*)((unsigned char*)F.out + YO_QA); bf16* MIX = (bf16*)(F.ws + WS_MIX);
        for (int u = 256 + F.vcu; u < 768; u += F.G) {
            const bf16 *Qp, *Kp, *Vp; bf16* Op; int nk;
            if (u < 256) { const int qb = u & 1, bh = u >> 1, b = bh >> 3, h = bh & 7; const size_t r0 = (size_t)(b * 256 + qb * 128);
                Qp = QA + r0 * 1024 + h * 128; Kp = (const bf16*)((unsigned char*)F.out + YO_KP) + (size_t)bh * 256 * 128; Vp = (const bf16*)((unsigned char*)F.out + YO_VP) + (size_t)bh * 256 * 128; Op = MIX + (size_t)((r0 >> 8) * 32 + 2 * h) * 16384 + ((r0 >> 7) & 1) * 8192; nk = 256;
            } else { const int su = (u < 512) ? 2 * (u - 256) : 2 * (u - 512) + 1; const int qb = su & 7, bh = su >> 3, b = bh >> 3, h = bh & 7; const size_t r0 = (size_t)(NPROMPT + b * 1024 + qb * 128);
                Qp = QA + r0 * 1024 + h * 128; Kp = (const bf16*)(F.ws + WS_KS) + (size_t)bh * 1536 * 128; Vp = (const bf16*)(F.ws + WS_VS) + (size_t)bh * 1536 * 128; Op = MIX + (size_t)((r0 >> 8) * 32 + 2 * h) * 16384 + ((r0 >> 7) & 1) * 8192; nk = 1536; }
            dattn::attn_unit(Qp, Kp, Vp, Op, nk, lam, F.inp[16], (char*)lds);
        }
        {
#define CL_DEC(it_, s_, h_, c_) do { if ((it_) < 512) { s_ = (it_) >> 5; h_ = ((it_) >> 2) & 7; c_ = (it_) & 3; } else { const int j_ = (it_) - 512; s_ = 16 + (j_ >> 7); h_ = (j_ >> 4) & 7; c_ = j_ & 15; } } while (0)
            unsigned raw[3][12]; float abv[2];
            int it = F.vcu; int s = 0, h = 0, c = 0;
            if (it < 1536) { CL_DEC(it, s, h, c); gdn::cl_load(F, s, h, c, raw, abv); }
            for (; it < 1536; it += F.G) {
                const int nit = it + F.G; int ns = 0, nh = 0, nc = 0; const bool hn = nit < 1536; if (hn) CL_DEC(nit, ns, nh, nc);
                gdn::chunk_local(F, s, h, c, raw, abv, hn, ns, nh, nc);
                s = ns; h = nh; c = nc;
            }
#undef CL_DEC
        }
        SEAM(3);
    }
    if (IN(4)) {
        if (F.vcu < 128 && F.tid == 0) __hip_atomic_store((unsigned*)(F.ctl + CW_PAIR + 64 * F.vcu) + 1, xb_xcc_id() + 1u, __ATOMIC_RELAXED, __HIP_MEMORY_SCOPE_AGENT);
        for (int k = 0; k < 2; ++k) {
            int s_, h_, d_;
            if (F.vcu < 128) { if (k) break; s_ = 16 + (F.vcu >> 4); h_ = (F.vcu >> 1) & 7; d_ = F.vcu & 1; }
            else { const int p = 2 * (F.vcu - 128) + k; if (p >= 256) break; s_ = p >> 4; h_ = (p >> 1) & 7; d_ = p & 1; }
            gscan::scan_item(F, s_, h_, d_);
        }
        { int fr0, fn, fh;
          if (F.vcu < 128) { pair_sync((unsigned*)(F.ctl + CW_PAIR + 64 * F.vcu), (unsigned*)(F.ctl + CW_PAIR + 64 * (F.vcu ^ 1))); fr0 = NPROMPT + (F.vcu >> 4) * 1024 + (F.vcu & 1) * 512; fn = 512; fh = (F.vcu >> 1) & 7; }
          else { asm volatile("s_waitcnt vmcnt(0)" ::: "memory"); __syncthreads(); const int p = 2 * (F.vcu - 128); fr0 = (p >> 4) * 256; fn = 256; fh = (p >> 1) & 7; }
          gdn_finalize(F, fr0, fn, fh); __syncthreads(); }
        if (F.vcu >= 128) {
            const float* lp = F.inp[15];
            const float lam = __expf(wave_sum(lp[F.lane] * lp[64 + F.lane])) - __expf(wave_sum(lp[128 + F.lane] * lp[192 + F.lane])) + 0.2f;
            const bf16* QA = (const bf16*)((unsigned char*)F.out + YO_QA); bf16* MIX = (bf16*)(F.ws + WS_MIX);
            for (int k = 0; k < 2; ++k) { const int u = 2 * (F.vcu - 128) + k; const int qb = u & 1, bh = u >> 1, b = bh >> 3, h = bh & 7; const size_t r0 = (size_t)(b * 256 + qb * 128);
                dattn::attn_unit(QA + r0 * 1024 + h * 128, (const bf16*)((unsigned char*)F.out + YO_KP) + (size_t)bh * 256 * 128, (const bf16*)((unsigned char*)F.out + YO_VP) + (size_t)bh * 256 * 128,
                                 MIX + (size_t)((r0 >> 8) * 32 + 2 * h) * 16384 + ((r0 >> 7) & 1) * 8192, 256, lam, F.inp[16], (char*)lds); }
        }
        SEAM(4);
    }
    if (IN(6)) {
        pg8::Gemm g{(const pg8::bf16_t*)(F.ws + WS_MIX), (const pg8::bf16_t*)(F.ws + WS_WOUT), MROWS, DM, DM, 1}; pg8::PairOrder S; S.init(MROWS, DM, DM, F.G, (int)blockIdx.x, 24);
        pg8::EpiOutProj E{F.inp[0], F.inp[1], (const float*)(F.ws + WS_MOD), F.inp[18], (pg8::bf16_t*)(F.ws + WS_HB), (pg8::bf16_t*)(F.ws + WS_HW), (float*)(F.ws + WS_PART)};
        pg8::gemm_phase<pg8::EpiOutProj, pg8::PairOrder, true, true>(F.lds + RING_OFF, g, S, E, (float*)(F.ws + WS_WIN), (unsigned*)(F.ctl + CW_FLAG), 116, (unsigned)((WS_INTRA - WS_WIN) - 116 * 262144));
        SEAM(6);
    }
    if (IN(7)) {
        pg8::Gemm g{(const pg8::bf16_t*)(F.ws + WS_HW), (const pg8::bf16_t*)(F.ws + WS_WFF1), MROWS, DFF, DM, 1}; pg8::StaticOrder S; S.init(MROWS, DFF, DM, F.G, (int)blockIdx.x);
        LAS float* rt = (LAS float*)(F.lds + RSTD_OFF); const float* PART = (const float*)(F.ws + WS_PART);
        { const int half = F.tid >> 8, rr = F.tid & 255;
            f32x4 pv[3][8]; bool ok[3];
#pragma unroll
            for (int j = 0; j < 3; ++j) { pg8::Unit u; ok[j] = S.next(2 * j + half, u); const float* p = PART + ((size_t)(ok[j] ? u.pm : 0) * 256 + rr) * 32;
#pragma unroll
                for (int q = 0; q < 8; ++q) pv[j][q] = *(const f32x4*)(p + 4 * q); }
#pragma unroll
            for (int j = 0; j < 3; ++j) { float s = 0.f;
#pragma unroll
                for (int q = 0; q < 8; ++q) s += (pv[j][q][0] + pv[j][q][1]) + (pv[j][q][2] + pv[j][q][3]);
                if (ok[j]) rt[(2 * j + half) * 256 + rr] = rsqrtf(s * (1.0f / DM) + EPS); } }
        __syncthreads();
        pg8::EpiFF1 E{(const float*)(F.ws + WS_C2), (pg8::bf16_t*)(F.ws + WS_FF), (const LAS float*)rt};
        pg8::gemm_phase<pg8::EpiFF1, pg8::StaticOrder, true, true>(F.lds + RING_OFF, g, S, E);
        SEAM(7);
    }
    if (IN(8)) {
        pg8::Gemm g{(const pg8::bf16_t*)(F.ws + WS_FF), (const pg8::bf16_t*)(F.ws + WS_WFF2), MROWS, DM, DFF, 1}; pg8::PairOrder S; S.init(MROWS, DM, DFF, F.G, (int)blockIdx.x, 76);
        pg8::EpiFF2 E{(const float*)(F.ws + WS_MOD), (const pg8::bf16_t*)(F.ws + WS_HB), F.out, (float*)(F.ws + WS_PART2), F.inp[21], (unsigned*)(F.ctl + CW_PANEL)};
        pg8::gemm_phase<pg8::EpiFF2, pg8::PairOrder, true, true>(F.lds + RING_OFF, g, S, E, (float*)(F.ws + WS_WIN), (unsigned*)(F.ctl + CW_FLAG + 1024), 116, (unsigned)((WS_INTRA - WS_WIN) - 116 * 262144));
    }
#undef IN
#undef SEAM
}

extern "C" void kernel_launch(void* const* d_in, const int* in_sizes, int n_in, void* d_out, int out_size, void* d_ws, size_t ws_size, hipStream_t stream) {
    static int grid = 0;
    if (grid == 0) {
        if (n_in != 22 || out_size != 37748736 || ws_size < WS_END) { fprintf(stderr, "kernel_launch: unexpected shapes: n_in %d out %d ws %zu (need %zu)\n", n_in, out_size, ws_size, (size_t)WS_END); grid = -1; return; }
        if (hipFuncSetAttribute((const void*)mega_fwd, hipFuncAttributeMaxDynamicSharedMemorySize, LDS_BYTES) != hipSuccess) { fprintf(stderr, "kernel_launch: hipFuncSetAttribute failed\n"); grid = -1; return; }
        int per_cu = 0; (void)hipOccupancyMaxActiveBlocksPerMultiprocessor(&per_cu, (const void*)mega_fwd, NWAVES * 64, LDS_BYTES); (void)hipGetLastError();
        if (per_cu < 1) fprintf(stderr, "kernel_launch: occupancy query reports %d blocks per CU\n", per_cu);
        grid = 256;
    }
    if (grid < 0) return;
    if (hipMemsetAsync((char*)d_ws + WS_CTL, 0, CTL_ZERO_BYTES, stream) != hipSuccess) { fprintf(stderr, "kernel_launch: memset failed\n"); return; }
    Args a{};
    for (int i = 0; i < 22; ++i) a.in[i] = (const float*)d_in[i];
    a.out = (float*)d_out; a.ws = (unsigned char*)d_ws;
    if (N_LAUNCHES == 1) { a.ph_lo = 0; a.ph_hi = N_PHASES; a.li = 0; hipLaunchKernelGGL(mega_fwd, dim3(grid), dim3(NWAVES * 64), LDS_BYTES, stream, a); }
    else { for (int li = 0; li < N_PHASES; ++li) { a.ph_lo = li; a.ph_hi = li + 1; a.li = li; hipLaunchKernelGGL(mega_fwd, dim3(grid), dim3(NWAVES * 64), LDS_BYTES, stream, a); } }
    const hipError_t le = hipPeekAtLastError();
    if (le != hipSuccess) fprintf(stderr, "kernel_launch: launch failed: %s\n", hipGetErrorName(le));
}
```

```cpp
#include <hip/hip_runtime.h>
#include <hip/hip_bf16.h>
#include <cstdio>
#include <cstdint>
#include <cmath>

namespace pg8 {
#define PG8_LAS __attribute__((address_space(3)))
typedef unsigned short bf16_t;
typedef short bf16x8 __attribute__((ext_vector_type(8)));
typedef float f32x4 __attribute__((ext_vector_type(4)));
typedef unsigned u32x4 __attribute__((ext_vector_type(4)));
constexpr int BM = 256, BK = 64, HALF = 128, HTB = HALF * BK * 2  , STAGE_BYTES = 8 * HTB, NXCD = 8, WGM = 4;

__host__ __device__ __forceinline__ int lds_byte(int r, int c) { const int st = (r >> 4) * 2 + (c >> 5), rr = r & 15, cc = c & 31, ob = rr * 64 + cc * 2; return st * 1024 + (ob ^ (((ob >> 9) & 1) << 5)); }
__host__ __device__ __forceinline__ void stage_rc(int b, int& R, int& C) { const int st = b / 1024, sb = b % 1024, swz = sb ^ (((sb >> 9) & 1) << 5); R = (st >> 1) * 16 + swz / 64; C = (st & 1) * 32 + (swz % 64) / 2; }
__host__ __device__ __forceinline__ int perm32inv(int v) { return 16 * ((v >> 2) & 1) + 4 * (v >> 3) + (v & 3); }
__host__ __device__ __forceinline__ int perm32(int rho) { const int n = rho >> 4, i = rho & 15; return 8 * (i >> 2) + 4 * n + (i & 3); }

struct Unit { int pm, pn, k0, nt, mode, slot, npart; };
struct Gemm { const bf16_t* A; const bf16_t* Bt; int M, N, K; int atiled; };

struct StaticOrder {
    int nM, nN, nwg, G, c, ntk;
    __host__ __device__ __forceinline__ void init(int M, int N, int K, int G_, int c_) { nM = M / BM; nN = N / BM; nwg = nM * nN; G = G_; c = c_; ntk = K / BK; }
    __host__ __device__ __forceinline__ bool next(int i, Unit& u) const {
        const long L = (long)i * G + c; if (L >= nwg) return false;
        int wgid = (int)L; { const int q = nwg / NXCD, r = nwg % NXCD, xcd = wgid % NXCD, off = wgid / NXCD; wgid = (xcd < r ? xcd * (q + 1) : r * (q + 1) + (xcd - r) * q) + off; }
        const int nig = WGM * nN, gid = wgid / nig, fm = gid * WGM, gsz = (nM - fm) < WGM ? (nM - fm) : WGM;
        u.pm = fm + ((wgid % nig) % gsz); u.pn = (wgid % nig) / gsz; u.k0 = 0; u.nt = ntk; u.mode = 0; u.slot = 0; u.npart = 0; return true;
    }
    __device__ __forceinline__ void a_ready(const Unit&) const {}
    __device__ __forceinline__ void done(const Unit&) const {}
};


typedef float cvt_f32x2 __attribute__((ext_vector_type(2))); typedef __bf16 cvt_bf16x2 __attribute__((ext_vector_type(2)));
__device__ __forceinline__ unsigned cvt_pk_bf16(float lo, float hi) { cvt_f32x2 v = {lo, hi}; cvt_bf16x2 b = __builtin_convertvector(v, cvt_bf16x2); return __builtin_bit_cast(unsigned, b); }

struct PairOrder {
    int c, ntk, G, ntp;
    __host__ __device__ __forceinline__ void init(int M, int N, int K, int G_, int c_, int ntp_) { c = c_; ntk = K / BK; G = G_; ntp = ntp_; }
    __host__ __device__ __forceinline__ bool next(int i, Unit& u) const {
        if (i >= 2 || G != 256) return false;
        const int x = c & 7, lc = c >> 3, jp = lc >> 1, j = x * 16 + jp, role = lc & 1;
        int T, k0 = 0, nt = ntk, mode = 0;
        if (role == 0) { if (i == 0) { T = 48 * x + 32 + jp; nt = ntp; mode = 1; } else T = 48 * x + 16 + jp; }
        else           { if (i == 0) T = 48 * x + jp; else { T = 48 * x + 32 + jp; k0 = ntp; nt = ntk - ntp; mode = 2; } }
        u.pm = T >> 3; u.pn = T & 7; u.k0 = k0; u.nt = nt; u.mode = mode; u.slot = j; u.npart = 1; return true;
    }
    __device__ __forceinline__ void a_ready(const Unit&) const {}
    __device__ __forceinline__ void done(const Unit&) const {}
};

struct QuadOrder {
    StaticOrder base; int c, ntk;
    __host__ __device__ __forceinline__ void init(int M, int N, int K, int G_, int c_) { base.init(M, N, K, G_, c_); c = c_; ntk = K / BK; }
    __host__ __device__ __forceinline__ bool next(int i, Unit& u) const {
        if (base.G != 256 || base.nwg != 1344) return base.next(i, u);
        const int role = c >> 6, t = c & 63, q = (ntk == 32) ? 10 : ntk / 4;
        if (i > 5) return false;
        const bool split = (role < 3) ? (i == 0) : (i == 5);
        if (!split) return base.next(role < 3 ? i - 1 : i, u);
        StaticOrder b2 = base; b2.c = t; b2.next(5, u);
        u.k0 = role * q; u.nt = (role < 3) ? q : ntk - 3 * q; u.mode = (role < 3) ? 1 : 2; u.slot = (role < 3) ? t * 3 + role : t * 3; u.npart = 3; return true;
    }
    __device__ __forceinline__ void a_ready(const Unit&) const {}
    __device__ __forceinline__ void done(const Unit&) const {}
};

typedef float f32x2 __attribute__((ext_vector_type(2)));
typedef unsigned u32x2 __attribute__((ext_vector_type(2)));
__device__ __forceinline__ u32x2 pack4(const f32x4 v) { u32x2 w; w.x = cvt_pk_bf16(v[0], v[1]); w.y = cvt_pk_bf16(v[2], v[3]); return w; }
struct EpiInProj {
    static constexpr bool PERM = true, AFTER_DRAIN = false;
    bf16_t *QA, *KP, *VP, *KS, *VS, *QKVB, *GATE; float *outK, *outV; const float* rope;
    __device__ __forceinline__ void operator()(const f32x4 (&acc)[2][2][4][2], const Unit& u, int ui, int wr, int wc, int fr_, int fq_) const {
        int fr = fr_, fq = fq_; asm volatile("" : "+v"(fr), "+v"(fq));
        const int pm = u.pm, pn = u.pn; const bool sample = pm >= 16;
        const int tq = (pm - 16) & 3, bs = (pm - 16) >> 2;
        if (pn >= 12) {
            bf16_t* base; int ld, c0;
            if (pn < 24) { base = QKVB; ld = 3072; c0 = (pn - 12) * 256; } else { base = GATE; ld = 1024; c0 = (pn - 24) * 256; }
#pragma unroll
            for (int ai = 0; ai < 2; ++ai)
#pragma unroll
                for (int m = 0; m < 4; ++m) { const size_t row = (size_t)pm * 256 + ai * 128 + wr * 64 + m * 16 + fr;
#pragma unroll
                    for (int bj = 0; bj < 2; ++bj) { const u32x2 lo = pack4(acc[ai][bj][m][0]), hi = pack4(acc[ai][bj][m][1]); u32x4 w; w.x = lo.x; w.y = lo.y; w.z = hi.x; w.w = hi.y;
                        *(u32x4*)(base + row * ld + c0 + bj * 128 + wc * 32 + 8 * fq) = w; } }
        } else if (pn >= 8) {
#pragma unroll
            for (int bj = 0; bj < 2; ++bj) { const int h = 2 * (pn - 8) + bj;
#pragma unroll
                for (int ai = 0; ai < 2; ++ai)
#pragma unroll
                    for (int m = 0; m < 4; ++m) { const int tl = ai * 128 + wr * 64 + m * 16 + fr; const int d = wc * 32 + 8 * fq;
                        const f32x4 v0 = acc[ai][bj][m][0], v1 = acc[ai][bj][m][1];
                        const u32x2 lo = pack4(v0), hi = pack4(v1); u32x4 w; w.x = lo.x; w.y = lo.y; w.z = hi.x; w.w = hi.y;
                        if (!sample) { const size_t idx = ((size_t)(pm * 8 + h) * 256 + tl) * 128 + d; *(f32x4*)(outV + idx) = v0; *(f32x4*)(outV + idx + 4) = v1; *(u32x4*)(VP + idx) = w; }
                        else { const size_t idx = ((size_t)(bs * 8 + h) * 1536 + 512 + tq * 256 + tl) * 128 + d; *(u32x4*)(VS + idx) = w; } } }
        } else {
            const bool isK = pn >= 4; const bool colrot = (wc & 1) != 0; const bool upper = fq >= 2;
            const int i0 = 8 * (fq & 1);
            const float sgn = upper ? 1.f : -1.f;
#pragma unroll
            for (int ai = 0; ai < 2; ++ai) {
                f32x4 cr0 = {1.f, 1.f, 1.f, 1.f}, cr1 = cr0, sr0 = {0.f, 0.f, 0.f, 0.f}, sr1 = sr0;
                if (sample && !colrot) { const int pos = tq * 4 + ai * 2 + wr; cr0 = *(const f32x4*)(rope + pos * 16 + i0); cr1 = *(const f32x4*)(rope + pos * 16 + i0 + 4); sr0 = *(const f32x4*)(rope + 1024 + pos * 16 + i0); sr1 = *(const f32x4*)(rope + 1024 + pos * 16 + i0 + 4); }
#pragma unroll
                for (int m = 0; m < 4; ++m) { const int tl = ai * 128 + wr * 64 + m * 16 + fr;
                    f32x4 c0v = cr0, c1v = cr1, s0v = sr0, s1v = sr1;
                    if (sample && colrot) { const int pos = m * 16 + fr; c0v = *(const f32x4*)(rope + pos * 16 + i0); c1v = *(const f32x4*)(rope + pos * 16 + i0 + 4); s0v = *(const f32x4*)(rope + 1024 + pos * 16 + i0); s1v = *(const f32x4*)(rope + 1024 + pos * 16 + i0 + 4); }
#pragma unroll
                    for (int bj = 0; bj < 2; ++bj) { f32x4 o0 = acc[ai][bj][m][0], o1 = acc[ai][bj][m][1];
                        if (sample) {
                            f32x4 p0, p1;
#pragma unroll
                            for (int e = 0; e < 4; ++e) { p0[e] = __shfl_xor(o0[e], 32); p1[e] = __shfl_xor(o1[e], 32); }
                            o0 = o0 * c0v + p0 * s0v * sgn; o1 = o1 * c1v + p1 * s1v * sgn; }
                        const int d = wc * 32 + 8 * fq;
                        const u32x2 lo = pack4(o0), hi = pack4(o1); u32x4 w; w.x = lo.x; w.y = lo.y; w.z = hi.x; w.w = hi.y;
                        if (!isK) { *(u32x4*)(QA + ((size_t)pm * 256 + tl) * 1024 + pn * 256 + bj * 128 + d) = w; }
                        else { const int h = 2 * (pn - 4) + bj;
                            if (!sample) { const size_t idx = ((size_t)(pm * 8 + h) * 256 + tl) * 128 + d; *(f32x4*)(outK + idx) = o0; *(f32x4*)(outK + idx + 4) = o1; *(u32x4*)(KP + idx) = w; }
                            else { const size_t idx = ((size_t)(bs * 8 + h) * 1536 + 512 + tq * 256 + tl) * 128 + d; *(u32x4*)(KS + idx) = w; } } } } }
        }
    }
};
struct EpiOutProj {
    static constexpr bool PERM = true, AFTER_DRAIN = false;
    const float *xp, *xs, *mod, *norm2; bf16_t* HB; bf16_t* HW; float* PART;
    __device__ __forceinline__ void operator()(const f32x4 (&acc)[2][2][4][2], const Unit& u, int ui, int wr, int wc, int fr_, int fq_) const {
        int fr = fr_, fq = fq_; asm volatile("" : "+v"(fr), "+v"(fq));
        const int pm = u.pm, pn = u.pn; const int mb = pm < 16 ? 0 : 1 + ((pm - 16) >> 2);
        const float* xb = pm < 16 ? xp + (size_t)pm * 256 * 2048 : xs + (size_t)(pm - 16) * 256 * 2048;
        const float* g1 = mod + mb * 12288 + 2 * 2048; const float* sc2 = mod + mb * 12288 + 4 * 2048;
        bf16_t* hbt = HB + (size_t)(pm * 8 + pn) * 65536 + (((wr * 4 + wc) * 4 + fq) * 16 + fr) * 8;
        f32x4 g1v[2][2], w2v[2][2];
#pragma unroll
        for (int bj = 0; bj < 2; ++bj)
#pragma unroll
            for (int n = 0; n < 2; ++n) { const int col = pn * 256 + bj * 128 + wc * 32 + 8 * fq + 4 * n; g1v[bj][n] = *(const f32x4*)(g1 + col);
                const f32x4 a = *(const f32x4*)(norm2 + col), b = *(const f32x4*)(sc2 + col); w2v[bj][n] = a * (b + 1.0f); }
#pragma unroll
        for (int am = 0; am < 4; ++am) { const int ai = am >> 1, m0 = (am & 1) * 2;
            f32x4 xin[2][2][2];
#pragma unroll
            for (int mm = 0; mm < 2; ++mm)
#pragma unroll
                for (int bj = 0; bj < 2; ++bj)
#pragma unroll
                    for (int n = 0; n < 2; ++n) xin[mm][bj][n] = __builtin_nontemporal_load((const f32x4*)(xb + (size_t)(ai * 128 + wr * 64 + (m0 + mm) * 16 + fr) * 2048 + pn * 256 + bj * 128 + wc * 32 + 8 * fq + 4 * n));
#pragma unroll
            for (int mm = 0; mm < 2; ++mm) { const int m = m0 + mm; const int rl = ai * 128 + wr * 64 + m * 16 + fr; const size_t row = (size_t)pm * 256 + rl; float s = 0.f;
#pragma unroll
                for (int bj = 0; bj < 2; ++bj) { const int col = pn * 256 + bj * 128 + wc * 32 + 8 * fq;
                    const f32x4 h0 = xin[mm][bj][0] + g1v[bj][0] * acc[ai][bj][m][0], h1 = xin[mm][bj][1] + g1v[bj][1] * acc[ai][bj][m][1];
                    s += (h0[0] * h0[0] + h0[1] * h0[1]) + (h0[2] * h0[2] + h0[3] * h0[3]) + (h1[0] * h1[0] + h1[1] * h1[1]) + (h1[2] * h1[2] + h1[3] * h1[3]);
                    { const u32x2 lo = pack4(h0), hi = pack4(h1); u32x4 w; w.x = lo.x; w.y = lo.y; w.z = hi.x; w.w = hi.y; *(u32x4*)(hbt + ((ai * 2 + bj) * 4 + m) * 4096) = w; }
                    { const u32x2 lo = pack4(h0 * w2v[bj][0]), hi = pack4(h1 * w2v[bj][1]); u32x4 w; w.x = lo.x; w.y = lo.y; w.z = hi.x; w.w = hi.y; *(u32x4*)(HW + (size_t)(pm * 32 + pn * 4 + bj * 2 + (wc >> 1)) * 16384 + ai * 8192 + (lds_byte(wr * 64 + m * 16 + fr, (wc & 1) * 32 + 8 * fq) >> 1)) = w; } }
                s += __shfl_xor(s, 16); s += __shfl_xor(s, 32);
                if (fq == 0) PART[row * 32 + pn * 4 + wc] = s; }
            asm volatile("" ::: "memory"); }
    }
};
struct EpiFF1 {
    static constexpr bool PERM = true, AFTER_DRAIN = false;
    const float* c2; bf16_t* FF; const PG8_LAS float* rstd;
    __device__ __forceinline__ void operator()(const f32x4 (&acc)[2][2][4][2], const Unit& u, int ui, int wr, int wc, int fr_, int fq_) const {
        int fr = fr_, fq = fq_; asm volatile("" : "+v"(fr), "+v"(fq));
        const int pm = u.pm, pn = u.pn; const int mb = pm < 16 ? 0 : 1 + ((pm - 16) >> 2);
        f32x4 cv[2][2];
#pragma unroll
        for (int bj = 0; bj < 2; ++bj)
#pragma unroll
            for (int n = 0; n < 2; ++n) cv[bj][n] = *(const f32x4*)(c2 + mb * 8192 + pn * 256 + bj * 128 + wc * 32 + 8 * fq + 4 * n);
#pragma unroll
        for (int ai = 0; ai < 2; ++ai)
#pragma unroll
            for (int m = 0; m < 4; ++m) { const int rl = ai * 128 + wr * 64 + m * 16 + fr; const float r = rstd[ui * 256 + rl];
                bf16_t* rowp = FF + (size_t)(pm * 128 + pn * 4 + (wc >> 1)) * 16384 + ai * 8192 + (lds_byte(wr * 64 + m * 16 + fr, (wc & 1) * 32 + 8 * fq) >> 1);
#pragma unroll
                for (int bj = 0; bj < 2; ++bj) { f32x4 v0 = acc[ai][bj][m][0] * r + cv[bj][0], v1 = acc[ai][bj][m][1] * r + cv[bj][1];
#pragma unroll
                    for (int e = 0; e < 4; ++e) { const float a = fmaxf(v0[e], 0.f), b = fmaxf(v1[e], 0.f); v0[e] = a * a; v1[e] = b * b; }
                    u32x4 w; w.x = cvt_pk_bf16(v0[0], v0[1]); w.y = cvt_pk_bf16(v0[2], v0[3]); w.z = cvt_pk_bf16(v1[0], v1[1]); w.w = cvt_pk_bf16(v1[2], v1[3]);
                    *(u32x4*)(rowp + bj * 2 * 16384) = w; } }
    }
};
struct EpiFF2 {
    static constexpr bool PERM = true, AFTER_DRAIN = false;
    const float* mod; const bf16_t* HB; float* out; float* PART; const float* nf; unsigned* cnt;
    __device__ __forceinline__ void operator()(const f32x4 (&acc)[2][2][4][2], const Unit& u, int ui, int wr, int wc, int fr_, int fq_) const {
        int fr = fr_, fq = fq_; asm volatile("" : "+v"(fr), "+v"(fq));
        const int pm = u.pm, pn = u.pn; const int mb = pm < 16 ? 0 : 1 + ((pm - 16) >> 2);
        const __amdgpu_buffer_rsrc_t pr = __builtin_amdgcn_make_buffer_rsrc(PART, 0, 0x7fffffff, 0x00020000);
        const float* g2 = mod + mb * 12288 + 5 * 2048;
        f32x4 gv[2][2];
#pragma unroll
        for (int bj = 0; bj < 2; ++bj)
#pragma unroll
            for (int n = 0; n < 2; ++n) gv[bj][n] = *(const f32x4*)(g2 + pn * 256 + bj * 128 + wc * 32 + 8 * fq + 4 * n);
#define FF2_H(hw_) const f32x4 h0 = {__builtin_bit_cast(float, hw_.x << 16), __builtin_bit_cast(float, hw_.x & 0xffff0000u), __builtin_bit_cast(float, hw_.y << 16), __builtin_bit_cast(float, hw_.y & 0xffff0000u)}; \
                   const f32x4 h1 = {__builtin_bit_cast(float, hw_.z << 16), __builtin_bit_cast(float, hw_.z & 0xffff0000u), __builtin_bit_cast(float, hw_.w << 16), __builtin_bit_cast(float, hw_.w & 0xffff0000u)}
#pragma unroll
        for (int ai = 0; ai < 2; ++ai) {
            u32x4 hin[4][2];
#pragma unroll
            for (int m = 0; m < 4; ++m)
#pragma unroll
                for (int bj = 0; bj < 2; ++bj) hin[m][bj] = *(const u32x4*)(HB + (size_t)(pm * 8 + pn) * 65536 + (((wr * 4 + wc) * 4 + fq) * 16 + fr) * 8 + ((ai * 2 + bj) * 4 + m) * 4096);
#pragma unroll
            for (int m = 0; m < 4; ++m) { const int row = pm * 256 + ai * 128 + wr * 64 + m * 16 + fr; float s = 0.f;
#pragma unroll
                for (int bj = 0; bj < 2; ++bj) { const u32x4 hw_ = hin[m][bj]; FF2_H(hw_);
                    const f32x4 y0 = h0 + gv[bj][0] * acc[ai][bj][m][0], y1 = h1 + gv[bj][1] * acc[ai][bj][m][1];
                    s += (y0[0] * y0[0] + y0[1] * y0[1]) + (y0[2] * y0[2] + y0[3] * y0[3]) + (y1[0] * y1[0] + y1[1] * y1[1]) + (y1[2] * y1[2] + y1[3] * y1[3]); }
                s += __shfl_xor(s, 16); s += __shfl_xor(s, 32);
                if (fq == 0) __builtin_amdgcn_raw_buffer_store_b32(__builtin_bit_cast(unsigned, s), pr, (unsigned)(row * 32 + pn * 4 + wc) * 4u, 0, 16); }
            asm volatile("" ::: "memory"); }
        asm volatile("s_waitcnt vmcnt(0)" ::: "memory");
        unsigned* pc = cnt + pm * 64;
        if (fr == 0 && fq == 0) __hip_atomic_fetch_add(pc, 1u, __ATOMIC_RELAXED, __HIP_MEMORY_SCOPE_AGENT);
        { unsigned spins = 0;
          while ((unsigned)__builtin_amdgcn_readfirstlane((int)__hip_atomic_load(pc, __ATOMIC_RELAXED, __HIP_MEMORY_SCOPE_AGENT)) < 64u) { __builtin_amdgcn_s_sleep(2); if (++spins > (1u << 22)) break; } }
        asm volatile("" : "+v"(fr), "+v"(fq) :: "memory");
        asm volatile("" : "+v"(gv[0][0]), "+v"(gv[0][1]), "+v"(gv[1][0]), "+v"(gv[1][1]));
        float rs[2][4];
#pragma unroll
        for (int ai = 0; ai < 2; ++ai) { u32x4 pa[4][2];
#pragma unroll
            for (int m = 0; m < 4; ++m) { const int row = pm * 256 + ai * 128 + wr * 64 + m * 16 + fr;
#pragma unroll
                for (int q = 0; q < 2; ++q) pa[m][q] = __builtin_amdgcn_raw_buffer_load_b128(pr, (unsigned)(row * 32 + fq * 8 + 4 * q) * 4u, 0, 16); }
#pragma unroll
            for (int m = 0; m < 4; ++m) { const f32x4 a = __builtin_bit_cast(f32x4, pa[m][0]), b = __builtin_bit_cast(f32x4, pa[m][1]);
                float s = (a[0] + a[1]) + (a[2] + a[3]) + (b[0] + b[1]) + (b[2] + b[3]);
                s += __shfl_xor(s, 16); s += __shfl_xor(s, 32);
                rs[ai][m] = __builtin_amdgcn_rsqf(s * (1.0f / 2048.0f) + 1e-6f); }
            asm volatile("" ::: "memory"); }
        f32x4 nv[2][2];
#pragma unroll
        for (int bj = 0; bj < 2; ++bj)
#pragma unroll
            for (int n = 0; n < 2; ++n) nv[bj][n] = *(const f32x4*)(nf + pn * 256 + bj * 128 + wc * 32 + 8 * fq + 4 * n);
#pragma unroll
        for (int ai = 0; ai < 2; ++ai) { u32x4 hin[4][2];
#pragma unroll
            for (int m = 0; m < 4; ++m)
#pragma unroll
                for (int bj = 0; bj < 2; ++bj) hin[m][bj] = *(const u32x4*)(HB + (size_t)(pm * 8 + pn) * 65536 + (((wr * 4 + wc) * 4 + fq) * 16 + fr) * 8 + ((ai * 2 + bj) * 4 + m) * 4096);
#pragma unroll
            for (int m = 0; m < 4; ++m) { const size_t row = (size_t)pm * 256 + ai * 128 + wr * 64 + m * 16 + fr; const float r = rs[ai][m];
#pragma unroll
                for (int bj = 0; bj < 2; ++bj) { const u32x4 hw_ = hin[m][bj]; FF2_H(hw_);
                    const f32x4 y0 = h0 + gv[bj][0] * acc[ai][bj][m][0], y1 = h1 + gv[bj][1] * acc[ai][bj][m][1];
                    float* p = out + row * 2048 + pn * 256 + bj * 128 + wc * 32 + 8 * fq;
                    *(f32x4*)p = y0 * r * nv[bj][0]; *(f32x4*)(p + 4) = y1 * r * nv[bj][1]; } }
            asm volatile("" ::: "memory"); }
#undef FF2_H
    }
};

template <class Epi, class Sched, bool ALIGN_EPI = false, bool SP2 = false, int NPART = 1, int NSLOTS = 128>
__device__ __forceinline__ void gemm_phase(PG8_LAS unsigned char* lds, const Gemm g, const Sched& S, const Epi& E, float* partial = nullptr, unsigned* flags = nullptr, int pslot_split = 1 << 30, unsigned pslot_gap = 0u) {
    const int tid = threadIdx.x, wid = __builtin_amdgcn_readfirstlane(tid >> 6), lane = tid & 63, wr = wid >> 2, wc = wid & 3, fr = lane & 15, fq = lane >> 4;
    const int K = g.K;
    unsigned voffA[2], voffB[2];
    static_assert(Epi::PERM, "the weight images are stored with the perm32 row order");
#pragma unroll
    for (int i = 0; i < 2; ++i) { int R, C; stage_rc(tid * 16 + i * 8192, R, C);
        voffA[i] = g.atiled ? (unsigned)(tid * 16 + i * 8192) : (unsigned)(R * K + C) * 2u; voffB[i] = (unsigned)(tid * 16 + i * 8192); }
    const size_t kstep = (size_t)(BK * 2);
    const size_t hstep = (size_t)HALF * K * 2;
    const size_t tstep = 2 * hstep;
    const size_t kstepA = g.atiled ? (size_t)(BM * BK * 2) : kstep;
    const size_t hstepA = g.atiled ? (size_t)(HALF * BK * 2) : hstep;
    const size_t kstepB = (size_t)(BM * BK * 2), hstepB = (size_t)(HALF * BK * 2);
    const unsigned ldsw = (unsigned)wid * 1024u;
    const int aoff = lds_byte(wr * 64 + fr, fq * 8), boff = lds_byte(wc * 32 + fr, fq * 8);
#define PG8_SA(b, h) (((b) * 2 + (h)) * HTB)
#define PG8_SB(b, h) ((4 + (b) * 2 + (h)) * HTB)
#define PG8_STAGE(bufoff, gbase, voff) do { _Pragma("unroll") for (int _i = 0; _i < 2; ++_i) \
        __builtin_amdgcn_global_load_lds((const unsigned*)((const char*)(gbase) + (voff)[_i]), (PG8_LAS unsigned*)(lds + (bufoff) + ldsw + _i * 8192), 16, 0, 0); } while (0)
#define PG8_LDA(dst, b, h) do { _Pragma("unroll") for (int m = 0; m < 4; ++m) _Pragma("unroll") for (int k = 0; k < 2; ++k) dst[m][k] = *(const PG8_LAS bf16x8*)(lds + PG8_SA(b, h) + aoff + m * 2048 + k * 1024); } while (0)
#define PG8_LDB(dst, b, h) do { _Pragma("unroll") for (int n = 0; n < 2; ++n) _Pragma("unroll") for (int k = 0; k < 2; ++k) dst[n][k] = *(const PG8_LAS bf16x8*)(lds + PG8_SB(b, h) + boff + n * 2048 + k * 1024); } while (0)
#define PG8_MMA(ai, bj, At, Bt) do { __builtin_amdgcn_s_setprio(1); _Pragma("unroll") for (int m = 0; m < 4; ++m) _Pragma("unroll") for (int n = 0; n < 2; ++n) _Pragma("unroll") for (int k = 0; k < 2; ++k) \
        acc[ai][bj][m][n] = __builtin_amdgcn_mfma_f32_16x16x32_bf16(Bt[n][k], At[m][k], acc[ai][bj][m][n], 0, 0, 0); __builtin_amdgcn_s_setprio(0); } while (0)
#define PG8_WAIT_V(n) asm volatile("s_waitcnt vmcnt(" #n ")" ::: "memory")
#define PG8_WAIT_L(n) asm volatile("s_waitcnt lgkmcnt(" #n ")" ::: "memory")
#define PG8_BAR __builtin_amdgcn_s_barrier()
#define PG8_SCHED __builtin_amdgcn_sched_barrier(0)
    Unit cur, nxt; int ui = 0;
    if (!S.next(0, cur)) return;
    f32x4 acc[2][2][4][2];
#pragma unroll
    for (int a = 0; a < 2; ++a)
#pragma unroll
        for (int b = 0; b < 2; ++b)
#pragma unroll
            for (int m = 0; m < 4; ++m)
#pragma unroll
                for (int n = 0; n < 2; ++n) acc[a][b][m][n] = (f32x4){0.f, 0.f, 0.f, 0.f};
    bf16x8 At[4][2], B0[2][2], B1[2][2];
    const char* cA = (const char*)g.A + (size_t)cur.pm * tstep + (size_t)cur.k0 * kstepA; const char* cB = (const char*)g.Bt + (size_t)cur.pn * tstep + (size_t)cur.k0 * kstepB;
    S.a_ready(cur);
    if constexpr (SP2) {
        PG8_STAGE(PG8_SB(0, 0), cB, voffB); PG8_STAGE(PG8_SB(0, 1), cB + hstepB, voffB); PG8_STAGE(PG8_SA(0, 0), cA, voffA); PG8_STAGE(PG8_SA(0, 1), cA + hstepA, voffA);
        if (wr == 1) PG8_BAR;
        PG8_WAIT_V(2); PG8_BAR;
        PG8_STAGE(PG8_SB(1, 0), cB + kstepB, voffB); PG8_STAGE(PG8_SA(1, 0), cA + kstepA, voffA); PG8_STAGE(PG8_SB(1, 1), cB + hstepB + kstepB, voffB);
        PG8_WAIT_V(6); PG8_BAR;
    } else {
        PG8_STAGE(PG8_SB(0, 0), cB, voffB); PG8_STAGE(PG8_SA(0, 0), cA, voffA); PG8_STAGE(PG8_SB(0, 1), cB + hstepB, voffB); PG8_STAGE(PG8_SA(0, 1), cA + hstepA, voffA);
        if (wr == 1) PG8_BAR;
        PG8_WAIT_V(4); PG8_BAR;
        PG8_STAGE(PG8_SB(1, 0), cB + kstepB, voffB); PG8_STAGE(PG8_SA(1, 0), cA + kstepA, voffA); PG8_STAGE(PG8_SB(1, 1), cB + hstepB + kstepB, voffB);
        PG8_WAIT_V(6); PG8_BAR;
    }
    for (;;) {
        const bool has_next = S.next(ui + 1, nxt);
        const char* nA = has_next ? (const char*)g.A + (size_t)nxt.pm * tstep + (size_t)nxt.k0 * kstepA : cA; const char* nB = has_next ? (const char*)g.Bt + (size_t)nxt.pn * tstep + (size_t)nxt.k0 * kstepB : cB;
        const int nt = cur.nt;
        for (int t = 0; t < nt; t += 2) {
            const bool last = (t == nt - 2);
            const char* a1 = cA + (size_t)(t + 1) * kstepA;
            const char* a2 = last ? nA : cA + (size_t)(t + 2) * kstepA; const char* b2 = last ? nB : cB + (size_t)(t + 2) * kstepB;
            const char* a3 = a2 + kstepA; const char* b3 = b2 + kstepB;
            if (last && has_next) S.a_ready(nxt);
            if constexpr (SP2) {
            PG8_LDB(B0, 0, 0); PG8_LDB(B1, 0, 1); PG8_SCHED; PG8_LDA(At, 0, 0); PG8_STAGE(PG8_SA(1, 1), a1 + hstepA, voffA);
            PG8_WAIT_V(8); PG8_WAIT_L(0); PG8_BAR; PG8_MMA(0, 0, At, B0); PG8_MMA(0, 1, At, B1); PG8_BAR; PG8_SCHED;
            PG8_LDA(At, 0, 1); PG8_STAGE(PG8_SB(0, 0), b2, voffB); PG8_STAGE(PG8_SB(0, 1), b2 + hstepB, voffB); PG8_STAGE(PG8_SA(0, 0), a2, voffA);
            PG8_WAIT_V(8); PG8_WAIT_L(0); PG8_BAR; PG8_MMA(1, 0, At, B0); PG8_MMA(1, 1, At, B1); PG8_BAR; PG8_SCHED;
            PG8_LDB(B0, 1, 0); PG8_LDB(B1, 1, 1); PG8_SCHED; PG8_LDA(At, 1, 0); PG8_STAGE(PG8_SA(0, 1), a2 + hstepA, voffA);
            PG8_WAIT_V(8); PG8_WAIT_L(0); PG8_BAR; PG8_MMA(0, 0, At, B0); PG8_MMA(0, 1, At, B1); PG8_BAR; PG8_SCHED;
            PG8_LDA(At, 1, 1); PG8_STAGE(PG8_SB(1, 0), b3, voffB); PG8_STAGE(PG8_SB(1, 1), b3 + hstepB, voffB); PG8_STAGE(PG8_SA(1, 0), a3, voffA);
            PG8_WAIT_V(8); PG8_WAIT_L(0); PG8_BAR; PG8_MMA(1, 0, At, B0); PG8_MMA(1, 1, At, B1); PG8_BAR; PG8_SCHED;
            } else {
            PG8_LDB(B0, 0, 0); PG8_SCHED; PG8_LDA(At, 0, 0); PG8_STAGE(PG8_SA(1, 1), a1 + hstepA, voffA);
            PG8_WAIT_L(8); PG8_BAR; PG8_WAIT_L(0); PG8_MMA(0, 0, At, B0); PG8_BAR; PG8_SCHED;
            PG8_LDB(B1, 0, 1); PG8_STAGE(PG8_SB(0, 0), b2, voffB);
            PG8_BAR; PG8_WAIT_L(0); PG8_MMA(0, 1, At, B1); PG8_BAR;
            PG8_LDA(At, 0, 1); PG8_STAGE(PG8_SA(0, 0), a2, voffA);
            PG8_BAR; PG8_WAIT_L(0); PG8_MMA(1, 0, At, B0); PG8_BAR; PG8_SCHED;
            PG8_STAGE(PG8_SB(0, 1), b2 + hstepB, voffB);
            PG8_WAIT_V(6); PG8_BAR; PG8_MMA(1, 1, At, B1); PG8_BAR;
            PG8_LDB(B0, 1, 0); PG8_SCHED; PG8_LDA(At, 1, 0); PG8_STAGE(PG8_SA(0, 1), a2 + hstepA, voffA);
            PG8_WAIT_L(8); PG8_BAR; PG8_WAIT_L(0); PG8_MMA(0, 0, At, B0); PG8_BAR; PG8_SCHED;
            PG8_LDB(B1, 1, 1); PG8_STAGE(PG8_SB(1, 0), b3, voffB);
            PG8_BAR; PG8_WAIT_L(0); PG8_MMA(0, 1, At, B1); PG8_BAR;
            PG8_LDA(At, 1, 1); PG8_STAGE(PG8_SA(1, 0), a3, voffA);
            PG8_BAR; PG8_WAIT_L(0); PG8_MMA(1, 0, At, B0); PG8_BAR; PG8_SCHED;
            PG8_STAGE(PG8_SB(1, 1), b3 + hstepB, voffB);
            PG8_WAIT_V(6); PG8_BAR; PG8_MMA(1, 1, At, B1); PG8_BAR;
            }
        }
        if constexpr (ALIGN_EPI) { if (wr == 0) PG8_BAR; }
        if constexpr (!Epi::AFTER_DRAIN) {
            if (partial != nullptr) {
                int tid_o = tid; asm volatile("" : "+v"(tid_o));
                const unsigned pb = (unsigned)cur.slot * 262144u + (cur.slot >= pslot_split ? pslot_gap : 0u) + (unsigned)tid_o * 16u;
                const bool m2 = cur.mode == 2;
                if (m2) {
                    unsigned spins = 0;
                    for (;;) { unsigned ok = 1u;
#pragma unroll
                        for (int p = 0; p < NPART; ++p) if (p < cur.npart) ok &= (__hip_atomic_load(flags + (cur.slot + p) * 8 + wid, __ATOMIC_RELAXED, __HIP_MEMORY_SCOPE_AGENT) != 0u) ? 1u : 0u;
                        if (__builtin_amdgcn_readfirstlane(ok) != 0u) break;
                        __builtin_amdgcn_s_sleep(8); if (++spins > (1u << 22)) break; }
                }
#pragma unroll 1
                for (int p = 0; p < (m2 ? cur.npart : 0); ++p) {
                    const __amdgpu_buffer_rsrc_t prl = __builtin_amdgcn_make_buffer_rsrc(partial, 0, 0x7fffffff, 0x00020000);
                    const unsigned pbp = pb + (unsigned)p * 262144u;
#pragma unroll
                    for (int a = 0; a < 2; ++a) { u32x4 pv_[2][4];
#pragma unroll
                        for (int b = 0; b < 2; ++b)
#pragma unroll
                            for (int m = 0; m < 4; ++m) pv_[b][m] = __builtin_amdgcn_raw_buffer_load_b128(prl, pbp, ((a * 2 + b) * 4 + m) * 8192, 16);
#pragma unroll
                        for (int b = 0; b < 2; ++b)
#pragma unroll
                            for (int m = 0; m < 4; ++m) { const u32x4 w = pv_[b][m];
                                acc[a][b][m][0] += (f32x4){__builtin_bit_cast(float, w.x << 16), __builtin_bit_cast(float, w.x & 0xffff0000u), __builtin_bit_cast(float, w.y << 16), __builtin_bit_cast(float, w.y & 0xffff0000u)};
                                acc[a][b][m][1] += (f32x4){__builtin_bit_cast(float, w.z << 16), __builtin_bit_cast(float, w.z & 0xffff0000u), __builtin_bit_cast(float, w.w << 16), __builtin_bit_cast(float, w.w & 0xffff0000u)}; }
                        asm volatile("" ::: "memory"); }
                }
            }
            {
                if (partial != nullptr && cur.mode == 1) {
                    int tid_o = tid; asm volatile("" : "+v"(tid_o));
                    const unsigned pb = (unsigned)cur.slot * 262144u + (cur.slot >= pslot_split ? pslot_gap : 0u) + (unsigned)tid_o * 16u;
                    const __amdgpu_buffer_rsrc_t pr_ = __builtin_amdgcn_make_buffer_rsrc(partial, 0, 0x7fffffff, 0x00020000);
#pragma unroll
                    for (int a = 0; a < 2; ++a)
#pragma unroll
                        for (int b = 0; b < 2; ++b)
#pragma unroll
                            for (int m = 0; m < 4; ++m) { const u32x2 lo = pack4(acc[a][b][m][0]), hi = pack4(acc[a][b][m][1]); u32x4 w; w.x = lo.x; w.y = lo.y; w.z = hi.x; w.w = hi.y;
                                __builtin_amdgcn_raw_buffer_store_b128(w, pr_, pb, ((a * 2 + b) * 4 + m) * 8192, 16); }
                    asm volatile("s_waitcnt vmcnt(0)" ::: "memory");
                    if (lane == 0) __hip_atomic_store(flags + cur.slot * 8 + wid, 1u, __ATOMIC_RELAXED, __HIP_MEMORY_SCOPE_AGENT);
                } else E(acc, cur, ui, wr, wc, fr, fq);
            }
            S.done(cur);
        }
        if (!has_next) break;
#pragma unroll
        for (int a = 0; a < 2; ++a)
#pragma unroll
            for (int b = 0; b < 2; ++b)
#pragma unroll
                for (int m = 0; m < 4; ++m)
#pragma unroll
                    for (int n = 0; n < 2; ++n) acc[a][b][m][n] = (f32x4){0.f, 0.f, 0.f, 0.f};
        cur = nxt; cA = nA; cB = nB; ++ui;
        if constexpr (ALIGN_EPI) { if (wr == 1) PG8_BAR; }
    }
    PG8_WAIT_V(0);
    if constexpr (!ALIGN_EPI) { if (wr == 0) PG8_BAR; }
    PG8_BAR;
    if constexpr (Epi::AFTER_DRAIN) { E.fused(acc, cur, wr, wc, fr, fq, lds, wid, lane); S.done(cur); }
#undef PG8_SA
#undef PG8_SB
#undef PG8_STAGE
#undef PG8_LDA
#undef PG8_LDB
#undef PG8_MMA
#undef PG8_WAIT_V
#undef PG8_WAIT_L
#undef PG8_BAR
#undef PG8_SCHED
}
}

#define GAS __attribute__((address_space(1)))
#define LAS __attribute__((address_space(3)))
typedef unsigned short bf16;
typedef unsigned v4u __attribute__((ext_vector_type(4)));
typedef float f32x4 __attribute__((ext_vector_type(4)));
typedef short bf16x8 __attribute__((ext_vector_type(8)));
typedef GAS unsigned gu32;
typedef GAS unsigned long long gu64;
#define RLX_AGENT __ATOMIC_RELAXED, __HIP_MEMORY_SCOPE_AGENT
#define LBAR() asm volatile("s_waitcnt lgkmcnt(0)\n\ts_barrier" ::: "memory")
#define LDS_WAIT() asm volatile("s_waitcnt lgkmcnt(0)" ::: "memory")
#define VM_WAIT() asm volatile("s_waitcnt vmcnt(0)" ::: "memory")
__device__ __forceinline__ unsigned long long rt() { return __builtin_amdgcn_s_memrealtime(); }
__device__ __forceinline__ unsigned f2bf(float f) { unsigned u = __builtin_bit_cast(unsigned, f); return (u + 0x7fffu + ((u >> 16) & 1u)) >> 16; }
__device__ __forceinline__ unsigned pk2(float lo, float hi) { return f2bf(lo) | (f2bf(hi) << 16); }

#define XB_TMO      128
#define XB_XCNT(j)  (256  + 64 * (j))
#define XB_XSUB(j)  (1280 + 64 * (j))
#define XB_XGEN(j)  (2304 + 64 * (j))
#define XB_TOP      3328
#define XB_TOPGEN   3392
#define XCD_BAR_WORDS 3456
#define XB_SPIN_CAP (1u << 18)

__device__ __forceinline__ unsigned xb_ld(unsigned* p)              { return __hip_atomic_load(p, __ATOMIC_RELAXED, __HIP_MEMORY_SCOPE_AGENT); }
__device__ __forceinline__ unsigned xb_add(unsigned* p, unsigned v) { return __hip_atomic_fetch_add(p, v, __ATOMIC_RELAXED, __HIP_MEMORY_SCOPE_AGENT); }
__device__ __forceinline__ unsigned xb_xcc_id() { return (unsigned)__builtin_amdgcn_s_getreg((3 << 11) | 20) & 0xFu; }
#define XB_SPIN(cond, bar) do { unsigned _sp = 0; while (cond) { __builtin_amdgcn_s_sleep(1); \
    if ((++_sp & 255u) == 0u) { if (xb_ld(&(bar)[XB_TMO])) break; if (_sp > XB_SPIN_CAP) { atomicAdd(&(bar)[XB_TMO], 1u); break; } } } } while (0)

struct XcdBarrier {
    unsigned* bar; unsigned x;
    volatile LAS unsigned* st;
};

__device__ __forceinline__ XcdBarrier xcd_barrier_post(unsigned* bar, volatile LAS unsigned* st) {
    XcdBarrier b; b.bar = bar; b.x = xb_xcc_id(); b.st = st;
    if (threadIdx.x == 0) (void)xb_add(&bar[XB_XCNT(b.x)], 1u);
    return b;
}
__device__ __forceinline__ void xcd_barrier_complete(unsigned* bar, unsigned x, unsigned& nloc, unsigned& nx) {
    const unsigned G = gridDim.x * gridDim.y * gridDim.z;
    unsigned sum, cnt, mine, sp = 0u;
    for (;;) {
        sum = 0u; cnt = 0u; mine = 0u;
#pragma unroll
        for (unsigned j = 0; j < 16; ++j) { const unsigned c = xb_ld(&bar[XB_XCNT(j)]); sum += c; cnt += (c > 0u) ? 1u : 0u; mine = (j == x) ? c : mine; }
        if (sum == G) break;
        __builtin_amdgcn_s_sleep(1);
        if ((++sp & 255u) == 0u) { if (xb_ld(&bar[XB_TMO])) break; if (sp > XB_SPIN_CAP) { atomicAdd(&bar[XB_TMO], 1u); break; } }
    }
    nloc = mine > 0u ? mine : 1u; nx = cnt > 0u ? cnt : 1u;
}

__device__ __forceinline__ void xcd_barrier(const XcdBarrier& b) {
    asm volatile("s_waitcnt vmcnt(0)" ::: "memory");
    __syncthreads();
    if (threadIdx.x == 0) {
        unsigned* bar = b.bar;
        __builtin_amdgcn_s_waitcnt(0);
        unsigned nloc = b.st[0], nx = b.st[1];
        if (nloc == 0u) { xcd_barrier_complete(bar, b.x, nloc, nx); b.st[0] = nloc; b.st[1] = nx; }
        const unsigned old = xb_add(&bar[XB_XSUB(b.x)], 1u);
        const unsigned gen = old / nloc;
        if (old + 1u == (gen + 1u) * nloc) {
            __builtin_amdgcn_fence(__ATOMIC_RELEASE, "agent");
            asm volatile("s_waitcnt vmcnt(0)" ::: "memory");
            const unsigned og = xb_add(&bar[XB_TOP], 1u);
            const unsigned tg = og / nx;
            if (og + 1u == (tg + 1u) * nx) xb_add(&bar[XB_TOPGEN], 1u);
            else XB_SPIN(xb_ld(&bar[XB_TOPGEN]) == tg, bar);
            __builtin_amdgcn_fence(__ATOMIC_ACQUIRE, "agent");
            xb_add(&bar[XB_XGEN(b.x)], 1u);
            asm volatile("s_waitcnt vmcnt(0)" ::: "memory");
        } else {
            XB_SPIN(xb_ld(&bar[XB_XGEN(b.x)]) == gen, bar);
            __builtin_amdgcn_fence(__ATOMIC_ACQUIRE, "agent");
            asm volatile("s_waitcnt vmcnt(0)" ::: "memory");
        }
    }
    __syncthreads();
}

constexpr int NWAVES = 8;
constexpr int DM = 2048, NPROMPT = 4096, NSAMPLE = 8192, MROWS = 12288, DFF = 8192, INC = 7200, NMOD = 12288;
constexpr float EPS = 1e-6f;
constexpr size_t MiB = 1u << 20;
constexpr size_t WS_CTL = 0, CTL_ZERO_BYTES = 128 * 1024;
constexpr size_t WS_MOD = 1 * MiB;
constexpr size_t WS_C2 = WS_MOD + 9 * 12288 * 4;
constexpr size_t WS_ROPE = WS_C2 + 9 * 8192 * 4;
constexpr size_t WS_PART = 2 * MiB, WS_PART2 = 4 * MiB, WS_AB = 6 * MiB;
constexpr size_t WS_EVEC = 8 * MiB;
constexpr size_t WS_WOUT = 12 * MiB, WS_WFF1 = 20 * MiB, WS_WFF2 = 52 * MiB, WS_WIN = 84 * MiB;
constexpr size_t WS_QHAT = 84 * MiB;
constexpr size_t WS_KS = 113 * MiB, WS_VS = 137 * MiB;
constexpr size_t WS_QKVB = 161 * MiB;
constexpr size_t WS_HB = 113 * MiB;
constexpr size_t WS_OF = 161 * MiB;
constexpr size_t WS_HW = 161 * MiB;
constexpr size_t WS_MIX = 233 * MiB;
constexpr size_t WS_KHT = 281 * MiB;
constexpr size_t WS_XN = 305 * MiB;
constexpr size_t WS_NW = 305 * MiB;
constexpr size_t WS_U = 353 * MiB;
constexpr size_t WS_INTRA = 401 * MiB;
constexpr size_t WS_FF = 209 * MiB;
constexpr size_t WS_END = 425 * MiB;
static_assert(WS_ROPE + 2048 * 4 <= WS_PART && WS_EVEC + 3072 * 192 * 4 <= WS_WOUT && WS_WIN + (size_t)INC * DM * 2 <= WS_KS && WS_FF + (size_t)MROWS * DFF * 2 <= WS_INTRA + 24 * MiB, "ws map");
static_assert(WS_HW + 48 * MiB <= WS_FF, "HW below FF");
constexpr size_t YO_QA = 0, YO_GATE = 24 * MiB, YO_KP = 48 * MiB, YO_VP = 56 * MiB, YO_OF = 48 * MiB, YO_OB = 72 * MiB;
constexpr size_t OUT_Y = 0, OUT_K = 25165824, OUT_V = OUT_K + 4194304, OUT_S = OUT_V + 4194304;
constexpr int CW_TMO = 0, CW_BAR = 4096, CW_FLAG = 16384, CW_PANEL = 20480, CW_PAIR = 24576;
constexpr int RING_OFF = 0, RING_BYTES = 131072, P0_SCR_BYTES = 8 * 16640, RSTD_OFF = 135168, LDSCTL_OFF = 146432, MISC_OFF = LDSCTL_OFF + 320, LDS_BYTES = 147456;
static_assert(P0_SCR_BYTES <= RSTD_OFF && RSTD_OFF + 6 * 256 * 4 <= LDSCTL_OFF && MISC_OFF + 128 <= LDS_BYTES, "LDS map");

typedef unsigned short bf16;
typedef unsigned u32x2 __attribute__((ext_vector_type(2)));
typedef float f32x16 __attribute__((ext_vector_type(16)));
typedef short s16x4 __attribute__((ext_vector_type(4)));
__device__ __forceinline__ float bf2f(unsigned short v) { return __builtin_bit_cast(float, (unsigned)v << 16); }
__device__ __forceinline__ float bflo(unsigned w) { return __builtin_bit_cast(float, w << 16); }
__device__ __forceinline__ float bfhi(unsigned w) { return __builtin_bit_cast(float, w & 0xffff0000u); }
__device__ __forceinline__ unsigned cvtpk(float lo, float hi) { return pg8::cvt_pk_bf16(lo, hi); }
__device__ __forceinline__ float wave_sum(float v) {
#pragma unroll
    for (int o = 1; o < 64; o <<= 1) v += __shfl_xor(v, o);
    return v;
}
__device__ __forceinline__ int crow(int r, int hi) { return (r & 3) + 8 * (r >> 2) + 4 * hi; }
__device__ __forceinline__ float silu_f(float x) { return x * __builtin_amdgcn_rcpf(1.0f + __expf(-x)); }

struct Frame {
    LAS unsigned char* lds; unsigned char* ldsg;
    volatile LAS unsigned* MISC;
    gu32* ctl;
    int tid, lane, wave, vcu, G;
    const float* const* inp; float* out; unsigned char* ws;
};

struct TileSrc { const float* src; bf16* dst; int K, N, n0; bool cval; };
__device__ __forceinline__ TileSrc p0_tile(Frame& F, int it, int lane) {
    constexpr int I_IN = (DM / 64) * ((INC + 63) / 64), I_OUT = (DM / 64) * (DM / 64), I_F1 = (DM / 64) * (DFF / 64);
    const float* W; bf16* WT; int K, N; int r = it;
    if (r < I_IN) { W = F.inp[10]; WT = (bf16*)(F.ws + WS_WIN); K = DM; N = INC; }
    else if ((r -= I_IN) < I_OUT) { W = F.inp[17]; WT = (bf16*)(F.ws + WS_WOUT); K = DM; N = DM; }
    else if ((r -= I_OUT) < I_F1) { W = F.inp[19]; WT = (bf16*)(F.ws + WS_WFF1); K = DM; N = DFF; }
    else { r -= I_F1; W = F.inp[20]; WT = (bf16*)(F.ws + WS_WFF2); K = DFF; N = DM; }
    const int nblk = (N + 63) / 64, kb = r / nblk, nb = r % nblk, k0 = 64 * kb, n0 = 64 * nb; const int c = 4 * (lane & 15);
    TileSrc t; t.src = W + (size_t)(k0 + (lane >> 4)) * N + n0 + c; t.dst = WT + (size_t)((n0 >> 8) * (K >> 6) + kb) * 16384; t.K = K;     t.N = N; t.n0 = n0; t.cval = (n0 + c) < N; return t;
}
__device__ __forceinline__ void p0_tile_load(Frame& F, int it, int lane, f32x4 (&v)[16]) {
    const TileSrc t = p0_tile(F, it, lane);
    const float* p = t.src; const size_t step = (size_t)4 * t.N;
#pragma unroll
    for (int i = 0; i < 16; ++i) { v[i] = (f32x4){0.f, 0.f, 0.f, 0.f}; if (t.cval) v[i] = __builtin_nontemporal_load((const f32x4*)p); p += step; asm volatile("" : "+v"(p)); }
}
__device__ __forceinline__ void p0_tile_store(Frame& F, int it, const f32x4 (&v)[16], LAS float* scr, int lane) {
    const TileSrc t = p0_tile(F, it, lane);
    const int c = 4 * (lane & 15);
#pragma unroll
    for (int i = 0; i < 16; ++i) { LAS float* d = scr + (4 * i + (lane >> 4)) * 65 + c; d[0] = v[i][0]; d[1] = v[i][1]; d[2] = v[i][2]; d[3] = v[i][3]; }
    LDS_WAIT(); asm volatile("" ::: "memory");
    const int c8 = lane & 7;
#pragma unroll
    for (int j = 0; j < 8; ++j) { const int n = (lane >> 3) + 8 * j; const LAS float* s_ = scr + (8 * c8) * 65 + n;
        v4u o; o.x = cvtpk(s_[0 * 65], s_[1 * 65]); o.y = cvtpk(s_[2 * 65], s_[3 * 65]); o.z = cvtpk(s_[4 * 65], s_[5 * 65]); o.w = cvtpk(s_[6 * 65], s_[7 * 65]);
        const int nb_ = (t.n0 & 255) + n, ri_ = (nb_ & 96) + pg8::perm32inv(nb_ & 31);
        bf16* dp_ = t.dst + (nb_ >> 7) * 8192 + (pg8::lds_byte(ri_, 8 * c8) >> 1);
        if (t.n0 + n < t.N) { if (t.N == INC) *(GAS v4u*)dp_ = o; else __builtin_nontemporal_store(o, (GAS v4u*)dp_); }
        if (j & 1) __builtin_amdgcn_sched_barrier(0); }
    LDS_WAIT(); asm volatile("" ::: "memory");
}
__device__ __forceinline__ void p0_phase(Frame& F) {
    const float* c_lat = F.inp[5]; const float* c_ctx = F.inp[6]; const float* w_mod = F.inp[7]; const float* b_mod = F.inp[8];
    float* MOD = (float*)(F.ws + WS_MOD);
    const int bid = F.vcu;
    if (bid < 192) {
        LAS float* sil = (LAS float*)(F.lds);
        LAS float* red = (LAS float*)(F.lds + 9 * 2048 * 4);
        for (int idx = F.tid; idx < 9 * 2048; idx += 512) { const int b = idx >> 11, k = idx & 2047; const float cv = (b == 0) ? c_ctx[k] : c_lat[(b - 1) * 2048 + k]; sil[idx] = silu_f(cv); }
        __syncthreads();
        const int c0 = 64 * bid + 4 * (F.lane & 15);
        f32x4 acc[9];
#pragma unroll
        for (int b = 0; b < 9; ++b) acc[b] = (f32x4){0.f, 0.f, 0.f, 0.f};
        const int kbase = 256 * F.wave + (F.lane >> 4);
        for (int it0 = 0; it0 < 64; it0 += 16) {
            f32x4 wv[16];
#pragma unroll
            for (int u = 0; u < 16; ++u) wv[u] = __builtin_nontemporal_load((const f32x4*)(w_mod + (size_t)(kbase + 4 * (it0 + u)) * NMOD + c0));
#pragma unroll
            for (int u = 0; u < 16; ++u) { const int k = kbase + 4 * (it0 + u);
#pragma unroll
                for (int b = 0; b < 9; ++b) { const float s_ = sil[b * 2048 + k]; acc[b] += wv[u] * s_; }
                if ((u & 1) == 1) __builtin_amdgcn_sched_barrier(0); }
        }
#pragma unroll
        for (int b = 0; b < 9; ++b)
#pragma unroll
            for (int e = 0; e < 4; ++e) { float v = acc[b][e]; v += __shfl_xor(v, 16); v += __shfl_xor(v, 32); acc[b][e] = v; }
        if (F.lane < 16) {
#pragma unroll
            for (int b = 0; b < 9; ++b)
#pragma unroll
                for (int e = 0; e < 4; ++e) red[(F.wave * 9 + b) * 64 + 4 * F.lane + e] = acc[b][e]; }
        __syncthreads();
        for (int idx = F.tid; idx < 9 * 64; idx += 512) { const int b = idx >> 6, cc = idx & 63; float s_ = b_mod[64 * bid + cc];
#pragma unroll
            for (int w = 0; w < 8; ++w) s_ += red[(w * 9 + b) * 64 + cc];
            MOD[b * NMOD + 64 * bid + cc] = s_; }
        __syncthreads();
    } else if (bid == 255) { float* rope = (float*)(F.ws + WS_ROPE);
        for (int idx = F.tid; idx < 1024; idx += 512) { const int pos = idx >> 4, i = idx & 15; const float inv = 1.0f / powf(10000.0f, (float)i * (1.0f / 16.0f)); const float ang = (float)pos * inv;
            rope[idx] = cosf(ang); rope[1024 + idx] = sinf(ang); } }
    const int myslots = (bid < 192) ? 5 : 7;
    const int slot0 = (bid < 192) ? (bid * NWAVES + F.wave) * 5 : 192 * NWAVES * 5 + ((bid - 192) * NWAVES + F.wave) * 7;
    constexpr int NSLOT = 192 * NWAVES * 5 + 64 * NWAVES * 7;
    {
        LAS float* scr = (LAS float*)(F.lds + F.wave * 16640);
        constexpr int NITEMS = (DM / 64) * ((INC + 63) / 64) + (DM / 64) * (DM / 64) + (DM / 64) * (DFF / 64) + (DFF / 64) * (DM / 64);
        f32x4 ta[16], tb[16];
        const int gw_ = bid * NWAVES + F.wave, NGW_ = F.G * NWAVES;
#define P0_ITEM(q) (gw_ + NGW_ * (q))
        int q = 0; int ia = P0_ITEM(0);
        if (ia < NITEMS) { p0_tile_load(F, ia, F.lane, ta);
            for (;;) {
                const int ib = P0_ITEM(q + 1); const bool hb = ib < NITEMS;
                if (hb) p0_tile_load(F, ib, F.lane, tb);
                p0_tile_store(F, ia, ta, scr, F.lane);
                if (!hb) break;
                const int ic = P0_ITEM(q + 2); const bool hc = ic < NITEMS;
                if (hc) p0_tile_load(F, ic, F.lane, ta);
                p0_tile_store(F, ib, tb, scr, F.lane);
                if (!hc) break;
                q += 2; ia = ic;
            }
        }
#undef P0_ITEM
    }
    {
        const float* ck = F.inp[2]; const float* cv = F.inp[3];
        bf16* KS = (bf16*)(F.ws + WS_KS); bf16* VS = (bf16*)(F.ws + WS_VS);
        for (int s_ = 0; s_ < myslots; ++s_)
            for (int base = slot0 + s_; base < 2 * 8192; base += 4 * NSLOT) {
                f32x4 a[4], b[4];
#pragma unroll
                for (int u = 0; u < 4; ++u) { const int it = base + u * NSLOT; if (it < 2 * 8192) { const bool isV = it >= 8192; const int j = isV ? it - 8192 : it; const float* src = (isV ? cv : ck) + (size_t)j * 512 + 8 * F.lane; a[u] = __builtin_nontemporal_load((const f32x4*)src); b[u] = __builtin_nontemporal_load((const f32x4*)(src + 4)); } }
#pragma unroll
                for (int u = 0; u < 4; ++u) { const int it = base + u * NSLOT; if (it < 2 * 8192) { const bool isV = it >= 8192; const int j = isV ? it - 8192 : it;
                    const size_t e0 = (size_t)j * 512 + 8 * F.lane; const int bh = (int)(e0 >> 16); const size_t rem = e0 & 65535;
                    v4u o; o.x = cvtpk(a[u][0], a[u][1]); o.y = cvtpk(a[u][2], a[u][3]); o.z = cvtpk(b[u][0], b[u][1]); o.w = cvtpk(b[u][2], b[u][3]);
                    __builtin_nontemporal_store(o, (GAS v4u*)((isV ? VS : KS) + (size_t)bh * 1536 * 128 + rem)); } }
            }
    }
}
__device__ __forceinline__ float wsum64(float v) {
    v += __builtin_bit_cast(float, __builtin_amdgcn_update_dpp(0, __builtin_bit_cast(int, v), 0xB1, 0xf, 0xf, true));
    v += __builtin_bit_cast(float, __builtin_amdgcn_update_dpp(0, __builtin_bit_cast(int, v), 0x4E, 0xf, 0xf, true));
    v += __builtin_bit_cast(float, __builtin_amdgcn_update_dpp(0, __builtin_bit_cast(int, v), 0x141, 0xf, 0xf, true));
    v += __builtin_bit_cast(float, __builtin_amdgcn_update_dpp(0, __builtin_bit_cast(int, v), 0x140, 0xf, 0xf, true));
    const int b = __builtin_bit_cast(int, v);
    return __builtin_bit_cast(float, __builtin_amdgcn_readlane(b, 0)) + __builtin_bit_cast(float, __builtin_amdgcn_readlane(b, 16)) + __builtin_bit_cast(float, __builtin_amdgcn_readlane(b, 32)) + __builtin_bit_cast(float, __builtin_amdgcn_readlane(b, 48));
}
__device__ __forceinline__ void p1_phase(Frame& F) {
    const float* MOD = (const float*)(F.ws + WS_MOD); const float* norm1 = F.inp[9];
    bf16* XN = (bf16*)(F.ws + WS_XN);
    const int gw = F.vcu * NWAVES + F.wave, NGW = F.G * NWAVES;
    {
        const bf16* W1t = (const bf16*)(F.ws + WS_WFF1); float* C2 = (float*)(F.ws + WS_C2);
        const int n = F.lane & 15, g = F.lane >> 4;
        LAS float* red = (LAS float*)F.lds;
        for (int id = F.vcu; id < DFF / 16; id += F.G) {
            const int f_ = id * 16 + n;
            const int fb_ = f_ & 255, fri_ = (fb_ & 96) + pg8::perm32inv(fb_ & 31);
            const bf16* bp = W1t + (size_t)((f_ >> 8) * 32 + 4 * F.wave) * 16384 + (fb_ >> 7) * 8192;
            const float* ap = MOD + (size_t)(n < 9 ? n : 0) * NMOD + 3 * DM + 256 * F.wave + 8 * g;
            f32x4 acc = {0.f, 0.f, 0.f, 0.f};
#pragma unroll
            for (int st = 0; st < 8; ++st) {
                const bf16x8 bfr = *(const bf16x8*)(bp + (st >> 1) * 16384 + (pg8::lds_byte(fri_, 32 * (st & 1) + 8 * g) >> 1));
                f32x4 a0 = *(const f32x4*)(ap + 32 * st), a1 = *(const f32x4*)(ap + 32 * st + 4);
                if (n >= 9) { a0 = (f32x4){0.f, 0.f, 0.f, 0.f}; a1 = a0; }
                v4u aw; aw.x = cvtpk(a0[0], a0[1]); aw.y = cvtpk(a0[2], a0[3]); aw.z = cvtpk(a1[0], a1[1]); aw.w = cvtpk(a1[2], a1[3]);
                acc = __builtin_amdgcn_mfma_f32_16x16x32_bf16(__builtin_bit_cast(bf16x8, aw), bfr, acc, 0, 0, 0);
            }
#pragma unroll
            for (int r = 0; r < 4; ++r) red[(F.wave * 16 + 4 * g + r) * 17 + n] = acc[r];
            __syncthreads();
            if (F.tid < 9 * 16) { const int mb = F.tid >> 4, cc = F.tid & 15; float v = 0.f;
#pragma unroll
                for (int w = 0; w < 8; ++w) v += red[(w * 16 + mb) * 17 + cc];
                C2[mb * DFF + id * 16 + cc] = v; }
            __syncthreads();
        }
    }
    {
        const int rpw = (MROWS + NGW - 1) / NGW; const int row0 = gw * rpw; const int rend = (row0 + rpw) < MROWS ? (row0 + rpw) : MROWS;
        int lane = F.lane; asm volatile("" : "+v"(lane));
        f32x4 v[8], vn[8], gsv[8], bv[8]; int cmb = -1;
        if (row0 < rend) { const float* xr = (row0 < NPROMPT ? F.inp[0] + (size_t)row0 * DM : F.inp[1] + (size_t)(row0 - NPROMPT) * DM) + 8 * lane;
#pragma unroll
            for (int j = 0; j < 4; ++j) { v[2 * j] = __builtin_nontemporal_load((const f32x4*)(xr + 512 * j)); v[2 * j + 1] = __builtin_nontemporal_load((const f32x4*)(xr + 512 * j + 4)); } }
        for (int row = row0; row < rend; ++row) {
            const int nrow = row + 1;
            if (nrow < rend) { const float* xr = (nrow < NPROMPT ? F.inp[0] + (size_t)nrow * DM : F.inp[1] + (size_t)(nrow - NPROMPT) * DM) + 8 * lane;
#pragma unroll
                for (int j = 0; j < 4; ++j) { vn[2 * j] = __builtin_nontemporal_load((const f32x4*)(xr + 512 * j)); vn[2 * j + 1] = __builtin_nontemporal_load((const f32x4*)(xr + 512 * j + 4)); } }
            const int mb = row < NPROMPT ? 0 : 1 + ((row - NPROMPT) >> 10);
            if (mb != cmb) { cmb = mb; const float* sh1 = MOD + mb * NMOD + 8 * lane; const float* sc1 = sh1 + DM; const float* n1 = norm1 + 8 * lane;
#pragma unroll
                for (int j = 0; j < 8; ++j) { const int k = 512 * (j >> 1) + 4 * (j & 1); const f32x4 g = *(const f32x4*)(n1 + k), s_ = *(const f32x4*)(sc1 + k); gsv[j] = g * (s_ + 1.0f); bv[j] = *(const f32x4*)(sh1 + k); } }
            float ss = 0.f;
#pragma unroll
            for (int j = 0; j < 8; ++j) ss += (v[j][0] * v[j][0] + v[j][1] * v[j][1]) + (v[j][2] * v[j][2] + v[j][3] * v[j][3]);
            const float rstd = rsqrtf(wsum64(ss) * (1.0f / DM) + EPS);
            bf16* xo = XN + (size_t)row * DM + 8 * lane;
#pragma unroll
            for (int j = 0; j < 4; ++j) { const f32x4 o0 = v[2 * j] * rstd * gsv[2 * j] + bv[2 * j], o1 = v[2 * j + 1] * rstd * gsv[2 * j + 1] + bv[2 * j + 1];
                v4u w; w.x = cvtpk(o0[0], o0[1]); w.y = cvtpk(o0[2], o0[3]); w.z = cvtpk(o1[0], o1[1]); w.w = cvtpk(o1[2], o1[3]); *(GAS v4u*)(xo + 512 * j) = w; }
#pragma unroll
            for (int j = 0; j < 8; ++j) v[j] = vn[j];
        }
    }
}
__device__ __forceinline__ void p2_ab(Frame& F) {
    const bf16* XN = (const bf16*)(F.ws + WS_XN); const bf16* Wab = (const bf16*)(F.ws + WS_WIN) + (size_t)28 * 32 * 16384;   float* AB = (float*)(F.ws + WS_AB);
    const int r32 = F.lane & 31, hi = F.lane >> 5;
    LAS float* red = (LAS float*)F.lds;
    for (int rb = F.vcu; rb < MROWS / 32; rb += F.G) {
        const bf16* ap = XN + (size_t)(rb * 32 + r32) * DM + 256 * F.wave + 8 * hi; const bf16* bp = Wab + (size_t)(4 * F.wave) * 16384; const int bri = pg8::perm32inv(r32);
        f32x16 acc = {};
#pragma unroll
        for (int s_ = 0; s_ < 16; ++s_) { const bf16x8 a = *(const bf16x8*)(ap + 16 * s_), b = *(const bf16x8*)(bp + (s_ >> 2) * 16384 + (pg8::lds_byte(bri, 16 * (s_ & 3) + 8 * hi) >> 1)); acc = __builtin_amdgcn_mfma_f32_32x32x16_bf16(a, b, acc, 0, 0, 0); }
#pragma unroll
        for (int r = 0; r < 16; ++r) red[(F.wave * 32 + crow(r, hi)) * 33 + r32] = acc[r];
        __syncthreads();
        for (int o = F.tid; o < 1024; o += 512) { const int row = o >> 5, col = o & 31; float v = 0.f;
#pragma unroll
            for (int w = 0; w < 8; ++w) v += red[(w * 32 + row) * 33 + col];
            AB[(size_t)(rb * 32 + row) * 32 + col] = v; }
        __syncthreads();
    }
}
namespace dattn {
using bf16x8 = __attribute__((ext_vector_type(8))) short;
using u32x4 = __attribute__((ext_vector_type(4))) unsigned;
constexpr int KVBLK = 64; constexpr float SCALE = 0.125f; constexpr float THR = 8.f;
constexpr int SHM_V = 64 * 128 * 2, SHM_K = 64 * 128 * 2;
#define KSWZ(row, colB) ((row) * 256 + ((colB) ^ (((row) & 7) << 4)))
#define SBAR() __builtin_amdgcn_sched_barrier(0)
__device__ __forceinline__ void partialSM(f32x16& p0, f32x16& p1, float& m_reg, float& mn, float& alpha) {
  constexpr float C = SCALE * 1.4426950408889634f;
  float pmax = p0[0];
#pragma unroll
  for (int r = 1; r < 16; ++r) pmax = fmaxf(pmax, p0[r]);
#pragma unroll
  for (int r = 0; r < 16; ++r) pmax = fmaxf(pmax, p1[r]);
  { auto rr = __builtin_amdgcn_permlane32_swap(__float_as_uint(pmax), __float_as_uint(pmax), false, false);
    pmax = fmaxf(__uint_as_float(rr[0]), __uint_as_float(rr[1])); }
  if (__builtin_expect(__all(pmax - m_reg <= THR / SCALE), 1)) { mn = m_reg; alpha = 1.f; }
  else { mn = fmaxf(m_reg, pmax); alpha = __builtin_amdgcn_exp2f((m_reg - mn) * C); m_reg = mn; }
  float mnC = -mn * C;
#pragma unroll
  for (int r = 0; r < 16; ++r) p0[r] = fmaf(p0[r], C, mnC);
#pragma unroll
  for (int r = 0; r < 16; ++r) p1[r] = fmaf(p1[r], C, mnC);
#pragma unroll
  for (int r = 0; r < 16; ++r) p0[r] = __builtin_amdgcn_exp2f(p0[r]);
}
__device__ __forceinline__ void finishSM(f32x16& p0, f32x16& p1, float alpha, float& l_reg, bf16x8& pa0, bf16x8& pa1, bf16x8& pa2, bf16x8& pa3) {
#pragma unroll
  for (int r = 0; r < 16; ++r) p1[r] = __builtin_amdgcn_exp2f(p1[r]);
  float ps = 0;
#pragma unroll
  for (int r = 0; r < 16; ++r) ps += p0[r];
#pragma unroll
  for (int r = 0; r < 16; ++r) ps += p1[r];
  { auto rr = __builtin_amdgcn_permlane32_swap(__float_as_uint(ps), __float_as_uint(ps), false, false);
    ps = __uint_as_float(rr[0]) + __uint_as_float(rr[1]); }
  l_reg = l_reg * alpha + ps;
#define PK4(P, BASE, OUT) do { unsigned a0 = cvtpk(P[BASE + 0], P[BASE + 1]), a1 = cvtpk(P[BASE + 2], P[BASE + 3]);   \
    unsigned b0 = cvtpk(P[BASE + 4], P[BASE + 5]), b1 = cvtpk(P[BASE + 6], P[BASE + 7]);                              \
    auto r0 = __builtin_amdgcn_permlane32_swap(a0, b0, false, false); auto r1 = __builtin_amdgcn_permlane32_swap(a1, b1, false, false); \
    u32x4 w = {r0[0], r1[0], r0[1], r1[1]}; OUT = *reinterpret_cast<bf16x8*>(&w); } while (0)
  PK4(p0, 0, pa0); PK4(p0, 8, pa1); PK4(p1, 0, pa2); PK4(p1, 8, pa3);
#undef PK4
}
__device__ __forceinline__ void qkt(f32x16& p0, f32x16& p1, const bf16* Ks, const bf16x8* qr, int r32, int hi, int map) {
  p0 = f32x16{}; p1 = f32x16{};
#pragma unroll
  for (int d0 = 0; d0 < 4; ++d0) { int cb = (map * 64 + d0 * 16 + hi * 8) * 2;
    bf16x8 b0 = *reinterpret_cast<const bf16x8*>((const char*)Ks + KSWZ(r32, cb));
    bf16x8 b1 = *reinterpret_cast<const bf16x8*>((const char*)Ks + KSWZ(32 + r32, cb));
    p0 = __builtin_amdgcn_mfma_f32_32x32x16_bf16(b0, qr[d0], p0, 0, 0, 0);
    p1 = __builtin_amdgcn_mfma_f32_32x32x16_bf16(b1, qr[d0], p1, 0, 0, 0); }
}
__device__ __forceinline__ int v_st(int k, int c) { const int kk = (k & ~0xC) | ((k & 4) << 1) | ((k & 8) >> 1); return ((kk >> 3) * 4 + (c >> 5)) * 512 + ((kk & 7) * 32 + (c & 31)) * 2; }
__device__ __forceinline__ int v_rd_base(int lane) { return ((lane & 3) << 3) | (((lane >> 2) & 3) << 6) | (((lane >> 4) & 1) << 5) | (((lane >> 5) & 1) << 8); }
constexpr int v_rd_off(int d0, int ks, int half) { return d0 * 512 + ks * 4096 + half * 2048; }
template <int OFF> __device__ __forceinline__ s16x4 tr_read(int vb) {
  s16x4 r; asm volatile("ds_read_b64_tr_b16 %0, %1 offset:%2" : "=&v"(r) : "v"(vb), "i"(OFF) : "memory"); return r;
}
template <int D0> __device__ __forceinline__ void pv_one(f32x16& od, int vb, bf16x8 pa0, bf16x8 pa1, bf16x8 pa2, bf16x8 pa3) {
  const s16x4 l0 = tr_read<v_rd_off(D0, 0, 0)>(vb), h0 = tr_read<v_rd_off(D0, 0, 1)>(vb), l1 = tr_read<v_rd_off(D0, 1, 0)>(vb), h1 = tr_read<v_rd_off(D0, 1, 1)>(vb);
  const s16x4 l2 = tr_read<v_rd_off(D0, 2, 0)>(vb), h2 = tr_read<v_rd_off(D0, 2, 1)>(vb), l3 = tr_read<v_rd_off(D0, 3, 0)>(vb), h3 = tr_read<v_rd_off(D0, 3, 1)>(vb);
  asm volatile("s_waitcnt lgkmcnt(0)" ::: "memory"); SBAR();
#define PK(L, H) (bf16x8){L[0], L[1], L[2], L[3], H[0], H[1], H[2], H[3]}
  od = __builtin_amdgcn_mfma_f32_32x32x16_bf16(pa0, PK(l0, h0), od, 0, 0, 0);
  od = __builtin_amdgcn_mfma_f32_32x32x16_bf16(pa1, PK(l1, h1), od, 0, 0, 0);
  od = __builtin_amdgcn_mfma_f32_32x32x16_bf16(pa2, PK(l2, h2), od, 0, 0, 0);
  od = __builtin_amdgcn_mfma_f32_32x32x16_bf16(pa3, PK(l3, h3), od, 0, 0, 0);
#undef PK
}
__device__ __forceinline__ void pv_d0(f32x16* o, int vb, bf16x8 pa0, bf16x8 pa1, bf16x8 pa2, bf16x8 pa3) {
  pv_one<0>(o[0], vb, pa0, pa1, pa2, pa3); pv_one<1>(o[1], vb, pa0, pa1, pa2, pa3); pv_one<2>(o[2], vb, pa0, pa1, pa2, pa3); pv_one<3>(o[3], vb, pa0, pa1, pa2, pa3);
}
__device__ __forceinline__ void attn_unit(const bf16* __restrict__ Qb, const bf16* __restrict__ Kh, const bf16* __restrict__ Vh, bf16* __restrict__ Ob, int seq, float lam, const float* __restrict__ subln, char* lds) {
  constexpr int LDQ = 1024, LDK = 128;
  const int tid = threadIdx.x, wid = tid >> 6, lane = tid & 63, r32 = lane & 31, hi = lane >> 5;
  const int map = wid >> 2, qw = wid & 3;
  bf16* V_lds = (bf16*)lds; bf16* K_lds = (bf16*)(lds + 2 * SHM_V);
  float* ws = (float*)(lds + 2 * SHM_V + 2 * SHM_K) + wid * 64; float* li_l = ws; float* al_l = ws + 32;
  float m_reg = -1e30f, l_reg = 0; f32x16 o[4] = {}; bf16x8 qr[4];
  const bf16* Qw = Qb + (long)(qw * 32 + r32) * LDQ + map * 64 + hi * 8;
#pragma unroll
  for (int d0 = 0; d0 < 4; ++d0) qr[d0] = *reinterpret_cast<const bf16x8*>(Qw + d0 * 16);
  const int sr = tid >> 4, sc = (tid & 15) * 8, vst0 = v_st(sr, sc), vst1 = v_st(32 + sr, sc);
  const int vb0 = (int)(uintptr_t)V_lds + v_rd_base(lane);
  struct { bf16x8 vs0, vs1, ks0, ks1; } sr_[2];
#define LD8(p) (*reinterpret_cast<const bf16x8*>(p))
#define SLOAD(i, k0) do { sr_[i].vs0 = LD8(&Vh[(long)((k0) + sr) * LDK + sc]); sr_[i].vs1 = LD8(&Vh[(long)((k0) + 32 + sr) * LDK + sc]); \
    sr_[i].ks0 = LD8(&Kh[(long)((k0) + sr) * LDK + sc]); sr_[i].ks1 = LD8(&Kh[(long)((k0) + 32 + sr) * LDK + sc]); } while (0)
#define SWRITE(b, i) do { *(bf16x8*)((char*)V_lds + (b) * SHM_V + vst0) = sr_[i].vs0;          \
    *(bf16x8*)((char*)V_lds + (b) * SHM_V + vst1) = sr_[i].vs1; int kc = sc * 2;               \
    *(bf16x8*)((char*)K_lds + (b) * SHM_K + KSWZ(sr, kc)) = sr_[i].ks0;                       \
    *(bf16x8*)((char*)K_lds + (b) * SHM_K + KSWZ(32 + sr, kc)) = sr_[i].ks1; } while (0)
#define SWAIT() asm volatile("s_waitcnt vmcnt(4)" ::: "memory")
#define RESC(a) do { if (__any((a) < 1.f)) { if (hi == 0) al_l[r32] = (a); asm volatile("s_waitcnt lgkmcnt(0)" ::: "memory"); \
    _Pragma("unroll") for (int d = 0; d < 4; ++d) _Pragma("unroll") for (int r = 0; r < 16; ++r) o[d][r] *= al_l[crow(r, hi)]; } } while (0)
  f32x16 pA0, pA1, pB0, pB1; float mnA, mnB, alA, alB; bf16x8 pa0, pa1, pa2, pa3; const int NT = seq / KVBLK;
  constexpr int SE = 0, SO = 1;
  SLOAD(SE, 0); asm volatile("s_waitcnt vmcnt(0)" ::: "memory"); SWRITE(0, SE); __syncthreads();
  qkt(pA0, pA1, K_lds, qr, r32, hi, map); partialSM(pA0, pA1, m_reg, mnA, alA);
  SLOAD(SO, KVBLK); if (2 < NT) SLOAD(SE, 2 * KVBLK);
  SWAIT(); SWRITE(1, SO); __syncthreads();
  for (int j = 1; j + 1 < NT; j += 2) {
    SBAR(); qkt(pB0, pB1, (bf16*)((char*)K_lds + SHM_K), qr, r32, hi, map);
    finishSM(pA0, pA1, alA, l_reg, pa0, pa1, pa2, pa3); SBAR();
    SLOAD(SO, (j + 2) * KVBLK); SBAR();
    pv_d0(o, vb0, pa0, pa1, pa2, pa3); partialSM(pB0, pB1, m_reg, mnB, alB);
    __syncthreads(); SWAIT(); SWRITE(0, SE);
    RESC(alB); __syncthreads();
    SBAR(); qkt(pA0, pA1, K_lds, qr, r32, hi, map);
    finishSM(pB0, pB1, alB, l_reg, pa0, pa1, pa2, pa3); SBAR();
    if (j + 3 < NT) SLOAD(SE, (j + 3) * KVBLK); SBAR();
    pv_d0(o, vb0 + (int)SHM_V, pa0, pa1, pa2, pa3); partialSM(pA0, pA1, m_reg, mnA, alA);
    __syncthreads(); SWAIT(); SWRITE(1, SO);
    RESC(alA); __syncthreads();
  }
  SBAR(); qkt(pB0, pB1, (bf16*)((char*)K_lds + SHM_K), qr, r32, hi, map);
  finishSM(pA0, pA1, alA, l_reg, pa0, pa1, pa2, pa3); SBAR();
  pv_d0(o, vb0, pa0, pa1, pa2, pa3); partialSM(pB0, pB1, m_reg, mnB, alB);
  __syncthreads(); RESC(alB);
  finishSM(pB0, pB1, alB, l_reg, pa0, pa1, pa2, pa3); SBAR();
  pv_d0(o, vb0 + (int)SHM_V, pa0, pa1, pa2, pa3);
  if (hi == 0) li_l[r32] = l_reg; asm volatile("s_waitcnt lgkmcnt(0)" ::: "memory");
  float rli[16];
#pragma unroll
  for (int r = 0; r < 16; ++r) rli[r] = __builtin_amdgcn_rcpf(li_l[crow(r, hi)]);
  __syncthreads();
  int r32e = r32, hie = hi; asm volatile("" : "+v"(r32e), "+v"(hie));
  float* X = (float*)lds;
  if (map == 1) {
#pragma unroll
    for (int r = 0; r < 16; ++r)
#pragma unroll
      for (int d0 = 0; d0 < 4; ++d0) X[(qw * 32 + crow(r, hie)) * 128 + d0 * 32 + r32e] = o[d0][r] * rli[r];
  }
  __syncthreads();
  if (map == 0) {
    float sw[4];
#pragma unroll
    for (int d0 = 0; d0 < 4; ++d0) sw[d0] = subln[d0 * 32 + r32e] * 0.8f;
#pragma unroll
    for (int r = 0; r < 16; ++r) { float val[4]; float ss = 0.f;
#pragma unroll
      for (int d0 = 0; d0 < 4; ++d0) { val[d0] = o[d0][r] * rli[r] - lam * X[(qw * 32 + crow(r, hie)) * 128 + d0 * 32 + r32e]; ss += val[d0] * val[d0]; }
      ss += __shfl_xor(ss, 1); ss += __shfl_xor(ss, 2); ss += __shfl_xor(ss, 4); ss += __shfl_xor(ss, 8); ss += __shfl_xor(ss, 16);
      const float rs = rsqrtf(ss * (1.0f / 128.0f) + 1e-6f);
#pragma unroll
      for (int d0 = 0; d0 < 4; ++d0) ((unsigned short*)Ob)[(d0 >> 1) * 16384 + (pg8::lds_byte(qw * 32 + crow(r, hie), (d0 & 1) * 32 + r32e) >> 1)] = (unsigned short)(cvtpk(val[d0] * rs * sw[d0], 0.f) & 0xffffu); }
  }
  __syncthreads();
#undef LD8
#undef SLOAD
#undef SWRITE
#undef SWAIT
#undef RESC
}
#undef KSWZ
#undef SBAR
}

template <int CTRL> __device__ __forceinline__ float dppf(float v) { return __builtin_bit_cast(float, __builtin_amdgcn_update_dpp(0, __builtin_bit_cast(int, v), CTRL, 0xf, 0xf, true)); }
__device__ __forceinline__ float wave_sum_dpp(float v) {
    v += dppf<0xB1>(v); v += dppf<0x4E>(v); v += dppf<0x141>(v); v += dppf<0x140>(v);
    const int b = __builtin_bit_cast(int, v);
    return __builtin_bit_cast(float, __builtin_amdgcn_readlane(b, 0)) + __builtin_bit_cast(float, __builtin_amdgcn_readlane(b, 16)) + __builtin_bit_cast(float, __builtin_amdgcn_readlane(b, 32)) + __builtin_bit_cast(float, __builtin_amdgcn_readlane(b, 48));
}
namespace gdn {
using bf16x8 = __attribute__((ext_vector_type(8))) short;
constexpr int TS = 272;
constexpr int OFF_Q = 0, OFF_K = 64 * TS, OFF_V = 2 * 64 * TS, OFF_KK = 3 * 64 * TS, OFF_QK = OFF_KK + 64 * 65 * 4, OFF_L = OFF_QK + 64 * 65 * 4, LSTR = 68,
              OFF_VEC = OFF_L + 2 * 64 * LSTR * 4,
              OFF_D = OFF_KK, DSTR = 20;
static_assert(8 * 16 * DSTR * 4 <= 64 * 65 * 4 && OFF_VEC + 6 * 64 * 4 <= 131072, "gdn lds");
__device__ __forceinline__ void seq_info(int s, int& rowbase, int& L) { if (s < 16) { rowbase = s * 256; L = 256; } else { rowbase = NPROMPT + (s - 16) * 1024; L = 1024; } }
__device__ __forceinline__ int chunk_id(int s, int h, int c) { return s < 16 ? ((s * 8 + h) * 4 + c) : 512 + (((s - 16) * 8 + h) * 16 + c); }

__device__ __forceinline__ void cl_load(Frame& F, int s, int h, int c, unsigned (&raw)[3][12], float (&abv)[2]) {
    const bf16* QKVB = (const bf16*)(F.ws + WS_QKVB); const float* AB = (const float*)(F.ws + WS_AB);
    int rowbase, L; seq_info(s, rowbase, L);
    int lane = F.lane; asm volatile("" : "+v"(lane)); const int wid = F.wave; const int tok0 = 8 * wid;
    const bf16* rp = QKVB + ((long)(rowbase + c * 64 + tok0) - 2) * 3072 + h * 128 + 2 * lane;
#pragma unroll
    for (int j = 0; j < 12; ++j) { const int t = c * 64 + tok0 - 2 + j; const bool ok = (t >= 0) && (t < L);
#pragma unroll
        for (int x = 0; x < 3; ++x) raw[x][j] = ok ? *(const unsigned*)(rp + x * 1024) : 0u;
        rp += 3072; asm volatile("" : "+v"(rp)); }
    abv[0] = 0.f; abv[1] = 0.f;
    if (wid < 2) { const size_t row = (size_t)rowbase + c * 64 + lane; abv[0] = AB[row * 32 + wid * 8 + h]; abv[1] = AB[row * 32 + 16 + wid * 8 + h]; }
}
__device__ __forceinline__ void chunk_local(Frame& F, int s, int h, int c, unsigned (&raw)[3][12], float (&abv)[2], bool has_next, int ns, int nh, int nc) {
    const bf16* QKVB = (const bf16*)(F.ws + WS_QKVB); const float* AB = (const float*)(F.ws + WS_AB);
    const float* conv_w = F.inp[11]; const float* a_log = F.inp[12]; const float* dt_bias = F.inp[13];
    bf16* QHAT = (bf16*)(F.ws + WS_QHAT); bf16* KHT = (bf16*)(F.ws + WS_KHT); bf16* NWg = (bf16*)(F.ws + WS_NW); bf16* Ug = (bf16*)(F.ws + WS_U); bf16* INTRA = (bf16*)(F.ws + WS_INTRA);
    float* EVEC = (float*)(F.ws + WS_EVEC);
    int rowbase, L; seq_info(s, rowbase, L); const int cid = chunk_id(s, h, c);
    int tid = F.tid, lane = F.lane; const int wid = F.wave; asm volatile("" : "+v"(tid), "+v"(lane));
    LAS unsigned char* lds = F.lds;
    LAS float* vec = (LAS float*)(lds + OFF_VEC);
    {
        const int tok0 = 8 * wid;
        float cw[3][5][2];
#pragma unroll
        for (int x = 0; x < 3; ++x)
#pragma unroll
            for (int j = 0; j < 5; ++j) { const float* p = conv_w + j * 3072 + x * 1024 + h * 128 + 2 * lane; cw[x][j][0] = p[0]; cw[x][j][1] = p[1]; }
        unsigned kt[2][4];
        float val[8][3][2]; float sv[16];
#pragma unroll
        for (int tt = 0; tt < 8; ++tt) {
#pragma unroll
            for (int x = 0; x < 3; ++x) { pg8::f32x2 a2 = {0.f, 0.f};
#pragma unroll
                for (int j = 0; j < 5; ++j) { const pg8::f32x2 w2_ = {cw[x][j][0], cw[x][j][1]}; const pg8::f32x2 r2_ = {bflo(raw[x][tt + j]), bfhi(raw[x][tt + j])}; a2 = __builtin_elementwise_fma(w2_, r2_, a2); }
                val[tt][x][0] = silu_f(a2.x); val[tt][x][1] = silu_f(a2.y); }
            sv[tt] = val[tt][0][0] * val[tt][0][0] + val[tt][0][1] * val[tt][0][1];
            sv[8 + tt] = val[tt][1][0] * val[tt][1][0] + val[tt][1][1] * val[tt][1][1];
        }
        float tot[16];
        {
            float w8[8], u4[4];
#pragma unroll
            for (int i = 0; i < 8; ++i) { const auto r = __builtin_amdgcn_permlane32_swap(__builtin_bit_cast(unsigned, sv[i]), __builtin_bit_cast(unsigned, sv[i + 8]), false, false);
                const unsigned r0 = r[0], r1 = r[1]; w8[i] = __builtin_bit_cast(float, r0) + __builtin_bit_cast(float, r1); }
#pragma unroll
            for (int i = 0; i < 4; ++i) { const auto r = __builtin_amdgcn_permlane16_swap(__builtin_bit_cast(unsigned, w8[i]), __builtin_bit_cast(unsigned, w8[i + 4]), false, false);
                const unsigned r0 = r[0], r1 = r[1]; float v = __builtin_bit_cast(float, r0) + __builtin_bit_cast(float, r1);
                v += dppf<0xB1>(v); v += dppf<0x4E>(v); v += dppf<0x141>(v); v += dppf<0x140>(v); u4[i] = v; }
#pragma unroll
            for (int r = 0; r < 4; ++r)
#pragma unroll
                for (int i = 0; i < 4; ++i) tot[i + 4 * (r & 1) + 8 * (r >> 1)] = __builtin_bit_cast(float, __builtin_amdgcn_readlane(__builtin_bit_cast(int, u4[i]), 16 * r));
        }
#pragma unroll
        for (int tt = 0; tt < 8; ++tt) {
            const float rq = rsqrtf(tot[tt] + EPS) * 0.08838834764831845f, rk = rsqrtf(tot[8 + tt] + EPS);
            const unsigned qw_ = cvtpk(val[tt][0][0] * rq, val[tt][0][1] * rq), kw_ = cvtpk(val[tt][1][0] * rk, val[tt][1][1] * rk), vw_ = cvtpk(val[tt][2][0], val[tt][2][1]);
            const int tok = tok0 + tt;
            *(LAS unsigned*)(lds + OFF_Q + tok * TS + 4 * lane) = qw_;
            *(LAS unsigned*)(lds + OFF_K + tok * TS + 4 * lane) = kw_;
            *(LAS unsigned*)(lds + OFF_V + tok * TS + 4 * lane) = vw_;
            *(unsigned*)(QHAT + ((size_t)cid * 64 + tok) * 128 + 2 * lane) = qw_;
            if (tt & 1) { kt[0][tt >> 1] |= (kw_ << 16); kt[1][tt >> 1] |= (kw_ & 0xffff0000u); } else { kt[0][tt >> 1] = kw_ & 0xffffu; kt[1][tt >> 1] = kw_ >> 16; }
        }
#pragma unroll
        for (int e = 0; e < 2; ++e) { v4u w; w.x = kt[e][0]; w.y = kt[e][1]; w.z = kt[e][2]; w.w = kt[e][3];
            *(GAS v4u*)(KHT + ((size_t)cid * 128 + 2 * lane + e) * 64 + tok0) = w; }
    }
    if (wid < 2) {
        const int dir = wid, tok = lane; const size_t row = (size_t)rowbase + c * 64 + tok;
        const float a = abv[0], b = abv[1];
        const float xs = a + dt_bias[dir * 8 + h];
        const float sp = xs > 20.f ? xs : log1pf(__expf(xs));
        const float g = -__expf(a_log[dir * 8 + h]) * sp;
        const float beta = 1.0f / (1.0f + __expf(-b));
        float G = g;
        if (dir == 0) {
#pragma unroll
            for (int o = 1; o < 64; o <<= 1) { const float t = __shfl_up(G, o); if (lane >= o) G += t; }
        } else {
#pragma unroll
            for (int o = 1; o < 64; o <<= 1) { const float t = __shfl_down(G, o); if (lane + o < 64) G += t; }
        }
        const float gl = __shfl(G, dir == 0 ? 63 : 0);
        const float eG = __expf(G);
        vec[dir * 64 + tok] = beta; vec[128 + dir * 64 + tok] = G; vec[256 + dir * 64 + tok] = beta * eG;
        float* ev = EVEC + ((size_t)cid * 2 + dir) * 192;
        ev[tok] = eG; ev[64 + tok] = __expf(gl - G); if (lane == 0) ev[128] = __expf(gl);
    }
    if (has_next) cl_load(F, ns, nh, nc, raw, abv);
    LBAR();
    {
        const int r32 = lane & 31, hi = lane >> 5; const int mat = wid >> 2, bi = (wid >> 1) & 1, bj = wid & 1;
        const LAS unsigned char* ap = lds + (mat ? OFF_Q : OFF_K) + (32 * bi + r32) * TS + 16 * hi;
        const LAS unsigned char* bp = lds + OFF_K + (32 * bj + r32) * TS + 16 * hi;
        f32x16 acc = {};
#pragma unroll
        for (int st = 0; st < 8; ++st) { const bf16x8 a = *(const LAS bf16x8*)(ap + 32 * st), b = *(const LAS bf16x8*)(bp + 32 * st); acc = __builtin_amdgcn_mfma_f32_32x32x16_bf16(a, b, acc, 0, 0, 0); }
        LAS float* dst = (LAS float*)(lds + (mat ? OFF_QK : OFF_KK));
#pragma unroll
        for (int r = 0; r < 16; ++r) dst[(32 * bi + crow(r, hi)) * 65 + 32 * bj + r32] = acc[r];
    }
    LBAR();
    {
        const int dir = tid >> 8, i = (tid >> 2) & 63, j0 = (tid & 3) * 16;
        const LAS float* KKm = (const LAS float*)(lds + OFF_KK); const LAS float* QKm = (const LAS float*)(lds + OFF_QK);
        LAS float* Lm = (LAS float*)(lds + OFF_L) + dir * 64 * LSTR;
        const float bi_ = vec[dir * 64 + i], Gi = vec[128 + dir * 64 + i];
        unsigned iw[8];
#pragma unroll
        for (int jj = 0; jj < 16; ++jj) { const int j = j0 + jj; const float Gj = vec[128 + dir * 64 + j];
            const bool strict = dir ? (j > i) : (j < i); const bool incl = strict || (j == i);
            const float dec = incl ? __expf(Gi - Gj) : 0.f;
            const float lv = strict ? bi_ * KKm[i * 65 + j] * dec : 0.f;
            const float iv = QKm[i * 65 + j] * dec;
            if (dir) Lm[(63 - i) * LSTR + (63 - j)] = lv; else Lm[i * LSTR + j] = lv;
            const unsigned short bv = (unsigned short)(cvtpk(iv, 0.f) & 0xffffu);
            if (jj & 1) iw[jj >> 1] |= ((unsigned)bv << 16); else iw[jj >> 1] = bv; }
        bf16* ip = INTRA + (((size_t)cid * 2 + dir) * 64 + i) * 64 + j0;
        v4u w0, w1; w0.x = iw[0]; w0.y = iw[1]; w0.z = iw[2]; w0.w = iw[3]; w1.x = iw[4]; w1.y = iw[5]; w1.z = iw[6]; w1.w = iw[7];
        *(GAS v4u*)ip = w0; *(GAS v4u*)(ip + 8) = w1;
    }
    LBAR();
    if (tid < 128) {
        const int dir = tid >> 6, b = (tid >> 4) & 3, cidx = tid & 15;
        const LAS float* Lb = (const LAS float*)(lds + OFF_L) + dir * 64 * LSTR + (16 * b) * LSTR + 16 * b;
        LAS float* Dm = (LAS float*)(lds + OFF_D) + (dir * 4 + b) * 16 * DSTR;
        float d[16];
#pragma unroll
        for (int i = 0; i < 16; ++i) { float a = (i == cidx) ? 1.f : 0.f;
#pragma unroll
            for (int j = 0; j < i; ++j) a -= Lb[i * LSTR + j] * d[j];
            d[i] = a; Dm[i * DSTR + cidx] = a; }
    }
    LBAR();
    {
        const int dir = wid >> 2, wq = wid & 3; const bool isK = wq >= 2; const int cb = (wq & 1) * 64;
        const int n = lane & 15, g = lane >> 4;
        const LAS float* Lm = (const LAS float*)(lds + OFF_L) + dir * 64 * LSTR;
        const LAS float* Dall = (const LAS float*)(lds + OFF_D) + dir * 4 * 16 * DSTR;
        const LAS unsigned char* tile = lds + (isK ? OFF_K : OFF_V);
        const LAS float* scl = vec + (isK ? 256 : 0) + dir * 64;
        bf16* og = (isK ? NWg : Ug) + ((size_t)cid * 2 + dir) * 64 * 128;
        const float sgn = isK ? -1.f : 1.f;
        LAS unsigned char* stg = lds + OFF_Q + wid * 2176;
        u32x2 Xf[3][4];
#pragma unroll
        for (int b = 0; b < 4; ++b) {
            f32x4 R[4];
#pragma unroll
            for (int r = 0; r < 4; ++r) { const int p = 16 * b + 4 * g + r; const int tok = dir ? 63 - p : p; const float sc_ = scl[tok];
#pragma unroll
                for (int nt = 0; nt < 4; ++nt) R[nt][r] = bf2f(*(const LAS unsigned short*)(tile + tok * TS + 2 * (cb + 16 * nt + n))) * sc_; }
#pragma unroll
            for (int pr = 0; pr < 2; ++pr) if (2 * pr < b) {
                const int a0 = 2 * pr, a1 = 2 * pr + 1; const bool two = a1 < b;
                const f32x4 l0 = *(const LAS f32x4*)(Lm + (16 * b + n) * LSTR + 16 * a0 + 4 * g);
                f32x4 l1 = {0.f, 0.f, 0.f, 0.f}; if (two) l1 = *(const LAS f32x4*)(Lm + (16 * b + n) * LSTR + 16 * a1 + 4 * g);
                v4u aw; aw.x = cvtpk(-l0[0], -l0[1]); aw.y = cvtpk(-l0[2], -l0[3]); aw.z = cvtpk(-l1[0], -l1[1]); aw.w = cvtpk(-l1[2], -l1[3]);
                const bf16x8 af = __builtin_bit_cast(bf16x8, aw);
#pragma unroll
                for (int nt = 0; nt < 4; ++nt) { v4u bw; bw.x = Xf[a0][nt].x; bw.y = Xf[a0][nt].y; bw.z = two ? Xf[a1 < 3 ? a1 : 2][nt].x : 0u; bw.w = two ? Xf[a1 < 3 ? a1 : 2][nt].y : 0u;
                    R[nt] = __builtin_amdgcn_mfma_f32_16x16x32_bf16(af, __builtin_bit_cast(bf16x8, bw), R[nt], 0, 0, 0); }
            }
            const f32x4 df = *(const LAS f32x4*)(Dall + b * 16 * DSTR + n * DSTR + 4 * g);
            v4u dw; dw.x = cvtpk(df[0], df[1]); dw.y = cvtpk(df[2], df[3]); dw.z = 0u; dw.w = 0u;
            const bf16x8 dfr = __builtin_bit_cast(bf16x8, dw);
#pragma unroll
            for (int nt = 0; nt < 4; ++nt) {
                v4u rw; rw.x = cvtpk(R[nt][0], R[nt][1]); rw.y = cvtpk(R[nt][2], R[nt][3]); rw.z = 0u; rw.w = 0u;
                const f32x4 xb = __builtin_amdgcn_mfma_f32_16x16x32_bf16(dfr, __builtin_bit_cast(bf16x8, rw), (f32x4){0.f, 0.f, 0.f, 0.f}, 0, 0, 0);
                if (b < 3) { Xf[b][nt].x = cvtpk(xb[0], xb[1]); Xf[b][nt].y = cvtpk(xb[2], xb[3]); }
#pragma unroll
                for (int r = 0; r < 4; ++r) *(LAS unsigned short*)(stg + (4 * g + r) * 136 + 2 * (16 * nt + n)) = (unsigned short)(cvtpk(xb[r] * sgn, 0.f) & 0xffffu);
            }
            asm volatile("s_waitcnt lgkmcnt(0)" ::: "memory");
#pragma unroll
            for (int q = 0; q < 2; ++q) { const int piece = lane + 64 * q, lr = piece >> 3, ch = piece & 7; const int p = 16 * b + lr; const int tok = dir ? 63 - p : p;
                const u32x2 lo_ = *(const LAS u32x2*)(stg + lr * 136 + 16 * ch), hi_ = *(const LAS u32x2*)(stg + lr * 136 + 16 * ch + 8);
                v4u w; w.x = lo_.x; w.y = lo_.y; w.z = hi_.x; w.w = hi_.y;
                *(GAS v4u*)(og + tok * 128 + cb + 8 * ch) = w; }
            asm volatile("s_waitcnt lgkmcnt(0)" ::: "memory");
        }
    }
    LBAR();
}
}

namespace gscan {
using bf16x8 = __attribute__((ext_vector_type(8))) short;
constexpr int S128 = 264, S64 = 136;
constexpr int O_NW = 0, O_QH = 64 * S128, O_KHT = 2 * 64 * S128, O_IN = O_KHT + 128 * S64, O_EV = O_IN + 64 * S64, BUF = O_EV + 192 * 4;
static_assert(2 * BUF <= 131072 && (BUF % 8) == 0, "scan lds");
__device__ __forceinline__ bf16x8 afrag(const LAS unsigned char* p) { const u32x2 a = *(const LAS u32x2*)p, b = *(const LAS u32x2*)(p + 16); v4u w; w.x = a.x; w.y = a.y; w.z = b.x; w.w = b.y; return __builtin_bit_cast(bf16x8, w); }
__device__ __forceinline__ bf16x8 pack8(const f32x16& v, int s) { v4u w; w.x = cvtpk(v[8 * s + 0], v[8 * s + 1]); w.y = cvtpk(v[8 * s + 2], v[8 * s + 3]); w.z = cvtpk(v[8 * s + 4], v[8 * s + 5]); w.w = cvtpk(v[8 * s + 6], v[8 * s + 7]); return __builtin_bit_cast(bf16x8, w); }

#define SC_LOAD(T0, T1, T2, T3, EV, cid_) do { const int cidl_ = (cid_); const size_t cid2l_ = (size_t)cidl_ * 2 + dir; \
    _Pragma("unroll") for (int i_ = 0; i_ < 4; ++i_) { const int q_ = lt + 256 * i_; T0[i_] = *(const GAS v4u*)(NWg + cid2l_ * 8192 + (size_t)q_ * 8); T1[i_] = *(const GAS v4u*)(QHAT + (size_t)cidl_ * 8192 + (size_t)q_ * 8); T2[i_] = *(const GAS v4u*)(KHT + (size_t)cidl_ * 8192 + (size_t)q_ * 8); } \
    _Pragma("unroll") for (int i_ = 0; i_ < 2; ++i_) { const int q_ = lt + 256 * i_; T3[i_] = *(const GAS v4u*)(INTRA + cid2l_ * 4096 + (size_t)q_ * 8); } \
    EV = 0.f; if (lt < 192) EV = EVEC[cid2l_ * 192 + lt]; } while (0)
#define SC_WRITE(T0, T1, T2, T3, EV, b_) do { LAS unsigned char* Bw_ = lds + (b_) * BUF; \
    _Pragma("unroll") for (int i_ = 0; i_ < 4; ++i_) { const int q_ = lt + 256 * i_; const int r128_ = q_ >> 4, c128_ = q_ & 15, r64_ = q_ >> 3, c64_ = q_ & 7; \
        LAS unsigned char* d0_ = Bw_ + O_NW + r128_ * S128 + c128_ * 16; *(LAS u32x2*)d0_ = (u32x2){T0[i_].x, T0[i_].y}; *(LAS u32x2*)(d0_ + 8) = (u32x2){T0[i_].z, T0[i_].w}; \
        LAS unsigned char* d1_ = Bw_ + O_QH + r128_ * S128 + c128_ * 16; *(LAS u32x2*)d1_ = (u32x2){T1[i_].x, T1[i_].y}; *(LAS u32x2*)(d1_ + 8) = (u32x2){T1[i_].z, T1[i_].w}; \
        LAS unsigned char* d2_ = Bw_ + O_KHT + r64_ * S64 + c64_ * 16;  *(LAS u32x2*)d2_ = (u32x2){T2[i_].x, T2[i_].y}; *(LAS u32x2*)(d2_ + 8) = (u32x2){T2[i_].z, T2[i_].w}; } \
    _Pragma("unroll") for (int i_ = 0; i_ < 2; ++i_) { const int q_ = lt + 256 * i_; const int r64_ = q_ >> 3, c64_ = q_ & 7; \
        LAS unsigned char* d3_ = Bw_ + O_IN + r64_ * S64 + c64_ * 16; *(LAS u32x2*)d3_ = (u32x2){T3[i_].x, T3[i_].y}; *(LAS u32x2*)(d3_ + 8) = (u32x2){T3[i_].z, T3[i_].w}; } \
    if (lt < 192) *(LAS float*)(Bw_ + O_EV + 4 * lt) = EV; } while (0)
#define SC_ULOAD(UR, cid_) do { const unsigned short* up_ = (const unsigned short*)Ug + ((size_t)(cid_) * 2 + dir) * 8192 + (size_t)(4 * hi * 128 + n0 + r32); \
    _Pragma("unroll") for (int ib_ = 0; ib_ < 2; ++ib_) _Pragma("unroll") for (int r_ = 0; r_ < 16; ++r_) UR[ib_][r_] = up_[(32 * ib_ + (r_ & 3) + 8 * (r_ >> 2)) * 128]; } while (0)
#define SC_STEP(UR, b_, c_) do { const LAS unsigned char* B = lds + (b_) * BUF; \
    const LAS float* ev = (const LAS float*)(B + O_EV); \
    f32x16 vn[2] = {f32x16{}, f32x16{}}, qs[2] = {f32x16{}, f32x16{}}; \
    bf16x8 fa[4], fb[4]; \
      \
    _Pragma("unroll") for (int ib = 0; ib < 2; ++ib) { fa[ib] = afrag(B + O_NW + (32 * ib + r32) * S128 + (4 * hi) * 2); fa[2 + ib] = afrag(B + O_QH + (32 * ib + r32) * S128 + (4 * hi) * 2); } \
    _Pragma("unroll") for (int it = 0; it < 8; ++it) { const int mb = it >> 1, st = it & 1; \
        if (it + 1 < 8) { const int koffn = (32 * ((it + 1) >> 1) + 16 * ((it + 1) & 1) + 4 * hi) * 2; \
            _Pragma("unroll") for (int ib = 0; ib < 2; ++ib) { fb[ib] = afrag(B + O_NW + (32 * ib + r32) * S128 + koffn); fb[2 + ib] = afrag(B + O_QH + (32 * ib + r32) * S128 + koffn); } } \
        const bf16x8 sb = pack8(S[mb], st); \
        __builtin_amdgcn_sched_barrier(0); \
        _Pragma("unroll") for (int ib = 0; ib < 2; ++ib) { vn[ib] = __builtin_amdgcn_mfma_f32_32x32x16_bf16(fa[ib], sb, vn[ib], 0, 0, 0); qs[ib] = __builtin_amdgcn_mfma_f32_32x32x16_bf16(fa[2 + ib], sb, qs[ib], 0, 0, 0); } \
        __builtin_amdgcn_sched_barrier(0); \
        _Pragma("unroll") for (int q_ = 0; q_ < 4; ++q_) fa[q_] = fb[q_]; } \
      \
    _Pragma("unroll") for (int ib = 0; ib < 2; ++ib) fa[ib] = afrag(B + O_IN + (32 * ib + r32) * S64 + (4 * hi) * 2); \
    _Pragma("unroll") for (int ib = 0; ib < 2; ++ib) _Pragma("unroll") for (int r = 0; r < 16; ++r) { vn[ib][r] += bf2f(UR[ib][r]); qs[ib][r] *= ev[32 * ib + crow(r, hi)]; } \
      \
    _Pragma("unroll") for (int it = 0; it < 4; ++it) { const int jb = it >> 1, st = it & 1; \
        if (it + 1 < 4) { const int koffn = (32 * ((it + 1) >> 1) + 16 * ((it + 1) & 1) + 4 * hi) * 2; \
            _Pragma("unroll") for (int ib = 0; ib < 2; ++ib) fb[ib] = afrag(B + O_IN + (32 * ib + r32) * S64 + koffn); } \
        else { _Pragma("unroll") for (int mb = 0; mb < 4; ++mb) fb[mb] = afrag(B + O_KHT + (32 * mb + r32) * S64 + (4 * hi) * 2); }     \
        const bf16x8 vb = pack8(vn[jb], st); \
        __builtin_amdgcn_sched_barrier(0); \
        _Pragma("unroll") for (int ib = 0; ib < 2; ++ib) qs[ib] = __builtin_amdgcn_mfma_f32_32x32x16_bf16(fa[ib], vb, qs[ib], 0, 0, 0); \
        __builtin_amdgcn_sched_barrier(0); \
        if (it + 1 < 4) { fa[0] = fb[0]; fa[1] = fb[1]; } else { _Pragma("unroll") for (int q_ = 0; q_ < 4; ++q_) fa[q_] = fb[q_]; } } \
      \
    const float egl = ev[128]; \
    _Pragma("unroll") for (int mb = 0; mb < 4; ++mb) S[mb] *= egl; \
    _Pragma("unroll") for (int jb = 0; jb < 2; ++jb) _Pragma("unroll") for (int r = 0; r < 16; ++r) vn[jb][r] *= ev[64 + 32 * jb + crow(r, hi)]; \
    _Pragma("unroll") for (int it = 0; it < 4; ++it) { const int jb = it >> 1, st = it & 1; \
        if (it + 1 < 4) { const int koffn = (32 * ((it + 1) >> 1) + 16 * ((it + 1) & 1) + 4 * hi) * 2; \
            _Pragma("unroll") for (int mb = 0; mb < 4; ++mb) fb[mb] = afrag(B + O_KHT + (32 * mb + r32) * S64 + koffn); } \
        const bf16x8 vb = pack8(vn[jb], st); \
        __builtin_amdgcn_sched_barrier(0); \
        _Pragma("unroll") for (int mb = 0; mb < 4; ++mb) S[mb] = __builtin_amdgcn_mfma_f32_32x32x16_bf16(fa[mb], vb, S[mb], 0, 0, 0); \
        __builtin_amdgcn_sched_barrier(0); \
        _Pragma("unroll") for (int q_ = 0; q_ < 4; ++q_) fa[q_] = fb[q_]; } \
    unsigned short* op = (unsigned short*)OS + (size_t)(rowbase + 64 * (c_)) * 1024 + (size_t)(4 * hi * 1024 + h * 128 + n0 + r32); \
    _Pragma("unroll") for (int ib = 0; ib < 2; ++ib) _Pragma("unroll") for (int r = 0; r < 16; ++r) op[(32 * ib + (r & 3) + 8 * (r >> 2)) * 1024] = (unsigned short)(cvtpk(qs[ib][r], 0.f) & 0xffffu); } while (0)

__device__ __forceinline__ void scan_item(Frame& F, int s, int h, int dir) {
    const bf16* QHAT = (const bf16*)(F.ws + WS_QHAT); const bf16* KHT = (const bf16*)(F.ws + WS_KHT); const bf16* NWg = (const bf16*)(F.ws + WS_NW); const bf16* Ug = (const bf16*)(F.ws + WS_U);
    const bf16* INTRA = (const bf16*)(F.ws + WS_INTRA); const float* EVEC = (const float*)(F.ws + WS_EVEC);
    bf16* OS = dir ? (bf16*)((unsigned char*)F.out + YO_OB) : (bf16*)(F.ws + WS_OF);
    int rowbase, L; gdn::seq_info(s, rowbase, L); const int n = L / 64;
    const int wid = F.wave; int tid = F.tid, lane = F.lane; asm volatile("" : "+v"(tid), "+v"(lane));
    const int r32 = lane & 31, hi = lane >> 5; const int lt = tid - 256;
    LAS unsigned char* lds = F.lds;
    const bool loader = wid >= 4;
    const int n0 = 32 * (wid & 3);
#define SC_CID(j_) gdn::chunk_id(s, h, dir ? n - 1 - (j_) : (j_))
    if (loader) {
        v4u a0[4], a1[4], a2[4], a3[2], b0[4], b1[4], b2[4], b3[2]; float aev, bev;
        SC_LOAD(a0, a1, a2, a3, aev, SC_CID(0)); SC_WRITE(a0, a1, a2, a3, aev, 0);
        SC_LOAD(a0, a1, a2, a3, aev, SC_CID(1)); SC_LOAD(b0, b1, b2, b3, bev, SC_CID(2));
        LBAR();
        for (int i = 0; i < n; i += 2) {
            SC_WRITE(a0, a1, a2, a3, aev, 1);
            SC_LOAD(a0, a1, a2, a3, aev, SC_CID(i + 3 < n ? i + 3 : n - 1));
            LBAR();
            SC_WRITE(b0, b1, b2, b3, bev, 0);
            SC_LOAD(b0, b1, b2, b3, bev, SC_CID(i + 4 < n ? i + 4 : n - 1));
            LBAR();
        }
    } else {
        f32x16 S[4];
        if (s >= 16) { const float* sd = F.inp[4] + (((size_t)(s - 16) * 2 + dir) * 8 + h) * 16384 + (size_t)(4 * hi * 128 + n0 + r32);
#pragma unroll
            for (int mb = 0; mb < 4; ++mb)
#pragma unroll
                for (int r = 0; r < 16; ++r) S[mb][r] = sd[(32 * mb + (r & 3) + 8 * (r >> 2)) * 128];
        } else {
#pragma unroll
            for (int mb = 0; mb < 4; ++mb) S[mb] = f32x16{};
        }
        unsigned short ua[2][16], ub[2][16];
        SC_ULOAD(ua, SC_CID(0)); SC_ULOAD(ub, SC_CID(1));
        LBAR();
        for (int i = 0; i < n; i += 2) {
            SC_STEP(ua, 0, dir ? n - 1 - i : i);
            SC_ULOAD(ua, SC_CID(i + 2 < n ? i + 2 : n - 1));
            LBAR();
            SC_STEP(ub, 1, dir ? n - 2 - i : i + 1);
            SC_ULOAD(ub, SC_CID(i + 3 < n ? i + 3 : n - 1));
            LBAR();
        }
        if (s < 16) { float* so = F.out + OUT_S + (((size_t)s * 2 + dir) * 8 + h) * 16384 + (size_t)(4 * hi * 128 + n0 + r32);
#pragma unroll
            for (int mb = 0; mb < 4; ++mb)
#pragma unroll
                for (int r = 0; r < 16; ++r) so[(32 * mb + (r & 3) + 8 * (r >> 2)) * 128] = S[mb][r]; }
    }
#undef SC_CID
}
}

__device__ __forceinline__ void gdn_finalize(Frame& F, int row0, int nrows, int h) {
    const bf16* OFw = (const bf16*)(F.ws + WS_OF); const bf16* OBw = (const bf16*)((unsigned char*)F.out + YO_OB); const bf16* GATE = (const bf16*)((unsigned char*)F.out + YO_GATE);
    bf16* MIX = (bf16*)(F.ws + WS_MIX); const float* dn = F.inp[14];
    int lane = F.lane; asm volatile("" : "+v"(lane));
    const int tg = lane >> 3, cs = lane & 7; const int c0 = h * 128 + 16 * cs;
    float nw[16];
#pragma unroll
    for (int e = 0; e < 16; ++e) nw[e] = dn[16 * cs + e];
    const int npass = nrows >> 6;
    int row = row0 + 8 * F.wave + tg;
    for (int it0 = 0; it0 < npass; it0 += 4, row += 256) {
        v4u va[4][2], vb[4][2], vg[4][2];
#pragma unroll
        for (int u = 0; u < 4; ++u)
#pragma unroll
            for (int q = 0; q < 2; ++q) { const size_t off = (size_t)(row + 64 * u) * 1024 + c0 + 8 * q; va[u][q] = *(const GAS v4u*)(OFw + off); vb[u][q] = *(const GAS v4u*)(OBw + off); vg[u][q] = *(const GAS v4u*)(GATE + off); }
#pragma unroll
        for (int u = 0; u < 4; ++u) {
            float o[16], g[16]; float ss = 0.f;
#pragma unroll
            for (int q = 0; q < 2; ++q) { const unsigned aw[4] = {va[u][q].x, va[u][q].y, va[u][q].z, va[u][q].w}, bw[4] = {vb[u][q].x, vb[u][q].y, vb[u][q].z, vb[u][q].w}, gw_[4] = {vg[u][q].x, vg[u][q].y, vg[u][q].z, vg[u][q].w};
#pragma unroll
                for (int e = 0; e < 4; ++e) { o[8 * q + 2 * e] = bflo(aw[e]) + bflo(bw[e]); o[8 * q + 2 * e + 1] = bfhi(aw[e]) + bfhi(bw[e]); g[8 * q + 2 * e] = bflo(gw_[e]); g[8 * q + 2 * e + 1] = bfhi(gw_[e]); } }
#pragma unroll
            for (int e = 0; e < 16; ++e) ss += o[e] * o[e];
            ss += __shfl_xor(ss, 1); ss += __shfl_xor(ss, 2); ss += __shfl_xor(ss, 4);
            const float rs = rsqrtf(ss * (1.0f / 128.0f) + EPS);
            v4u w0, w1; unsigned ww[8];
#pragma unroll
            for (int e = 0; e < 8; ++e) ww[e] = cvtpk(o[2 * e] * rs * nw[2 * e] * silu_f(g[2 * e]), o[2 * e + 1] * rs * nw[2 * e + 1] * silu_f(g[2 * e + 1]));
            w0.x = ww[0]; w0.y = ww[1]; w0.z = ww[2]; w0.w = ww[3]; w1.x = ww[4]; w1.y = ww[5]; w1.z = ww[6]; w1.w = ww[7];
            const int rg_ = row + 64 * u;
            bf16* mo = MIX + (size_t)((rg_ >> 8) * 32 + 16 + 2 * h + (cs >> 2)) * 16384 + ((rg_ >> 7) & 1) * 8192;
            *(GAS v4u*)(mo + (pg8::lds_byte(rg_ & 127, 16 * (cs & 3)) >> 1)) = w0; *(GAS v4u*)(mo + (pg8::lds_byte(rg_ & 127, 16 * (cs & 3) + 8) >> 1)) = w1;
        }
    }
}
__device__ __forceinline__ void pair_sync(unsigned* mine, unsigned* theirs) {
    asm volatile("s_waitcnt vmcnt(0)" ::: "memory");
    __syncthreads();
    if (threadIdx.x == 0) {
        const bool same_xcc = __hip_atomic_load(theirs + 1, __ATOMIC_RELAXED, __HIP_MEMORY_SCOPE_AGENT) == xb_xcc_id() + 1u;
        if (!same_xcc) { __builtin_amdgcn_fence(__ATOMIC_RELEASE, "agent"); asm volatile("s_waitcnt vmcnt(0)" ::: "memory"); }
        __hip_atomic_store(mine, 1u, __ATOMIC_RELAXED, __HIP_MEMORY_SCOPE_AGENT);
        unsigned sp = 0u;
        while (__hip_atomic_load(theirs, __ATOMIC_RELAXED, __HIP_MEMORY_SCOPE_AGENT) == 0u) { __builtin_amdgcn_s_sleep(1); if (++sp > (1u << 22)) break; }
        __builtin_amdgcn_fence(__ATOMIC_ACQUIRE, "agent"); asm volatile("s_waitcnt vmcnt(0)" ::: "memory");
    }
    __syncthreads();
}
constexpr int N_PHASES = 10;
#ifndef MK_N_LAUNCHES
#define MK_N_LAUNCHES 1
#endif
constexpr int N_LAUNCHES = MK_N_LAUNCHES;
struct Args { const float* in[22]; float* out; unsigned char* ws; int ph_lo, ph_hi, li, pad; };
__global__ void __launch_bounds__(NWAVES * 64, 2) mega_fwd(Args args) {
    extern __shared__ __attribute__((aligned(16))) unsigned char lds[];
    Frame F;
    F.lds = (LAS unsigned char*)lds; F.ldsg = lds;
    F.MISC = (volatile LAS unsigned*)(F.lds + MISC_OFF);
    F.tid = threadIdx.x; F.lane = F.tid & 63; F.wave = __builtin_amdgcn_readfirstlane(F.tid >> 6);
    F.G = gridDim.x; { const int bx = blockIdx.x; F.vcu = (F.G % 8 == 0) ? (bx % 8) * (F.G / 8) + bx / 8 : bx; }
    F.ws = args.ws; F.out = args.out; F.ctl = (gu32*)(args.ws + WS_CTL);
    F.inp = args.in;
    for (int u = F.tid; u < (LDS_BYTES - LDSCTL_OFF) / 4; u += NWAVES * 64) ((LAS unsigned*)(F.lds + LDSCTL_OFF))[u] = 0u;
    __syncthreads();
    const int lo = args.ph_lo, hi = args.ph_hi;
    const bool use_bar = (hi - lo) > 1;
    XcdBarrier bar; bar.bar = (unsigned*)(F.ctl + CW_BAR); bar.x = 0; bar.st = nullptr;
    if (use_bar) bar = xcd_barrier_post((unsigned*)(F.ctl + CW_BAR), F.MISC + 8);
#define IN(k) (lo <= (k) && (k) < hi)
#define SEAM(k) do { if (IN(k) && IN((k) + 1)) xcd_barrier(bar); } while (0)
    if (IN(0)) { p0_phase(F); SEAM(0); }
    if (IN(1)) { p1_phase(F); SEAM(1); }
    if (IN(2)) {
        p2_ab(F);
        pg8::Gemm g{(const pg8::bf16_t*)(F.ws + WS_XN), (const pg8::bf16_t*)(F.ws + WS_WIN), MROWS, 7168, DM, 0}; pg8::QuadOrder S; S.init(MROWS, 7168, DM, F.G, (int)blockIdx.x);
        unsigned char* yb = (unsigned char*)F.out;
        pg8::EpiInProj E{(pg8::bf16_t*)(yb + YO_QA), (pg8::bf16_t*)(yb + YO_KP), (pg8::bf16_t*)(yb + YO_VP), (pg8::bf16_t*)(F.ws + WS_KS), (pg8::bf16_t*)(F.ws + WS_VS),
                         (pg8::bf16_t*)(F.ws + WS_QKVB), (pg8::bf16_t*)(yb + YO_GATE), F.out + OUT_K, F.out + OUT_V, (const float*)(F.ws + WS_ROPE)};
        pg8::gemm_phase<pg8::EpiInProj, pg8::QuadOrder, true, true, 3, 192>(F.lds + RING_OFF, g, S, E, (float*)(F.ws + WS_MIX), (unsigned*)(F.ctl + CW_FLAG + 2048));
        SEAM(2);
    }
    if (IN(3)) {
        const float* lp = F.inp[15];
        const float lam = __expf(wave_sum(lp[F.lane] * lp[64 + F.lane])) - __expf(wave_sum(lp[128 + F.lane] * lp[192 + F.lane])) + 0.2f;
        const bf16* QA = (const bf16*)((unsigned char*)F.out + YO_QA); bf16* MIX = (bf16*)(F.ws + WS_MIX);
        for (int u = 256 + F.vcu; u < 768; u += F.G) {
            const bf16 *Qp, *Kp, *Vp; bf16* Op; int nk;
            if (u < 256) { const int qb = u & 1, bh = u >> 1, b = bh >> 3, h = bh & 7; const size_t r0 = (size_t)(b * 256 + qb * 128);
                Qp = QA + r0 * 1024 + h * 128; Kp = (const bf16*)((unsigned char*)F.out + YO_KP) + (size_t)bh * 256 * 128; Vp = (const bf16*)((unsigned char*)F.out + YO_VP) + (size_t)bh * 256 * 128; Op = MIX + (size_t)((r0 >> 8) * 32 + 2 * h) * 16384 + ((r0 >> 7) & 1) * 8192; nk = 256;
            } else { const int su = (u < 512) ? 2 * (u - 256) : 2 * (u - 512) + 1; const int qb = su & 7, bh = su >> 3, b = bh >> 3, h = bh & 7; const size_t r0 = (size_t)(NPROMPT + b * 1024 + qb * 128);
                Qp = QA + r0 * 1024 + h * 128; Kp = (const bf16*)(F.ws + WS_KS) + (size_t)bh * 1536 * 128; Vp = (const bf16*)(F.ws + WS_VS) + (size_t)bh * 1536 * 128; Op = MIX + (size_t)((r0 >> 8) * 32 + 2 * h) * 16384 + ((r0 >> 7) & 1) * 8192; nk = 1536; }
            dattn::attn_unit(Qp, Kp, Vp, Op, nk, lam, F.inp[16], (char*)lds);
        }
        {
#define CL_DEC(it_, s_, h_, c_) do { if ((it_) < 512) { s_ = (it_) >> 5; h_ = ((it_) >> 2) & 7; c_ = (it_) & 3; } else { const int j_ = (it_) - 512; s_ = 16 + (j_ >> 7); h_ = (j_ >> 4) & 7; c_ = j_ & 15; } } while (0)
            unsigned raw[3][12]; float abv[2];
            int it = F.vcu; int s = 0, h = 0, c = 0;
            if (it < 1536) { CL_DEC(it, s, h, c); gdn::cl_load(F, s, h, c, raw, abv); }
            for (; it < 1536; it += F.G) {
                const int nit = it + F.G; int ns = 0, nh = 0, nc = 0; const bool hn = nit < 1536; if (hn) CL_DEC(nit, ns, nh, nc);
                gdn::chunk_local(F, s, h, c, raw, abv, hn, ns, nh, nc);
                s = ns; h = nh; c = nc;
            }
#undef CL_DEC
        }
        SEAM(3);
    }
    if (IN(4)) {
        if (F.vcu < 128 && F.tid == 0) __hip_atomic_store((unsigned*)(F.ctl + CW_PAIR + 64 * F.vcu) + 1, xb_xcc_id() + 1u, __ATOMIC_RELAXED, __HIP_MEMORY_SCOPE_AGENT);
        for (int k = 0; k < 2; ++k) {
            int s_, h_, d_;
            if (F.vcu < 128) { if (k) break; s_ = 16 + (F.vcu >> 4); h_ = (F.vcu >> 1) & 7; d_ = F.vcu & 1; }
            else { const int p = 2 * (F.vcu - 128) + k; if (p >= 256) break; s_ = p >> 4; h_ = (p >> 1) & 7; d_ = p & 1; }
            gscan::scan_item(F, s_, h_, d_);
        }
        { int fr0, fn, fh;
          if (F.vcu < 128) { pair_sync((unsigned*)(F.ctl + CW_PAIR + 64 * F.vcu), (unsigned*)(F.ctl + CW_PAIR + 64 * (F.vcu ^ 1))); fr0 = NPROMPT + (F.vcu >> 4) * 1024 + (F.vcu & 1) * 512; fn = 512; fh = (F.vcu >> 1) & 7; }
          else { asm volatile("s_waitcnt vmcnt(0)" ::: "memory"); __syncthreads(); const int p = 2 * (F.vcu - 128); fr0 = (p >> 4) * 256; fn = 256; fh = (p >> 1) & 7; }
          gdn_finalize(F, fr0, fn, fh); __syncthreads(); }
        if (F.vcu >= 128) {
            const float* lp = F.inp[15];
            const float lam = __expf(wave_sum(lp[F.lane] * lp[64 + F.lane])) - __expf(wave_sum(lp[128 + F.lane] * lp[192 + F.lane])) + 0.2f;
            const bf16* QA = (const bf16*)((unsigned char*)F.out + YO_QA); bf16* MIX = (bf16*)(F.ws + WS_MIX);
            for (int k = 0; k < 2; ++k) { const int u = 2 * (F.vcu - 128) + k; const int qb = u & 1, bh = u >> 1, b = bh >> 3, h = bh & 7; const size_t r0 = (size_t)(b * 256 + qb * 128);
                dattn::attn_unit(QA + r0 * 1024 + h * 128, (const bf16*)((unsigned char*)F.out + YO_KP) + (size_t)bh * 256 * 128, (const bf16*)((unsigned char*)F.out + YO_VP) + (size_t)bh * 256 * 128,
                                 MIX + (size_t)((r0 >> 8) * 32 + 2 * h) * 16384 + ((r0 >> 7) & 1) * 8192, 256, lam, F.inp[16], (char*)lds); }
        }
        SEAM(4);
    }
    if (IN(6)) {
        pg8::Gemm g{(const pg8::bf16_t*)(F.ws + WS_MIX), (const pg8::bf16_t*)(F.ws + WS_WOUT), MROWS, DM, DM, 1}; pg8::PairOrder S; S.init(MROWS, DM, DM, F.G, (int)blockIdx.x, 24);
        pg8::EpiOutProj E{F.inp[0], F.inp[1], (const float*)(F.ws + WS_MOD), F.inp[18], (pg8::bf16_t*)(F.ws + WS_HB), (pg8::bf16_t*)(F.ws + WS_HW), (float*)(F.ws + WS_PART)};
        pg8::gemm_phase<pg8::EpiOutProj, pg8::PairOrder, true, true>(F.lds + RING_OFF, g, S, E, (float*)(F.ws + WS_WIN), (unsigned*)(F.ctl + CW_FLAG), 116, (unsigned)((WS_INTRA - WS_WIN) - 116 * 262144));
        SEAM(6);
    }
    if (IN(7)) {
        pg8::Gemm g{(const pg8::bf16_t*)(F.ws + WS_HW), (const pg8::bf16_t*)(F.ws + WS_WFF1), MROWS, DFF, DM, 1}; pg8::StaticOrder S; S.init(MROWS, DFF, DM, F.G, (int)blockIdx.x);
        LAS float* rt = (LAS float*)(F.lds + RSTD_OFF); const float* PART = (const float*)(F.ws + WS_PART);
        { const int half = F.tid >> 8, rr = F.tid & 255;
            f32x4 pv[3][8]; bool ok[3];
#pragma unroll
            for (int j = 0; j < 3; ++j) { pg8::Unit u; ok[j] = S.next(2 * j + half, u); const float* p = PART + ((size_t)(ok[j] ? u.pm : 0) * 256 + rr) * 32;
#pragma unroll
                for (int q = 0; q < 8; ++q) pv[j][q] = *(const f32x4*)(p + 4 * q); }
#pragma unroll
            for (int j = 0; j < 3; ++j) { float s = 0.f;
#pragma unroll
                for (int q = 0; q < 8; ++q) s += (pv[j][q][0] + pv[j][q][1]) + (pv[j][q][2] + pv[j][q][3]);
                if (ok[j]) rt[(2 * j + half) * 256 + rr] = rsqrtf(s * (1.0f / DM) + EPS); } }
        __syncthreads();
        pg8::EpiFF1 E{(const float*)(F.ws + WS_C2), (pg8::bf16_t*)(F.ws + WS_FF), (const LAS float*)rt};
        pg8::gemm_phase<pg8::EpiFF1, pg8::StaticOrder, true, true>(F.lds + RING_OFF, g, S, E);
        SEAM(7);
    }
    if (IN(8)) {
        pg8::Gemm g{(const pg8::bf16_t*)(F.ws + WS_FF), (const pg8::bf16_t*)(F.ws + WS_WFF2), MROWS, DM, DFF, 1}; pg8::PairOrder S; S.init(MROWS, DM, DFF, F.G, (int)blockIdx.x, 76);
        pg8::EpiFF2 E{(const float*)(F.ws + WS_MOD), (const pg8::bf16_t*)(F.ws + WS_HB), F.out, (float*)(F.ws + WS_PART2), F.inp[21], (unsigned*)(F.ctl + CW_PANEL)};
        pg8::gemm_phase<pg8::EpiFF2, pg8::PairOrder, true, true>(F.lds + RING_OFF, g, S, E, (float*)(F.ws + WS_WIN), (unsigned*)(F.ctl + CW_FLAG + 1024), 116, (unsigned)((WS_INTRA - WS_WIN) - 116 * 262144));
    }
#undef IN
#undef SEAM
}

extern "C" void kernel_launch(void* const* d_in, const int* in_sizes, int n_in, void* d_out, int out_size, void* d_ws, size_t ws_size, hipStream_t stream) {
    static int grid = 0;
    if (grid == 0) {
        if (n_in != 22 || out_size != 37748736 || ws_size < WS_END) { fprintf(stderr, "kernel_launch: unexpected shapes: n_in %d out %d ws %zu (need %zu)\n", n_in, out_size, ws_size, (size_t)WS_END); grid = -1; return; }
        if (hipFuncSetAttribute((const void*)mega_fwd, hipFuncAttributeMaxDynamicSharedMemorySize, LDS_BYTES) != hipSuccess) { fprintf(stderr, "kernel_launch: hipFuncSetAttribute failed\n"); grid = -1; return; }
        int per_cu = 0; (void)hipOccupancyMaxActiveBlocksPerMultiprocessor(&per_cu, (const void*)mega_fwd, NWAVES * 64, LDS_BYTES); (void)hipGetLastError();
        if (per_cu < 1) fprintf(stderr, "kernel_launch: occupancy query reports %d blocks per CU\n", per_cu);
        grid = 256;
    }
    if (grid < 0) return;
    if (hipMemsetAsync((char*)d_ws + WS_CTL, 0, CTL_ZERO_BYTES, stream) != hipSuccess) { fprintf(stderr, "kernel_launch: memset failed\n"); return; }
    Args a{};
    for (int i = 0; i < 22; ++i) a.in[i] = (const float*)d_in[i];
    a.out = (float*)d_out; a.ws = (unsigned char*)d_ws;
    if (N_LAUNCHES == 1) { a.ph_lo = 0; a.ph_hi = N_PHASES; a.li = 0; hipLaunchKernelGGL(mega_fwd, dim3(grid), dim3(NWAVES * 64), LDS_BYTES, stream, a); }
    else { for (int li = 0; li < N_PHASES; ++li) { a.ph_lo = li; a.ph_hi = li + 1; a.li = li; hipLaunchKernelGGL(mega_fwd, dim3(grid), dim3(NWAVES * 64), LDS_BYTES, stream, a); } }
    const hipError_t le = hipPeekAtLastError();
    if (le != hipSuccess) fprintf(stderr, "kernel_launch: launch failed: %s\n", hipGetErrorName(le));
}
```

```cpp
#include <hip/hip_runtime.h>
#include <hip/hip_bf16.h>
#include <cstdio>
#include <cstdint>
#include <cmath>

namespace pg8 {
#define PG8_LAS __attribute__((address_space(3)))
typedef unsigned short bf16_t;
typedef short bf16x8 __attribute__((ext_vector_type(8)));
typedef float f32x4 __attribute__((ext_vector_type(4)));
typedef unsigned u32x4 __attribute__((ext_vector_type(4)));
constexpr int BM = 256, BK = 64, HALF = 128, HTB = HALF * BK * 2  , STAGE_BYTES = 8 * HTB, NXCD = 8, WGM = 4;

__host__ __device__ __forceinline__ int lds_byte(int r, int c) { const int st = (r >> 4) * 2 + (c >> 5), rr = r & 15, cc = c & 31, ob = rr * 64 + cc * 2; return st * 1024 + (ob ^ (((ob >> 9) & 1) << 5)); }
__host__ __device__ __forceinline__ void stage_rc(int b, int& R, int& C) { const int st = b / 1024, sb = b % 1024, swz = sb ^ (((sb >> 9) & 1) << 5); R = (st >> 1) * 16 + swz / 64; C = (st & 1) * 32 + (swz % 64) / 2; }
__host__ __device__ __forceinline__ int perm32inv(int v) { return 16 * ((v >> 2) & 1) + 4 * (v >> 3) + (v & 3); }
__host__ __device__ __forceinline__ int perm32(int rho) { const int n = rho >> 4, i = rho & 15; return 8 * (i >> 2) + 4 * n + (i & 3); }

struct Unit { int pm, pn, k0, nt, mode, slot, npart; };
struct Gemm { const bf16_t* A; const bf16_t* Bt; int M, N, K; int atiled; };

struct StaticOrder {
    int nM, nN, nwg, G, c, ntk;
    __host__ __device__ __forceinline__ void init(int M, int N, int K, int G_, int c_) { nM = M / BM; nN = N / BM; nwg = nM * nN; G = G_; c = c_; ntk = K / BK; }
    __host__ __device__ __forceinline__ bool next(int i, Unit& u) const {
        const long L = (long)i * G + c; if (L >= nwg) return false;
        int wgid = (int)L; { const int q = nwg / NXCD, r = nwg % NXCD, xcd = wgid % NXCD, off = wgid / NXCD; wgid = (xcd < r ? xcd * (q + 1) : r * (q + 1) + (xcd - r) * q) + off; }
        const int nig = WGM * nN, gid = wgid / nig, fm = gid * WGM, gsz = (nM - fm) < WGM ? (nM - fm) : WGM;
        u.pm = fm + ((wgid % nig) % gsz); u.pn = (wgid % nig) / gsz; u.k0 = 0; u.nt = ntk; u.mode = 0; u.slot = 0; u.npart = 0; return true;
    }
    __device__ __forceinline__ void a_ready(const Unit&) const {}
    __device__ __forceinline__ void done(const Unit&) const {}
};


typedef float cvt_f32x2 __attribute__((ext_vector_type(2))); typedef __bf16 cvt_bf16x2 __attribute__((ext_vector_type(2)));
__device__ __forceinline__ unsigned cvt_pk_bf16(float lo, float hi) { cvt_f32x2 v = {lo, hi}; cvt_bf16x2 b = __builtin_convertvector(v, cvt_bf16x2); return __builtin_bit_cast(unsigned, b); }

struct PairOrder {
    int c, ntk, G, ntp;
    __host__ __device__ __forceinline__ void init(int M, int N, int K, int G_, int c_, int ntp_) { c = c_; ntk = K / BK; G = G_; ntp = ntp_; }
    __host__ __device__ __forceinline__ bool next(int i, Unit& u) const {
        if (i >= 2 || G != 256) return false;
        const int x = c & 7, lc = c >> 3, jp = lc >> 1, j = x * 16 + jp, role = lc & 1;
        int T, k0 = 0, nt = ntk, mode = 0;
        if (role == 0) { if (i == 0) { T = 48 * x + 32 + jp; nt = ntp; mode = 1; } else T = 48 * x + 16 + jp; }
        else           { if (i == 0) T = 48 * x + jp; else { T = 48 * x + 32 + jp; k0 = ntp; nt = ntk - ntp; mode = 2; } }
        u.pm = T >> 3; u.pn = T & 7; u.k0 = k0; u.nt = nt; u.mode = mode; u.slot = j; u.npart = 1; return true;
    }
    __device__ __forceinline__ void a_ready(const Unit&) const {}
    __device__ __forceinline__ void done(const Unit&) const {}
};

struct QuadOrder {
    StaticOrder base; int c, ntk;
    __host__ __device__ __forceinline__ void init(int M, int N, int K, int G_, int c_) { base.init(M, N, K, G_, c_); c = c_; ntk = K / BK; }
    __host__ __device__ __forceinline__ bool next(int i, Unit& u) const {
        if (base.G != 256 || base.nwg != 1344) return base.next(i, u);
        const int role = c >> 6, t = c & 63, q = (ntk == 32) ? 10 : ntk / 4;
        if (i > 5) return false;
        const bool split = (role < 3) ? (i == 0) : (i == 5);
        if (!split) return base.next(role < 3 ? i - 1 : i, u);
        StaticOrder b2 = base; b2.c = t; b2.next(5, u);
        u.k0 = role * q; u.nt = (role < 3) ? q : ntk - 3 * q; u.mode = (role < 3) ? 1 : 2; u.slot = (role < 3) ? t * 3 + role : t * 3; u.npart = 3; return true;
    }
    __device__ __forceinline__ void a_ready(const Unit&) const {}
    __device__ __forceinline__ void done(const Unit&) const {}
};

typedef float f32x2 __attribute__((ext_vector_type(2)));
typedef unsigned u32x2 __attribute__((ext_vector_type(2)));
__device__ __forceinline__ u32x2 pack4(const f32x4 v) { u32x2 w; w.x = cvt_pk_bf16(v[0], v[1]); w.y = cvt_pk_bf16(v[2], v[3]); return w; }
struct EpiInProj {
    static constexpr bool PERM = true, AFTER_DRAIN = false;
    bf16_t *QA, *KP, *VP, *KS, *VS, *QKVB, *GATE; float *outK, *outV; const float* rope;
    __device__ __forceinline__ void operator()(const f32x4 (&acc)[2][2][4][2], const Unit& u, int ui, int wr, int wc, int fr_, int fq_) const {
        int fr = fr_, fq = fq_; asm volatile("" : "+v"(fr), "+v"(fq));
        const int pm = u.pm, pn = u.pn; const bool sample = pm >= 16;
        const int tq = (pm - 16) & 3, bs = (pm - 16) >> 2;
        if (pn >= 12) {
            bf16_t* base; int ld, c0;
            if (pn < 24) { base = QKVB; ld = 3072; c0 = (pn - 12) * 256; } else { base = GATE; ld = 1024; c0 = (pn - 24) * 256; }
#pragma unroll
            for (int ai = 0; ai < 2; ++ai)
#pragma unroll
                for (int m = 0; m < 4; ++m) { const size_t row = (size_t)pm * 256 + ai * 128 + wr * 64 + m * 16 + fr;
#pragma unroll
                    for (int bj = 0; bj < 2; ++bj) { const u32x2 lo = pack4(acc[ai][bj][m][0]), hi = pack4(acc[ai][bj][m][1]); u32x4 w; w.x = lo.x; w.y = lo.y; w.z = hi.x; w.w = hi.y;
                        *(u32x4*)(base + row * ld + c0 + bj * 128 + wc * 32 + 8 * fq) = w; } }
        } else if (pn >= 8) {
#pragma unroll
            for (int bj = 0; bj < 2; ++bj) { const int h = 2 * (pn - 8) + bj;
#pragma unroll
                for (int ai = 0; ai < 2; ++ai)
#pragma unroll
                    for (int m = 0; m < 4; ++m) { const int tl = ai * 128 + wr * 64 + m * 16 + fr; const int d = wc * 32 + 8 * fq;
                        const f32x4 v0 = acc[ai][bj][m][0], v1 = acc[ai][bj][m][1];
                        const u32x2 lo = pack4(v0), hi = pack4(v1); u32x4 w; w.x = lo.x; w.y = lo.y; w.z = hi.x; w.w = hi.y;
                        if (!sample) { const size_t idx = ((size_t)(pm * 8 + h) * 256 + tl) * 128 + d; *(f32x4*)(outV + idx) = v0; *(f32x4*)(outV + idx + 4) = v1; *(u32x4*)(VP + idx) = w; }
                        else { const size_t idx = ((size_t)(bs * 8 + h) * 1536 + 512 + tq * 256 + tl) * 128 + d; *(u32x4*)(VS + idx) = w; } } }
        } else {
            const bool isK = pn >= 4; const bool colrot = (wc & 1) != 0; const bool upper = fq >= 2;
            const int i0 = 8 * (fq & 1);
            const float sgn = upper ? 1.f : -1.f;
#pragma unroll
            for (int ai = 0; ai < 2; ++ai) {
                f32x4 cr0 = {1.f, 1.f, 1.f, 1.f}, cr1 = cr0, sr0 = {0.f, 0.f, 0.f, 0.f}, sr1 = sr0;
                if (sample && !colrot) { const int pos = tq * 4 + ai * 2 + wr; cr0 = *(const f32x4*)(rope + pos * 16 + i0); cr1 = *(const f32x4*)(rope + pos * 16 + i0 + 4); sr0 = *(const f32x4*)(rope + 1024 + pos * 16 + i0); sr1 = *(const f32x4*)(rope + 1024 + pos * 16 + i0 + 4); }
#pragma unroll
                for (int m = 0; m < 4; ++m) { const int tl = ai * 128 + wr * 64 + m * 16 + fr;
                    f32x4 c0v = cr0, c1v = cr1, s0v = sr0, s1v = sr1;
                    if (sample && colrot) { const int pos = m * 16 + fr; c0v = *(const f32x4*)(rope + pos * 16 + i0); c1v = *(const f32x4*)(rope + pos * 16 + i0 + 4); s0v = *(const f32x4*)(rope + 1024 + pos * 16 + i0); s1v = *(const f32x4*)(rope + 1024 + pos * 16 + i0 + 4); }
#pragma unroll
                    for (int bj = 0; bj < 2; ++bj) { f32x4 o0 = acc[ai][bj][m][0], o1 = acc[ai][bj][m][1];
                        if (sample) {
                            f32x4 p0, p1;
#pragma unroll
                            for (int e = 0; e < 4; ++e) { p0[e] = __shfl_xor(o0[e], 32); p1[e] = __shfl_xor(o1[e], 32); }
                            o0 = o0 * c0v + p0 * s0v * sgn; o1 = o1 * c1v + p1 * s1v * sgn; }
                        const int d = wc * 32 + 8 * fq;
                        const u32x2 lo = pack4(o0), hi = pack4(o1); u32x4 w; w.x = lo.x; w.y = lo.y; w.z = hi.x; w.w = hi.y;
                        if (!isK) { *(u32x4*)(QA + ((size_t)pm * 256 + tl) * 1024 + pn * 256 + bj * 128 + d) = w; }
                        else { const int h = 2 * (pn - 4) + bj;
                            if (!sample) { const size_t idx = ((size_t)(pm * 8 + h) * 256 + tl) * 128 + d; *(f32x4*)(outK + idx) = o0; *(f32x4*)(outK + idx + 4) = o1; *(u32x4*)(KP + idx) = w; }
                            else { const size_t idx = ((size_t)(bs * 8 + h) * 1536 + 512 + tq * 256 + tl) * 128 + d; *(u32x4*)(KS + idx) = w; } } } } }
        }
    }
};
struct EpiOutProj {
    static constexpr bool PERM = true, AFTER_DRAIN = false;
    const float *xp, *xs, *mod, *norm2; bf16_t* HB; bf16_t* HW; float* PART;
    __device__ __forceinline__ void operator()(const f32x4 (&acc)[2][2][4][2], const Unit& u, int ui, int wr, int wc, int fr_, int fq_) const {
        int fr = fr_, fq = fq_; asm volatile("" : "+v"(fr), "+v"(fq));
        const int pm = u.pm, pn = u.pn; const int mb = pm < 16 ? 0 : 1 + ((pm - 16) >> 2);
        const float* xb = pm < 16 ? xp + (size_t)pm * 256 * 2048 : xs + (size_t)(pm - 16) * 256 * 2048;
        const float* g1 = mod + mb * 12288 + 2 * 2048; const float* sc2 = mod + mb * 12288 + 4 * 2048;
        bf16_t* hbt = HB + (size_t)(pm * 8 + pn) * 65536 + (((wr * 4 + wc) * 4 + fq) * 16 + fr) * 8;
        f32x4 g1v[2][2], w2v[2][2];
#pragma unroll
        for (int bj = 0; bj < 2; ++bj)
#pragma unroll
            for (int n = 0; n < 2; ++n) { const int col = pn * 256 + bj * 128 + wc * 32 + 8 * fq + 4 * n; g1v[bj][n] = *(const f32x4*)(g1 + col);
                const f32x4 a = *(const f32x4*)(norm2 + col), b = *(const f32x4*)(sc2 + col); w2v[bj][n] = a * (b + 1.0f); }
#pragma unroll
        for (int am = 0; am < 4; ++am) { const int ai = am >> 1, m0 = (am & 1) * 2;
            f32x4 xin[2][2][2];
#pragma unroll
            for (int mm = 0; mm < 2; ++mm)
#pragma unroll
                for (int bj = 0; bj < 2; ++bj)
#pragma unroll
                    for (int n = 0; n < 2; ++n) xin[mm][bj][n] = __builtin_nontemporal_load((const f32x4*)(xb + (size_t)(ai * 128 + wr * 64 + (m0 + mm) * 16 + fr) * 2048 + pn * 256 + bj * 128 + wc * 32 + 8 * fq + 4 * n));
#pragma unroll
            for (int mm = 0; mm < 2; ++mm) { const int m = m0 + mm; const int rl = ai * 128 + wr * 64 + m * 16 + fr; const size_t row = (size_t)pm * 256 + rl; float s = 0.f;
#pragma unroll
                for (int bj = 0; bj < 2; ++bj) { const int col = pn * 256 + bj * 128 + wc * 32 + 8 * fq;
                    const f32x4 h0 = xin[mm][bj][0] + g1v[bj][0] * acc[ai][bj][m][0], h1 = xin[mm][bj][1] + g1v[bj][1] * acc[ai][bj][m][1];
                    s += (h0[0] * h0[0] + h0[1] * h0[1]) + (h0[2] * h0[2] + h0[3] * h0[3]) + (h1[0] * h1[0] + h1[1] * h1[1]) + (h1[2] * h1[2] + h1[3] * h1[3]);
                    { const u32x2 lo = pack4(h0), hi = pack4(h1); u32x4 w; w.x = lo.x; w.y = lo.y; w.z = hi.x; w.w = hi.y; *(u32x4*)(hbt + ((ai * 2 + bj) * 4 + m) * 4096) = w; }
                    { const u32x2 lo = pack4(h0 * w2v[bj][0]), hi = pack4(h1 * w2v[bj][1]); u32x4 w; w.x = lo.x; w.y = lo.y; w.z = hi.x; w.w = hi.y; *(u32x4*)(HW + (size_t)(pm * 32 + pn * 4 + bj * 2 + (wc >> 1)) * 16384 + ai * 8192 + (lds_byte(wr * 64 + m * 16 + fr, (wc & 1) * 32 + 8 * fq) >> 1)) = w; } }
                s += __shfl_xor(s, 16); s += __shfl_xor(s, 32);
                if (fq == 0) PART[row * 32 + pn * 4 + wc] = s; }
            asm volatile("" ::: "memory"); }
    }
};
struct EpiFF1 {
    static constexpr bool PERM = true, AFTER_DRAIN = false;
    const float* c2; bf16_t* FF; const PG8_LAS float* rstd;
    __device__ __forceinline__ void operator()(const f32x4 (&acc)[2][2][4][2], const Unit& u, int ui, int wr, int wc, int fr_, int fq_) const {
        int fr = fr_, fq = fq_; asm volatile("" : "+v"(fr), "+v"(fq));
        const int pm = u.pm, pn = u.pn; const int mb = pm < 16 ? 0 : 1 + ((pm - 16) >> 2);
        f32x4 cv[2][2];
#pragma unroll
        for (int bj = 0; bj < 2; ++bj)
#pragma unroll
            for (int n = 0; n < 2; ++n) cv[bj][n] = *(const f32x4*)(c2 + mb * 8192 + pn * 256 + bj * 128 + wc * 32 + 8 * fq + 4 * n);
#pragma unroll
        for (int ai = 0; ai < 2; ++ai)
#pragma unroll
            for (int m = 0; m < 4; ++m) { const int rl = ai * 128 + wr * 64 + m * 16 + fr; const float r = rstd[ui * 256 + rl];
                bf16_t* rowp = FF + (size_t)(pm * 128 + pn * 4 + (wc >> 1)) * 16384 + ai * 8192 + (lds_byte(wr * 64 + m * 16 + fr, (wc & 1) * 32 + 8 * fq) >> 1);
#pragma unroll
                for (int bj = 0; bj < 2; ++bj) { f32x4 v0 = acc[ai][bj][m][0] * r + cv[bj][0], v1 = acc[ai][bj][m][1] * r + cv[bj][1];
#pragma unroll
                    for (int e = 0; e < 4; ++e) { const float a = fmaxf(v0[e], 0.f), b = fmaxf(v1[e], 0.f); v0[e] = a * a; v1[e] = b * b; }
                    u32x4 w; w.x = cvt_pk_bf16(v0[0], v0[1]); w.y = cvt_pk_bf16(v0[2], v0[3]); w.z = cvt_pk_bf16(v1[0], v1[1]); w.w = cvt_pk_bf16(v1[2], v1[3]);
                    *(u32x4*)(rowp + bj * 2 * 16384) = w; } }
    }
};
struct EpiFF2 {
    static constexpr bool PERM = true, AFTER_DRAIN = false;
    const float* mod; const bf16_t* HB; float* out; float* PART; const float* nf; unsigned* cnt;
    __device__ __forceinline__ void operator()(const f32x4 (&acc)[2][2][4][2], const Unit& u, int ui, int wr, int wc, int fr_, int fq_) const {
        int fr = fr_, fq = fq_; asm volatile("" : "+v"(fr), "+v"(fq));
        const int pm = u.pm, pn = u.pn; const int mb = pm < 16 ? 0 : 1 + ((pm - 16) >> 2);
        const __amdgpu_buffer_rsrc_t pr = __builtin_amdgcn_make_buffer_rsrc(PART, 0, 0x7fffffff, 0x00020000);
        const float* g2 = mod + mb * 12288 + 5 * 2048;
        f32x4 gv[2][2];
#pragma unroll
        for (int bj = 0; bj < 2; ++bj)
#pragma unroll
            for (int n = 0; n < 2; ++n) gv[bj][n] = *(const f32x4*)(g2 + pn * 256 + bj * 128 + wc * 32 + 8 * fq + 4 * n);
#define FF2_H(hw_) const f32x4 h0 = {__builtin_bit_cast(float, hw_.x << 16), __builtin_bit_cast(float, hw_.x & 0xffff0000u), __builtin_bit_cast(float, hw_.y << 16), __builtin_bit_cast(float, hw_.y & 0xffff0000u)}; \
                   const f32x4 h1 = {__builtin_bit_cast(float, hw_.z << 16), __builtin_bit_cast(float, hw_.z & 0xffff0000u), __builtin_bit_cast(float, hw_.w << 16), __builtin_bit_cast(float, hw_.w & 0xffff0000u)}
#pragma unroll
        for (int ai = 0; ai < 2; ++ai) {
            u32x4 hin[4][2];
#pragma unroll
            for (int m = 0; m < 4; ++m)
#pragma unroll
                for (int bj = 0; bj < 2; ++bj) hin[m][bj] = *(const u32x4*)(HB + (size_t)(pm * 8 + pn) * 65536 + (((wr * 4 + wc) * 4 + fq) * 16 + fr) * 8 + ((ai * 2 + bj) * 4 + m) * 4096);
#pragma unroll
            for (int m = 0; m < 4; ++m) { const int row = pm * 256 + ai * 128 + wr * 64 + m * 16 + fr; float s = 0.f;
#pragma unroll
                for (int bj = 0; bj < 2; ++bj) { const u32x4 hw_ = hin[m][bj]; FF2_H(hw_);
                    const f32x4 y0 = h0 + gv[bj][0] * acc[ai][bj][m][0], y1 = h1 + gv[bj][1] * acc[ai][bj][m][1];
                    s += (y0[0] * y0[0] + y0[1] * y0[1]) + (y0[2] * y0[2] + y0[3] * y0[3]) + (y1[0] * y1[0] + y1[1] * y1[1]) + (y1[2] * y1[2] + y1[3] * y1[3]); }
                s += __shfl_xor(s, 16); s += __shfl_xor(s, 32);
                if (fq == 0) __builtin_amdgcn_raw_buffer_store_b32(__builtin_bit_cast(unsigned, s), pr, (unsigned)(row * 32 + pn * 4 + wc) * 4u, 0, 16); }
            asm volatile("" ::: "memory"); }
        asm volatile("s_waitcnt vmcnt(0)" ::: "memory");
        unsigned* pc = cnt + pm * 64;
        if (fr == 0 && fq == 0) __hip_atomic_fetch_add(pc, 1u, __ATOMIC_RELAXED, __HIP_MEMORY_SCOPE_AGENT);
        { unsigned spins = 0;
          while ((unsigned)__builtin_amdgcn_readfirstlane((int)__hip_atomic_load(pc, __ATOMIC_RELAXED, __HIP_MEMORY_SCOPE_AGENT)) < 64u) { __builtin_amdgcn_s_sleep(2); if (++spins > (1u << 22)) break; } }
        asm volatile("" : "+v"(fr), "+v"(fq) :: "memory");
        asm volatile("" : "+v"(gv[0][0]), "+v"(gv[0][1]), "+v"(gv[1][0]), "+v"(gv[1][1]));
        float rs[2][4];
#pragma unroll
        for (int ai = 0; ai < 2; ++ai) { u32x4 pa[4][2];
#pragma unroll
            for (int m = 0; m < 4; ++m) { const int row = pm * 256 + ai * 128 + wr * 64 + m * 16 + fr;
#pragma unroll
                for (int q = 0; q < 2; ++q) pa[m][q] = __builtin_amdgcn_raw_buffer_load_b128(pr, (unsigned)(row * 32 + fq * 8 + 4 * q) * 4u, 0, 16); }
#pragma unroll
            for (int m = 0; m < 4; ++m) { const f32x4 a = __builtin_bit_cast(f32x4, pa[m][0]), b = __builtin_bit_cast(f32x4, pa[m][1]);
                float s = (a[0] + a[1]) + (a[2] + a[3]) + (b[0] + b[1]) + (b[2] + b[3]);
                s += __shfl_xor(s, 16); s += __shfl_xor(s, 32);
                rs[ai][m] = __builtin_amdgcn_rsqf(s * (1.0f / 2048.0f) + 1e-6f); }
            asm volatile("" ::: "memory"); }
        f32x4 nv[2][2];
#pragma unroll
        for (int bj = 0; bj < 2; ++bj)
#pragma unroll
            for (int n = 0; n < 2; ++n) nv[bj][n] = *(const f32x4*)(nf + pn * 256 + bj * 128 + wc * 32 + 8 * fq + 4 * n);
#pragma unroll
        for (int ai = 0; ai < 2; ++ai) { u32x4 hin[4][2];
#pragma unroll
            for (int m = 0; m < 4; ++m)
#pragma unroll
                for (int bj = 0; bj < 2; ++bj) hin[m][bj] = *(const u32x4*)(HB + (size_t)(pm * 8 + pn) * 65536 + (((wr * 4 + wc) * 4 + fq) * 16 + fr) * 8 + ((ai * 2 + bj) * 4 + m) * 4096);
#pragma unroll
            for (int m = 0; m < 4; ++m) { const size_t row = (size_t)pm * 256 + ai * 128 + wr * 64 + m * 16 + fr; const float r = rs[ai][m];
#pragma unroll
                for (int bj = 0; bj < 2; ++bj) { const u32x4 hw_ = hin[m][bj]; FF2_H(hw_);
                    const f32x4 y0 = h0 + gv[bj][0] * acc[ai][bj][m][0], y1 = h1 + gv[bj][1] * acc[ai][bj][m][1];
                    float* p = out + row * 2048 + pn * 256 + bj * 128 + wc * 32 + 8 * fq;
                    *(f32x4*)p = y0 * r * nv[bj][0]; *(f32x4*)(p + 4) = y1 * r * nv[bj][1]; } }
            asm volatile("" ::: "memory"); }
#undef FF2_H
    }
};

template <class Epi, class Sched, bool ALIGN_EPI = false, bool SP2 = false, int NPART = 1, int NSLOTS = 128>
__device__ __forceinline__ void gemm_phase(PG8_LAS unsigned char* lds, const Gemm g, const Sched& S, const Epi& E, float* partial = nullptr, unsigned* flags = nullptr, int pslot_split = 1 << 30, unsigned pslot_gap = 0u) {
    const int tid = threadIdx.x, wid = __builtin_amdgcn_readfirstlane(tid >> 6), lane = tid & 63, wr = wid >> 2, wc = wid & 3, fr = lane & 15, fq = lane >> 4;
    const int K = g.K;
    unsigned voffA[2], voffB[2];
    static_assert(Epi::PERM, "the weight images are stored with the perm32 row order");
#pragma unroll
    for (int i = 0; i < 2; ++i) { int R, C; stage_rc(tid * 16 + i * 8192, R, C);
        voffA[i] = g.atiled ? (unsigned)(tid * 16 + i * 8192) : (unsigned)(R * K + C) * 2u; voffB[i] = (unsigned)(tid * 16 + i * 8192); }
    const size_t kstep = (size_t)(BK * 2);
    const size_t hstep = (size_t)HALF * K * 2;
    const size_t tstep = 2 * hstep;
    const size_t kstepA = g.atiled ? (size_t)(BM * BK * 2) : kstep;
    const size_t hstepA = g.atiled ? (size_t)(HALF * BK * 2) : hstep;
    const size_t kstepB = (size_t)(BM * BK * 2), hstepB = (size_t)(HALF * BK * 2);
    const unsigned ldsw = (unsigned)wid * 1024u;
    const int aoff = lds_byte(wr * 64 + fr, fq * 8), boff = lds_byte(wc * 32 + fr, fq * 8);
#define PG8_SA(b, h) (((b) * 2 + (h)) * HTB)
#define PG8_SB(b, h) ((4 + (b) * 2 + (h)) * HTB)
#define PG8_STAGE(bufoff, gbase, voff) do { _Pragma("unroll") for (int _i = 0; _i < 2; ++_i) \
        __builtin_amdgcn_global_load_lds((const unsigned*)((const char*)(gbase) + (voff)[_i]), (PG8_LAS unsigned*)(lds + (bufoff) + ldsw + _i * 8192), 16, 0, 0); } while (0)
#define PG8_LDA(dst, b, h) do { _Pragma("unroll") for (int m = 0; m < 4; ++m) _Pragma("unroll") for (int k = 0; k < 2; ++k) dst[m][k] = *(const PG8_LAS bf16x8*)(lds + PG8_SA(b, h) + aoff + m * 2048 + k * 1024); } while (0)
#define PG8_LDB(dst, b, h) do { _Pragma("unroll") for (int n = 0; n < 2; ++n) _Pragma("unroll") for (int k = 0; k < 2; ++k) dst[n][k] = *(const PG8_LAS bf16x8*)(lds + PG8_SB(b, h) + boff + n * 2048 + k * 1024); } while (0)
#define PG8_MMA(ai, bj, At, Bt) do { __builtin_amdgcn_s_setprio(1); _Pragma("unroll") for (int m = 0; m < 4; ++m) _Pragma("unroll") for (int n = 0; n < 2; ++n) _Pragma("unroll") for (int k = 0; k < 2; ++k) \
        acc[ai][bj][m][n] = __builtin_amdgcn_mfma_f32_16x16x32_bf16(Bt[n][k], At[m][k], acc[ai][bj][m][n], 0, 0, 0); __builtin_amdgcn_s_setprio(0); } while (0)
#define PG8_WAIT_V(n) asm volatile("s_waitcnt vmcnt(" #n ")" ::: "memory")
#define PG8_WAIT_L(n) asm volatile("s_waitcnt lgkmcnt(" #n ")" ::: "memory")
#define PG8_BAR __builtin_amdgcn_s_barrier()
#define PG8_SCHED __builtin_amdgcn_sched_barrier(0)
    Unit cur, nxt; int ui = 0;
    if (!S.next(0, cur)) return;
    f32x4 acc[2][2][4][2];
#pragma unroll
    for (int a = 0; a < 2; ++a)
#pragma unroll
        for (int b = 0; b < 2; ++b)
#pragma unroll
            for (int m = 0; m < 4; ++m)
#pragma unroll
                for (int n = 0; n < 2; ++n) acc[a][b][m][n] = (f32x4){0.f, 0.f, 0.f, 0.f};
    bf16x8 At[4][2], B0[2][2], B1[2][2];
    const char* cA = (const char*)g.A + (size_t)cur.pm * tstep + (size_t)cur.k0 * kstepA; const char* cB = (const char*)g.Bt + (size_t)cur.pn * tstep + (size_t)cur.k0 * kstepB;
    S.a_ready(cur);
    if constexpr (SP2) {
        PG8_STAGE(PG8_SB(0, 0), cB, voffB); PG8_STAGE(PG8_SB(0, 1), cB + hstepB, voffB); PG8_STAGE(PG8_SA(0, 0), cA, voffA); PG8_STAGE(PG8_SA(0, 1), cA + hstepA, voffA);
        if (wr == 1) PG8_BAR;
        PG8_WAIT_V(2); PG8_BAR;
        PG8_STAGE(PG8_SB(1, 0), cB + kstepB, voffB); PG8_STAGE(PG8_SA(1, 0), cA + kstepA, voffA); PG8_STAGE(PG8_SB(1, 1), cB + hstepB + kstepB, voffB);
        PG8_WAIT_V(6); PG8_BAR;
    } else {
        PG8_STAGE(PG8_SB(0, 0), cB, voffB); PG8_STAGE(PG8_SA(0, 0), cA, voffA); PG8_STAGE(PG8_SB(0, 1), cB + hstepB, voffB); PG8_STAGE(PG8_SA(0, 1), cA + hstepA, voffA);
        if (wr == 1) PG8_BAR;
        PG8_WAIT_V(4); PG8_BAR;
        PG8_STAGE(PG8_SB(1, 0), cB + kstepB, voffB); PG8_STAGE(PG8_SA(1, 0), cA + kstepA, voffA); PG8_STAGE(PG8_SB(1, 1), cB + hstepB + kstepB, voffB);
        PG8_WAIT_V(6); PG8_BAR;
    }
    for (;;) {
        const bool has_next = S.next(ui + 1, nxt);
        const char* nA = has_next ? (const char*)g.A + (size_t)nxt.pm * tstep + (size_t)nxt.k0 * kstepA : cA; const char* nB = has_next ? (const char*)g.Bt + (size_t)nxt.pn * tstep + (size_t)nxt.k0 * kstepB : cB;
        const int nt = cur.nt;
        for (int t = 0; t < nt; t += 2) {
            const bool last = (t == nt - 2);
            const char* a1 = cA + (size_t)(t + 1) * kstepA;
            const char* a2 = last ? nA : cA + (size_t)(t + 2) * kstepA; const char* b2 = last ? nB : cB + (size_t)(t + 2) * kstepB;
            const char* a3 = a2 + kstepA; const char* b3 = b2 + kstepB;
            if (last && has_next) S.a_ready(nxt);
            if constexpr (SP2) {
            PG8_LDB(B0, 0, 0); PG8_LDB(B1, 0, 1); PG8_SCHED; PG8_LDA(At, 0, 0); PG8_STAGE(PG8_SA(1, 1), a1 + hstepA, voffA);
            PG8_WAIT_V(8); PG8_WAIT_L(0); PG8_BAR; PG8_MMA(0, 0, At, B0); PG8_MMA(0, 1, At, B1); PG8_BAR; PG8_SCHED;
            PG8_LDA(At, 0, 1); PG8_STAGE(PG8_SB(0, 0), b2, voffB); PG8_STAGE(PG8_SB(0, 1), b2 + hstepB, voffB); PG8_STAGE(PG8_SA(0, 0), a2, voffA);
            PG8_WAIT_V(8); PG8_WAIT_L(0); PG8_BAR; PG8_MMA(1, 0, At, B0); PG8_MMA(1, 1, At, B1); PG8_BAR; PG8_SCHED;
            PG8_LDB(B0, 1, 0); PG8_LDB(B1, 1, 1); PG8_SCHED; PG8_LDA(At, 1, 0); PG8_STAGE(PG8_SA(0, 1), a2 + hstepA, voffA);
            PG8_WAIT_V(8); PG8_WAIT_L(0); PG8_BAR; PG8_MMA(0, 0, At, B0); PG8_MMA(0, 1, At, B1); PG8_BAR; PG8_SCHED;
            PG8_LDA(At, 1, 1); PG8_STAGE(PG8_SB(1, 0), b3, voffB); PG8_STAGE(PG8_SB(1, 1), b3 + hstepB, voffB); PG8_STAGE(PG8_SA(1, 0), a3, voffA);
            PG8_WAIT_V(8); PG8_WAIT_L(0); PG8_BAR; PG8_MMA(1, 0, At, B0); PG8_MMA(1, 1, At, B1); PG8_BAR; PG8_SCHED;
            } else {
            PG8_LDB(B0, 0, 0); PG8_SCHED; PG8_LDA(At, 0, 0); PG8_STAGE(PG8_SA(1, 1), a1 + hstepA, voffA);
            PG8_WAIT_L(8); PG8_BAR; PG8_WAIT_L(0); PG8_MMA(0, 0, At, B0); PG8_BAR; PG8_SCHED;
            PG8_LDB(B1, 0, 1); PG8_STAGE(PG8_SB(0, 0), b2, voffB);
            PG8_BAR; PG8_WAIT_L(0); PG8_MMA(0, 1, At, B1); PG8_BAR;
            PG8_LDA(At, 0, 1); PG8_STAGE(PG8_SA(0, 0), a2, voffA);
            PG8_BAR; PG8_WAIT_L(0); PG8_MMA(1, 0, At, B0); PG8_BAR; PG8_SCHED;
            PG8_STAGE(PG8_SB(0, 1), b2 + hstepB, voffB);
            PG8_WAIT_V(6); PG8_BAR; PG8_MMA(1, 1, At, B1); PG8_BAR;
            PG8_LDB(B0, 1, 0); PG8_SCHED; PG8_LDA(At, 1, 0); PG8_STAGE(PG8_SA(0, 1), a2 + hstepA, voffA);
            PG8_WAIT_L(8); PG8_BAR; PG8_WAIT_L(0); PG8_MMA(0, 0, At, B0); PG8_BAR; PG8_SCHED;
            PG8_LDB(B1, 1, 1); PG8_STAGE(PG8_SB(1, 0), b3, voffB);
            PG8_BAR; PG8_WAIT_L(0); PG8_MMA(0, 1, At, B1); PG8_BAR;
            PG8_LDA(At, 1, 1); PG8_STAGE(PG8_SA(1, 0), a3, voffA);
            PG8_BAR; PG8_WAIT_L(0); PG8_MMA(1, 0, At, B0); PG8_BAR; PG8_SCHED;
            PG8_STAGE(PG8_SB(1, 1), b3 + hstepB, voffB);
            PG8_WAIT_V(6); PG8_BAR; PG8_MMA(1, 1, At, B1); PG8_BAR;
            }
        }
        if constexpr (ALIGN_EPI) { if (wr == 0) PG8_BAR; }
        if constexpr (!Epi::AFTER_DRAIN) {
            if (partial != nullptr) {
                int tid_o = tid; asm volatile("" : "+v"(tid_o));
                const unsigned pb = (unsigned)cur.slot * 262144u + (cur.slot >= pslot_split ? pslot_gap : 0u) + (unsigned)tid_o * 16u;
                const bool m2 = cur.mode == 2;
                if (m2) {
                    unsigned spins = 0;
                    for (;;) { unsigned ok = 1u;
#pragma unroll
                        for (int p = 0; p < NPART; ++p) if (p < cur.npart) ok &= (__hip_atomic_load(flags + (cur.slot + p) * 8 + wid, __ATOMIC_RELAXED, __HIP_MEMORY_SCOPE_AGENT) != 0u) ? 1u : 0u;
                        if (__builtin_amdgcn_readfirstlane(ok) != 0u) break;
                        __builtin_amdgcn_s_sleep(8); if (++spins > (1u << 22)) break; }
                }
#pragma unroll 1
                for (int p = 0; p < (m2 ? cur.npart : 0); ++p) {
                    const __amdgpu_buffer_rsrc_t prl = __builtin_amdgcn_make_buffer_rsrc(partial, 0, 0x7fffffff, 0x00020000);
                    const unsigned pbp = pb + (unsigned)p * 262144u;
#pragma unroll
                    for (int a = 0; a < 2; ++a) { u32x4 pv_[2][4];
#pragma unroll
                        for (int b = 0; b < 2; ++b)
#pragma unroll
                            for (int m = 0; m < 4; ++m) pv_[b][m] = __builtin_amdgcn_raw_buffer_load_b128(prl, pbp, ((a * 2 + b) * 4 + m) * 8192, 16);
#pragma unroll
                        for (int b = 0; b < 2; ++b)
#pragma unroll
                            for (int m = 0; m < 4; ++m) { const u32x4 w = pv_[b][m];
                                acc[a][b][m][0] += (f32x4){__builtin_bit_cast(float, w.x << 16), __builtin_bit_cast(float, w.x & 0xffff0000u), __builtin_bit_cast(float, w.y << 16), __builtin_bit_cast(float, w.y & 0xffff0000u)};
                                acc[a][b][m][1] += (f32x4){__builtin_bit_cast(float, w.z << 16), __builtin_bit_cast(float, w.z & 0xffff0000u), __builtin_bit_cast(float, w.w << 16), __builtin_bit_cast(float, w.w & 0xffff0000u)}; }
                        asm volatile("" ::: "memory"); }
                }
            }
            {
                if (partial != nullptr && cur.mode == 1) {
                    int tid_o = tid; asm volatile("" : "+v"(tid_o));
                    const unsigned pb = (unsigned)cur.slot * 262144u + (cur.slot >= pslot_split ? pslot_gap : 0u) + (unsigned)tid_o * 16u;
                    const __amdgpu_buffer_rsrc_t pr_ = __builtin_amdgcn_make_buffer_rsrc(partial, 0, 0x7fffffff, 0x00020000);
#pragma unroll
                    for (int a = 0; a < 2; ++a)
#pragma unroll
                        for (int b = 0; b < 2; ++b)
#pragma unroll
                            for (int m = 0; m < 4; ++m) { const u32x2 lo = pack4(acc[a][b][m][0]), hi = pack4(acc[a][b][m][1]); u32x4 w; w.x = lo.x; w.y = lo.y; w.z = hi.x; w.w = hi.y;
                                __builtin_amdgcn_raw_buffer_store_b128(w, pr_, pb, ((a * 2 + b) * 4 + m) * 8192, 16); }
                    asm volatile("s_waitcnt vmcnt(0)" ::: "memory");
                    if (lane == 0) __hip_atomic_store(flags + cur.slot * 8 + wid, 1u, __ATOMIC_RELAXED, __HIP_MEMORY_SCOPE_AGENT);
                } else E(acc, cur, ui, wr, wc, fr, fq);
            }
            S.done(cur);
        }
        if (!has_next) break;
#pragma unroll
        for (int a = 0; a < 2; ++a)
#pragma unroll
            for (int b = 0; b < 2; ++b)
#pragma unroll
                for (int m = 0; m < 4; ++m)
#pragma unroll
                    for (int n = 0; n < 2; ++n) acc[a][b][m][n] = (f32x4){0.f, 0.f, 0.f, 0.f};
        cur = nxt; cA = nA; cB = nB; ++ui;
        if constexpr (ALIGN_EPI) { if (wr == 1) PG8_BAR; }
    }
    PG8_WAIT_V(0);
    if constexpr (!ALIGN_EPI) { if (wr == 0) PG8_BAR; }
    PG8_BAR;
    if constexpr (Epi::AFTER_DRAIN) { E.fused(acc, cur, wr, wc, fr, fq, lds, wid, lane); S.done(cur); }
#undef PG8_SA
#undef PG8_SB
#undef PG8_STAGE
#undef PG8_LDA
#undef PG8_LDB
#undef PG8_MMA
#undef PG8_WAIT_V
#undef PG8_WAIT_L
#undef PG8_BAR
#undef PG8_SCHED
}
}

#define GAS __attribute__((address_space(1)))
#define LAS __attribute__((address_space(3)))
typedef unsigned short bf16;
typedef unsigned v4u __attribute__((ext_vector_type(4)));
typedef float f32x4 __attribute__((ext_vector_type(4)));
typedef short bf16x8 __attribute__((ext_vector_type(8)));
typedef GAS unsigned gu32;
typedef GAS unsigned long long gu64;
#define RLX_AGENT __ATOMIC_RELAXED, __HIP_MEMORY_SCOPE_AGENT
#define LBAR() asm volatile("s_waitcnt lgkmcnt(0)\n\ts_barrier" ::: "memory")
#define LDS_WAIT() asm volatile("s_waitcnt lgkmcnt(0)" ::: "memory")
#define VM_WAIT() asm volatile("s_waitcnt vmcnt(0)" ::: "memory")
__device__ __forceinline__ unsigned long long rt() { return __builtin_amdgcn_s_memrealtime(); }
__device__ __forceinline__ unsigned f2bf(float f) { unsigned u = __builtin_bit_cast(unsigned, f); return (u + 0x7fffu + ((u >> 16) & 1u)) >> 16; }
__device__ __forceinline__ unsigned pk2(float lo, float hi) { return f2bf(lo) | (f2bf(hi) << 16); }

#define XB_TMO      128
#define XB_XCNT(j)  (256  + 64 * (j))
#define XB_XSUB(j)  (1280 + 64 * (j))
#define XB_XGEN(j)  (2304 + 64 * (j))
#define XB_TOP      3328
#define XB_TOPGEN   3392
#define XCD_BAR_WORDS 3456
#define XB_SPIN_CAP (1u << 18)

__device__ __forceinline__ unsigned xb_ld(unsigned* p)              { return __hip_atomic_load(p, __ATOMIC_RELAXED, __HIP_MEMORY_SCOPE_AGENT); }
__device__ __forceinline__ unsigned xb_add(unsigned* p, unsigned v) { return __hip_atomic_fetch_add(p, v, __ATOMIC_RELAXED, __HIP_MEMORY_SCOPE_AGENT); }
__device__ __forceinline__ unsigned xb_xcc_id() { return (unsigned)__builtin_amdgcn_s_getreg((3 << 11) | 20) & 0xFu; }
#define XB_SPIN(cond, bar) do { unsigned _sp = 0; while (cond) { __builtin_amdgcn_s_sleep(1); \
    if ((++_sp & 255u) == 0u) { if (xb_ld(&(bar)[XB_TMO])) break; if (_sp > XB_SPIN_CAP) { atomicAdd(&(bar)[XB_TMO], 1u); break; } } } } while (0)

struct XcdBarrier {
    unsigned* bar; unsigned x;
    volatile LAS unsigned* st;
};

__device__ __forceinline__ XcdBarrier xcd_barrier_post(unsigned* bar, volatile LAS unsigned* st) {
    XcdBarrier b; b.bar = bar; b.x = xb_xcc_id(); b.st = st;
    if (threadIdx.x == 0) (void)xb_add(&bar[XB_XCNT(b.x)], 1u);
    return b;
}
__device__ __forceinline__ void xcd_barrier_complete(unsigned* bar, unsigned x, unsigned& nloc, unsigned& nx) {
    const unsigned G = gridDim.x * gridDim.y * gridDim.z;
    unsigned sum, cnt, mine, sp = 0u;
    for (;;) {
        sum = 0u; cnt = 0u; mine = 0u;
#pragma unroll
        for (unsigned j = 0; j < 16; ++j) { const unsigned c = xb_ld(&bar[XB_XCNT(j)]); sum += c; cnt += (c > 0u) ? 1u : 0u; mine = (j == x) ? c : mine; }
        if (sum == G) break;
        __builtin_amdgcn_s_sleep(1);
        if ((++sp & 255u) == 0u) { if (xb_ld(&bar[XB_TMO])) break; if (sp > XB_SPIN_CAP) { atomicAdd(&bar[XB_TMO], 1u); break; } }
    }
    nloc = mine > 0u ? mine : 1u; nx = cnt > 0u ? cnt : 1u;
}

__device__ __forceinline__ void xcd_barrier(const XcdBarrier& b) {
    asm volatile("s_waitcnt vmcnt(0)" ::: "memory");
    __syncthreads();
    if (threadIdx.x == 0) {
        unsigned* bar = b.bar;
        __builtin_amdgcn_s_waitcnt(0);
        unsigned nloc = b.st[0], nx = b.st[1];
        if (nloc == 0u) { xcd_barrier_complete(bar, b.x, nloc, nx); b.st[0] = nloc; b.st[1] = nx; }
        const unsigned old = xb_add(&bar[XB_XSUB(b.x)], 1u);
        const unsigned gen = old / nloc;
        if (old + 1u == (gen + 1u) * nloc) {
            __builtin_amdgcn_fence(__ATOMIC_RELEASE, "agent");
            asm volatile("s_waitcnt vmcnt(0)" ::: "memory");
            const unsigned og = xb_add(&bar[XB_TOP], 1u);
            const unsigned tg = og / nx;
            if (og + 1u == (tg + 1u) * nx) xb_add(&bar[XB_TOPGEN], 1u);
            else XB_SPIN(xb_ld(&bar[XB_TOPGEN]) == tg, bar);
            __builtin_amdgcn_fence(__ATOMIC_ACQUIRE, "agent");
            xb_add(&bar[XB_XGEN(b.x)], 1u);
            asm volatile("s_waitcnt vmcnt(0)" ::: "memory");
        } else {
            XB_SPIN(xb_ld(&bar[XB_XGEN(b.x)]) == gen, bar);
            __builtin_amdgcn_fence(__ATOMIC_ACQUIRE, "agent");
            asm volatile("s_waitcnt vmcnt(0)" ::: "memory");
        }
    }
    __syncthreads();
}

constexpr int NWAVES = 8;
constexpr int DM = 2048, NPROMPT = 4096, NSAMPLE = 8192, MROWS = 12288, DFF = 8192, INC = 7200, NMOD = 12288;
constexpr float EPS = 1e-6f;
constexpr size_t MiB = 1u << 20;
constexpr size_t WS_CTL = 0, CTL_ZERO_BYTES = 128 * 1024;
constexpr size_t WS_MOD = 1 * MiB;
constexpr size_t WS_C2 = WS_MOD + 9 * 12288 * 4;
constexpr size_t WS_ROPE = WS_C2 + 9 * 8192 * 4;
constexpr size_t WS_PART = 2 * MiB, WS_PART2 = 4 * MiB, WS_AB = 6 * MiB;
constexpr size_t WS_EVEC = 8 * MiB;
constexpr size_t WS_WOUT = 12 * MiB, WS_WFF1 = 20 * MiB, WS_WFF2 = 52 * MiB, WS_WIN = 84 * MiB;
constexpr size_t WS_QHAT = 84 * MiB;
constexpr size_t WS_KS = 113 * MiB, WS_VS = 137 * MiB;
constexpr size_t WS_QKVB = 161 * MiB;
constexpr size_t WS_HB = 113 * MiB;
constexpr size_t WS_OF = 161 * MiB;
constexpr size_t WS_HW = 161 * MiB;
constexpr size_t WS_MIX = 233 * MiB;
constexpr size_t WS_KHT = 281 * MiB;
constexpr size_t WS_XN = 305 * MiB;
constexpr size_t WS_NW = 305 * MiB;
constexpr size_t WS_U = 353 * MiB;
constexpr size_t WS_INTRA = 401 * MiB;
constexpr size_t WS_FF = 209 * MiB;
constexpr size_t WS_END = 425 * MiB;
static_assert(WS_ROPE + 2048 * 4 <= WS_PART && WS_EVEC + 3072 * 192 * 4 <= WS_WOUT && WS_WIN + (size_t)INC * DM * 2 <= WS_KS && WS_FF + (size_t)MROWS * DFF * 2 <= WS_INTRA + 24 * MiB, "ws map");
static_assert(WS_HW + 48 * MiB <= WS_FF, "HW below FF");
constexpr size_t YO_QA = 0, YO_GATE = 24 * MiB, YO_KP = 48 * MiB, YO_VP = 56 * MiB, YO_OF = 48 * MiB, YO_OB = 72 * MiB;
constexpr size_t OUT_Y = 0, OUT_K = 25165824, OUT_V = OUT_K + 4194304, OUT_S = OUT_V + 4194304;
constexpr int CW_TMO = 0, CW_BAR = 4096, CW_FLAG = 16384, CW_PANEL = 20480, CW_PAIR = 24576;
constexpr int RING_OFF = 0, RING_BYTES = 131072, P0_SCR_BYTES = 8 * 16640, RSTD_OFF = 135168, LDSCTL_OFF = 146432, MISC_OFF = LDSCTL_OFF + 320, LDS_BYTES = 147456;
static_assert(P0_SCR_BYTES <= RSTD_OFF && RSTD_OFF + 6 * 256 * 4 <= LDSCTL_OFF && MISC_OFF + 128 <= LDS_BYTES, "LDS map");

typedef unsigned short bf16;
typedef unsigned u32x2 __attribute__((ext_vector_type(2)));
typedef float f32x16 __attribute__((ext_vector_type(16)));
typedef short s16x4 __attribute__((ext_vector_type(4)));
__device__ __forceinline__ float bf2f(unsigned short v) { return __builtin_bit_cast(float, (unsigned)v << 16); }
__device__ __forceinline__ float bflo(unsigned w) { return __builtin_bit_cast(float, w << 16); }
__device__ __forceinline__ float bfhi(unsigned w) { return __builtin_bit_cast(float, w & 0xffff0000u); }
__device__ __forceinline__ unsigned cvtpk(float lo, float hi) { return pg8::cvt_pk_bf16(lo, hi); }
__device__ __forceinline__ float wave_sum(float v) {
#pragma unroll
    for (int o = 1; o < 64; o <<= 1) v += __shfl_xor(v, o);
    return v;
}
__device__ __forceinline__ int crow(int r, int hi) { return (r & 3) + 8 * (r >> 2) + 4 * hi; }
__device__ __forceinline__ float silu_f(float x) { return x * __builtin_amdgcn_rcpf(1.0f + __expf(-x)); }

struct Frame {
    LAS unsigned char* lds; unsigned char* ldsg;
    volatile LAS unsigned* MISC;
    gu32* ctl;
    int tid, lane, wave, vcu, G;
    const float* const* inp; float* out; unsigned char* ws;
};

struct TileSrc { const float* src; bf16* dst; int K, N, n0; bool cval; };
__device__ __forceinline__ TileSrc p0_tile(Frame& F, int it, int lane) {
    constexpr int I_IN = (DM / 64) * ((INC + 63) / 64), I_OUT = (DM / 64) * (DM / 64), I_F1 = (DM / 64) * (DFF / 64);
    const float* W; bf16* WT; int K, N; int r = it;
    if (r < I_IN) { W = F.inp[10]; WT = (bf16*)(F.ws + WS_WIN); K = DM; N = INC; }
    else if ((r -= I_IN) < I_OUT) { W = F.inp[17]; WT = (bf16*)(F.ws + WS_WOUT); K = DM; N = DM; }
    else if ((r -= I_OUT) < I_F1) { W = F.inp[19]; WT = (bf16*)(F.ws + WS_WFF1); K = DM; N = DFF; }
    else { r -= I_F1; W = F.inp[20]; WT = (bf16*)(F.ws + WS_WFF2); K = DFF; N = DM; }
    const int nblk = (N + 63) / 64, kb = r / nblk, nb = r % nblk, k0 = 64 * kb, n0 = 64 * nb; const int c = 4 * (lane & 15);
    TileSrc t; t.src = W + (size_t)(k0 + (lane >> 4)) * N + n0 + c; t.dst = WT + (size_t)((n0 >> 8) * (K >> 6) + kb) * 16384; t.K = K;     t.N = N; t.n0 = n0; t.cval = (n0 + c) < N; return t;
}
__device__ __forceinline__ void p0_tile_load(Frame& F, int it, int lane, f32x4 (&v)[16]) {
    const TileSrc t = p0_tile(F, it, lane);
    const float* p = t.src; const size_t step = (size_t)4 * t.N;
#pragma unroll
    for (int i = 0; i < 16; ++i) { v[i] = (f32x4){0.f, 0.f, 0.f, 0.f}; if (t.cval) v[i] = __builtin_nontemporal_load((const f32x4*)p); p += step; asm volatile("" : "+v"(p)); }
}
__device__ __forceinline__ void p0_tile_store(Frame& F, int it, const f32x4 (&v)[16], LAS float* scr, int lane) {
    const TileSrc t = p0_tile(F, it, lane);
    const int c = 4 * (lane & 15);
#pragma unroll
    for (int i = 0; i < 16; ++i) { LAS float* d = scr + (4 * i + (lane >> 4)) * 65 + c; d[0] = v[i][0]; d[1] = v[i][1]; d[2] = v[i][2]; d[3] = v[i][3]; }
    LDS_WAIT(); asm volatile("" ::: "memory");
    const int c8 = lane & 7;
#pragma unroll
    for (int j = 0; j < 8; ++j) { const int n = (lane >> 3) + 8 * j; const LAS float* s_ = scr + (8 * c8) * 65 + n;
        v4u o; o.x = cvtpk(s_[0 * 65], s_[1 * 65]); o.y = cvtpk(s_[2 * 65], s_[3 * 65]); o.z = cvtpk(s_[4 * 65], s_[5 * 65]); o.w = cvtpk(s_[6 * 65], s_[7 * 65]);
        const int nb_ = (t.n0 & 255) + n, ri_ = (nb_ & 96) + pg8::perm32inv(nb_ & 31);
        bf16* dp_ = t.dst + (nb_ >> 7) * 8192 + (pg8::lds_byte(ri_, 8 * c8) >> 1);
        if (t.n0 + n < t.N) { if (t.N == INC) *(GAS v4u*)dp_ = o; else __builtin_nontemporal_store(o, (GAS v4u*)dp_); }
        if (j & 1) __builtin_amdgcn_sched_barrier(0); }
    LDS_WAIT(); asm volatile("" ::: "memory");
}
__device__ __forceinline__ void p0_phase(Frame& F) {
    const float* c_lat = F.inp[5]; const float* c_ctx = F.inp[6]; const float* w_mod = F.inp[7]; const float* b_mod = F.inp[8];
    float* MOD = (float*)(F.ws + WS_MOD);
    const int bid = F.vcu;
    if (bid < 192) {
        LAS float* sil = (LAS float*)(F.lds);
        LAS float* red = (LAS float*)(F.lds + 9 * 2048 * 4);
        for (int idx = F.tid; idx < 9 * 2048; idx += 512) { const int b = idx >> 11, k = idx & 2047; const float cv = (b == 0) ? c_ctx[k] : c_lat[(b - 1) * 2048 + k]; sil[idx] = silu_f(cv); }
        __syncthreads();
        const int c0 = 64 * bid + 4 * (F.lane & 15);
        f32x4 acc[9];
#pragma unroll
        for (int b = 0; b < 9; ++b) acc[b] = (f32x4){0.f, 0.f, 0.f, 0.f};
        const int kbase = 256 * F.wave + (F.lane >> 4);
        for (int it0 = 0; it0 < 64; it0 += 16) {
            f32x4 wv[16];
#pragma unroll
            for (int u = 0; u < 16; ++u) wv[u] = __builtin_nontemporal_load((const f32x4*)(w_mod + (size_t)(kbase + 4 * (it0 + u)) * NMOD + c0));
#pragma unroll
            for (int u = 0; u < 16; ++u) { const int k = kbase + 4 * (it0 + u);
#pragma unroll
                for (int b = 0; b < 9; ++b) { const float s_ = sil[b * 2048 + k]; acc[b] += wv[u] * s_; }
                if ((u & 1) == 1) __builtin_amdgcn_sched_barrier(0); }
        }
#pragma unroll
        for (int b = 0; b < 9; ++b)
#pragma unroll
            for (int e = 0; e < 4; ++e) { float v = acc[b][e]; v += __shfl_xor(v, 16); v += __shfl_xor(v, 32); acc[b][e] = v; }
        if (F.lane < 16) {
#pragma unroll
            for (int b = 0; b < 9; ++b)
#pragma unroll
                for (int e = 0; e < 4; ++e) red[(F.wave * 9 + b) * 64 + 4 * F.lane + e] = acc[b][e]; }
        __syncthreads();
        for (int idx = F.tid; idx < 9 * 64; idx += 512) { const int b = idx >> 6, cc = idx & 63; float s_ = b_mod[64 * bid + cc];
#pragma unroll
            for (int w = 0; w < 8; ++w) s_ += red[(w * 9 + b) * 64 + cc];
            MOD[b * NMOD + 64 * bid + cc] = s_; }
        __syncthreads();
    } else if (bid == 255) { float* rope = (float*)(F.ws + WS_ROPE);
        for (int idx = F.tid; idx < 1024; idx += 512) { const int pos = idx >> 4, i = idx & 15; const float inv = 1.0f / powf(10000.0f, (float)i * (1.0f / 16.0f)); const float ang = (float)pos * inv;
            rope[idx] = cosf(ang); rope[1024 + idx] = sinf(ang); } }
    const int myslots = (bid < 192) ? 5 : 7;
    const int slot0 = (bid < 192) ? (bid * NWAVES + F.wave) * 5 : 192 * NWAVES * 5 + ((bid - 192) * NWAVES + F.wave) * 7;
    constexpr int NSLOT = 192 * NWAVES * 5 + 64 * NWAVES * 7;
    {
        LAS float* scr = (LAS float*)(F.lds + F.wave * 16640);
        constexpr int NITEMS = (DM / 64) * ((INC + 63) / 64) + (DM / 64) * (DM / 64) + (DM / 64) * (DFF / 64) + (DFF / 64) * (DM / 64);
        f32x4 ta[16], tb[16];
        const int gw_ = bid * NWAVES + F.wave, NGW_ = F.G * NWAVES;
#define P0_ITEM(q) (gw_ + NGW_ * (q))
        int q = 0; int ia = P0_ITEM(0);
        if (ia < NITEMS) { p0_tile_load(F, ia, F.lane, ta);
            for (;;) {
                const int ib = P0_ITEM(q + 1); const bool hb = ib < NITEMS;
                if (hb) p0_tile_load(F, ib, F.lane, tb);
                p0_tile_store(F, ia, ta, scr, F.lane);
                if (!hb) break;
                const int ic = P0_ITEM(q + 2); const bool hc = ic < NITEMS;
                if (hc) p0_tile_load(F, ic, F.lane, ta);
                p0_tile_store(F, ib, tb, scr, F.lane);
                if (!hc) break;
                q += 2; ia = ic;
            }
        }
#undef P0_ITEM
    }
    {
        const float* ck = F.inp[2]; const float* cv = F.inp[3];
        bf16* KS = (bf16*)(F.ws + WS_KS); bf16* VS = (bf16*)(F.ws + WS_VS);
        for (int s_ = 0; s_ < myslots; ++s_)
            for (int base = slot0 + s_; base < 2 * 8192; base += 4 * NSLOT) {
                f32x4 a[4], b[4];
#pragma unroll
                for (int u = 0; u < 4; ++u) { const int it = base + u * NSLOT; if (it < 2 * 8192) { const bool isV = it >= 8192; const int j = isV ? it - 8192 : it; const float* src = (isV ? cv : ck) + (size_t)j * 512 + 8 * F.lane; a[u] = __builtin_nontemporal_load((const f32x4*)src); b[u] = __builtin_nontemporal_load((const f32x4*)(src + 4)); } }
#pragma unroll
                for (int u = 0; u < 4; ++u) { const int it = base + u * NSLOT; if (it < 2 * 8192) { const bool isV = it >= 8192; const int j = isV ? it - 8192 : it;
                    const size_t e0 = (size_t)j * 512 + 8 * F.lane; const int bh = (int)(e0 >> 16); const size_t rem = e0 & 65535;
                    v4u o; o.x = cvtpk(a[u][0], a[u][1]); o.y = cvtpk(a[u][2], a[u][3]); o.z = cvtpk(b[u][0], b[u][1]); o.w = cvtpk(b[u][2], b[u][3]);
                    __builtin_nontemporal_store(o, (GAS v4u*)((isV ? VS : KS) + (size_t)bh * 1536 * 128 + rem)); } }
            }
    }
}
__device__ __forceinline__ float wsum64(float v) {
    v += __builtin_bit_cast(float, __builtin_amdgcn_update_dpp(0, __builtin_bit_cast(int, v), 0xB1, 0xf, 0xf, true));
    v += __builtin_bit_cast(float, __builtin_amdgcn_update_dpp(0, __builtin_bit_cast(int, v), 0x4E, 0xf, 0xf, true));
    v += __builtin_bit_cast(float, __builtin_amdgcn_update_dpp(0, __builtin_bit_cast(int, v), 0x141, 0xf, 0xf, true));
    v += __builtin_bit_cast(float, __builtin_amdgcn_update_dpp(0, __builtin_bit_cast(int, v), 0x140, 0xf, 0xf, true));
    const int b = __builtin_bit_cast(int, v);
    return __builtin_bit_cast(float, __builtin_amdgcn_readlane(b, 0)) + __builtin_bit_cast(float, __builtin_amdgcn_readlane(b, 16)) + __builtin_bit_cast(float, __builtin_amdgcn_readlane(b, 32)) + __builtin_bit_cast(float, __builtin_amdgcn_readlane(b, 48));
}
__device__ __forceinline__ void p1_phase(Frame& F) {
    const float* MOD = (const float*)(F.ws + WS_MOD); const float* norm1 = F.inp[9];
    bf16* XN = (bf16*)(F.ws + WS_XN);
    const int gw = F.vcu * NWAVES + F.wave, NGW = F.G * NWAVES;
    {
        const bf16* W1t = (const bf16*)(F.ws + WS_WFF1); float* C2 = (float*)(F.ws + WS_C2);
        const int n = F.lane & 15, g = F.lane >> 4;
        LAS float* red = (LAS float*)F.lds;
        for (int id = F.vcu; id < DFF / 16; id += F.G) {
            const int f_ = id * 16 + n;
            const int fb_ = f_ & 255, fri_ = (fb_ & 96) + pg8::perm32inv(fb_ & 31);
            const bf16* bp = W1t + (size_t)((f_ >> 8) * 32 + 4 * F.wave) * 16384 + (fb_ >> 7) * 8192;
            const float* ap = MOD + (size_t)(n < 9 ? n : 0) * NMOD + 3 * DM + 256 * F.wave + 8 * g;
            f32x4 acc = {0.f, 0.f, 0.f, 0.f};
#pragma unroll
            for (int st = 0; st < 8; ++st) {
                const bf16x8 bfr = *(const bf16x8*)(bp + (st >> 1) * 16384 + (pg8::lds_byte(fri_, 32 * (st & 1) + 8 * g) >> 1));
                f32x4 a0 = *(const f32x4*)(ap + 32 * st), a1 = *(const f32x4*)(ap + 32 * st + 4);
                if (n >= 9) { a0 = (f32x4){0.f, 0.f, 0.f, 0.f}; a1 = a0; }
                v4u aw; aw.x = cvtpk(a0[0], a0[1]); aw.y = cvtpk(a0[2], a0[3]); aw.z = cvtpk(a1[0], a1[1]); aw.w = cvtpk(a1[2], a1[3]);
                acc = __builtin_amdgcn_mfma_f32_16x16x32_bf16(__builtin_bit_cast(bf16x8, aw), bfr, acc, 0, 0, 0);
            }
#pragma unroll
            for (int r = 0; r < 4; ++r) red[(F.wave * 16 + 4 * g + r) * 17 + n] = acc[r];
            __syncthreads();
            if (F.tid < 9 * 16) { const int mb = F.tid >> 4, cc = F.tid & 15; float v = 0.f;
#pragma unroll
                for (int w = 0; w < 8; ++w) v += red[(w * 16 + mb) * 17 + cc];
                C2[mb * DFF + id * 16 + cc] = v; }
            __syncthreads();
        }
    }
    if (F.G * 48 == MROWS) {
        int lane = F.lane; asm volatile("" : "+v"(lane));
        const int rbase = 48 * F.vcu;
        f32x4 v[8], vn[8], gsv[8], bv[8]; int cmb = -1;
#define P1_ROW(q) (rbase + 16 * ((q) >> 1) + 2 * F.wave + ((q) & 1))
        { const int r0_ = P1_ROW(0); const float* xr = (r0_ < NPROMPT ? F.inp[0] + (size_t)r0_ * DM : F.inp[1] + (size_t)(r0_ - NPROMPT) * DM) + 8 * lane;
#pragma unroll
            for (int j = 0; j < 4; ++j) { v[2 * j] = __builtin_nontemporal_load((const f32x4*)(xr + 512 * j)); v[2 * j + 1] = __builtin_nontemporal_load((const f32x4*)(xr + 512 * j + 4)); } }
        for (int q = 0; q < 6; ++q) {
            const int row = P1_ROW(q);
            if (q + 1 < 6) { const int nrow = P1_ROW(q + 1); const float* xr = (nrow < NPROMPT ? F.inp[0] + (size_t)nrow * DM : F.inp[1] + (size_t)(nrow - NPROMPT) * DM) + 8 * lane;
#pragma unroll
                for (int j = 0; j < 4; ++j) { vn[2 * j] = __builtin_nontemporal_load((const f32x4*)(xr + 512 * j)); vn[2 * j + 1] = __builtin_nontemporal_load((const f32x4*)(xr + 512 * j + 4)); } }
            const int mb = row < NPROMPT ? 0 : 1 + ((row - NPROMPT) >> 10);
            if (mb != cmb) { cmb = mb; const float* sh1 = MOD + mb * NMOD + 8 * lane; const float* sc1 = sh1 + DM; const float* n1 = norm1 + 8 * lane;
#pragma unroll
                for (int j = 0; j < 8; ++j) { const int k = 512 * (j >> 1) + 4 * (j & 1); const f32x4 g = *(const f32x4*)(n1 + k), s_ = *(const f32x4*)(sc1 + k); gsv[j] = g * (s_ + 1.0f); bv[j] = *(const f32x4*)(sh1 + k); } }
            float ss = 0.f;
#pragma unroll
            for (int j = 0; j < 8; ++j) ss += (v[j][0] * v[j][0] + v[j][1] * v[j][1]) + (v[j][2] * v[j][2] + v[j][3] * v[j][3]);
            const float rstd = rsqrtf(wsum64(ss) * (1.0f / DM) + EPS);
            const int r15 = 2 * F.wave + (q & 1);
            LAS unsigned char* sp = F.lds + ((q >> 1) & 1) * 65536 + (lane >> 3) * 2048 + ((lane >> 2) & 1) * 1024 + ((r15 * 64 + 16 * (lane & 3)) ^ ((r15 & 8) << 2));
#pragma unroll
            for (int j = 0; j < 4; ++j) { const f32x4 o0 = v[2 * j] * rstd * gsv[2 * j] + bv[2 * j], o1 = v[2 * j + 1] * rstd * gsv[2 * j + 1] + bv[2 * j + 1];
                v4u w; w.x = cvtpk(o0[0], o0[1]); w.y = cvtpk(o0[2], o0[3]); w.z = cvtpk(o1[0], o1[1]); w.w = cvtpk(o1[2], o1[3]); *(LAS v4u*)(sp + j * 8 * 2048) = w; }
#pragma unroll
            for (int j = 0; j < 8; ++j) v[j] = vn[j];
            if (q & 1) {
                LBAR();
                const int Rg = rbase + 16 * (q >> 1); const LAS unsigned char* src = F.lds + ((q >> 1) & 1) * 65536;
                unsigned char* dst = (unsigned char*)XN + (size_t)(Rg >> 8) * 32 * 32768 + ((Rg >> 7) & 1) * 16384 + ((Rg & 127) >> 4) * 2048 + (F.tid & 127) * 16;
#pragma unroll
                for (int it = 0; it < 8; ++it) { const v4u w = *(const LAS v4u*)(src + (F.tid + 512 * it) * 16); *(GAS v4u*)(dst + (size_t)((F.tid >> 7) + 4 * it) * 32768) = w; }
            }
        }
#undef P1_ROW
    }
}
__device__ __forceinline__ void p2_ab(Frame& F) {
    const bf16* XN = (const bf16*)(F.ws + WS_XN); const bf16* Wab = (const bf16*)(F.ws + WS_WIN) + (size_t)28 * 32 * 16384;   float* AB = (float*)(F.ws + WS_AB);
    const int r32 = F.lane & 31, hi = F.lane >> 5;
    LAS float* red = (LAS float*)F.lds;
    for (int rb = F.vcu; rb < MROWS / 32; rb += F.G) {
        const int arow = rb * 32 + r32;
        const bf16* ap = XN + (size_t)((arow >> 8) * 32 + 4 * F.wave) * 16384 + ((arow >> 7) & 1) * 8192; const bf16* bp = Wab + (size_t)(4 * F.wave) * 16384; const int bri = pg8::perm32inv(r32);
        f32x16 acc = {};
#pragma unroll
        for (int s_ = 0; s_ < 16; ++s_) { const bf16x8 a = *(const bf16x8*)(ap + (s_ >> 2) * 16384 + (pg8::lds_byte(arow & 127, 16 * (s_ & 3) + 8 * hi) >> 1)), b = *(const bf16x8*)(bp + (s_ >> 2) * 16384 + (pg8::lds_byte(bri, 16 * (s_ & 3) + 8 * hi) >> 1)); acc = __builtin_amdgcn_mfma_f32_32x32x16_bf16(a, b, acc, 0, 0, 0); }
#pragma unroll
        for (int r = 0; r < 16; ++r) red[(F.wave * 32 + crow(r, hi)) * 33 + r32] = acc[r];
        __syncthreads();
        for (int o = F.tid; o < 1024; o += 512) { const int row = o >> 5, col = o & 31; float v = 0.f;
#pragma unroll
            for (int w = 0; w < 8; ++w) v += red[(w * 32 + row) * 33 + col];
            AB[(size_t)(rb * 32 + row) * 32 + col] = v; }
        __syncthreads();
    }
}
namespace dattn {
using bf16x8 = __attribute__((ext_vector_type(8))) short;
using u32x4 = __attribute__((ext_vector_type(4))) unsigned;
constexpr int KVBLK = 64; constexpr float SCALE = 0.125f; constexpr float THR = 8.f;
constexpr int SHM_V = 64 * 128 * 2, SHM_K = 64 * 128 * 2;
#define KSWZ(row, colB) ((row) * 256 + ((colB) ^ (((row) & 7) << 4)))
#define SBAR() __builtin_amdgcn_sched_barrier(0)
__device__ __forceinline__ void partialSM(f32x16& p0, f32x16& p1, float& m_reg, float& mn, float& alpha) {
  constexpr float C = SCALE * 1.4426950408889634f;
  float pmax = p0[0];
#pragma unroll
  for (int r = 1; r < 16; ++r) pmax = fmaxf(pmax, p0[r]);
#pragma unroll
  for (int r = 0; r < 16; ++r) pmax = fmaxf(pmax, p1[r]);
  { auto rr = __builtin_amdgcn_permlane32_swap(__float_as_uint(pmax), __float_as_uint(pmax), false, false);
    pmax = fmaxf(__uint_as_float(rr[0]), __uint_as_float(rr[1])); }
  if (__builtin_expect(__all(pmax - m_reg <= THR / SCALE), 1)) { mn = m_reg; alpha = 1.f; }
  else { mn = fmaxf(m_reg, pmax); alpha = __builtin_amdgcn_exp2f((m_reg - mn) * C); m_reg = mn; }
  float mnC = -mn * C;
#pragma unroll
  for (int r = 0; r < 16; ++r) p0[r] = fmaf(p0[r], C, mnC);
#pragma unroll
  for (int r = 0; r < 16; ++r) p1[r] = fmaf(p1[r], C, mnC);
#pragma unroll
  for (int r = 0; r < 16; ++r) p0[r] = __builtin_amdgcn_exp2f(p0[r]);
}
__device__ __forceinline__ void finishSM(f32x16& p0, f32x16& p1, float alpha, float& l_reg, bf16x8& pa0, bf16x8& pa1, bf16x8& pa2, bf16x8& pa3) {
#pragma unroll
  for (int r = 0; r < 16; ++r) p1[r] = __builtin_amdgcn_exp2f(p1[r]);
  float ps = 0;
#pragma unroll
  for (int r = 0; r < 16; ++r) ps += p0[r];
#pragma unroll
  for (int r = 0; r < 16; ++r) ps += p1[r];
  { auto rr = __builtin_amdgcn_permlane32_swap(__float_as_uint(ps), __float_as_uint(ps), false, false);
    ps = __uint_as_float(rr[0]) + __uint_as_float(rr[1]); }
  l_reg = l_reg * alpha + ps;
#define PK4(P, BASE, OUT) do { unsigned a0 = cvtpk(P[BASE + 0], P[BASE + 1]), a1 = cvtpk(P[BASE + 2], P[BASE + 3]);   \
    unsigned b0 = cvtpk(P[BASE + 4], P[BASE + 5]), b1 = cvtpk(P[BASE + 6], P[BASE + 7]);                              \
    auto r0 = __builtin_amdgcn_permlane32_swap(a0, b0, false, false); auto r1 = __builtin_amdgcn_permlane32_swap(a1, b1, false, false); \
    u32x4 w = {r0[0], r1[0], r0[1], r1[1]}; OUT = *reinterpret_cast<bf16x8*>(&w); } while (0)
  PK4(p0, 0, pa0); PK4(p0, 8, pa1); PK4(p1, 0, pa2); PK4(p1, 8, pa3);
#undef PK4
}
__device__ __forceinline__ void qkt(f32x16& p0, f32x16& p1, const bf16* Ks, const bf16x8* qr, int r32, int hi, int map) {
  p0 = f32x16{}; p1 = f32x16{};
#pragma unroll
  for (int d0 = 0; d0 < 4; ++d0) { int cb = (map * 64 + d0 * 16 + hi * 8) * 2;
    bf16x8 b0 = *reinterpret_cast<const bf16x8*>((const char*)Ks + KSWZ(r32, cb));
    bf16x8 b1 = *reinterpret_cast<const bf16x8*>((const char*)Ks + KSWZ(32 + r32, cb));
    p0 = __builtin_amdgcn_mfma_f32_32x32x16_bf16(b0, qr[d0], p0, 0, 0, 0);
    p1 = __builtin_amdgcn_mfma_f32_32x32x16_bf16(b1, qr[d0], p1, 0, 0, 0); }
}
__device__ __forceinline__ int v_st(int k, int c) { const int kk = (k & ~0xC) | ((k & 4) << 1) | ((k & 8) >> 1); return ((kk >> 3) * 4 + (c >> 5)) * 512 + ((kk & 7) * 32 + (c & 31)) * 2; }
__device__ __forceinline__ int v_rd_base(int lane) { return ((lane & 3) << 3) | (((lane >> 2) & 3) << 6) | (((lane >> 4) & 1) << 5) | (((lane >> 5) & 1) << 8); }
constexpr int v_rd_off(int d0, int ks, int half) { return d0 * 512 + ks * 4096 + half * 2048; }
template <int OFF> __device__ __forceinline__ s16x4 tr_read(int vb) {
  s16x4 r; asm volatile("ds_read_b64_tr_b16 %0, %1 offset:%2" : "=&v"(r) : "v"(vb), "i"(OFF) : "memory"); return r;
}
template <int D0> __device__ __forceinline__ void pv_one(f32x16& od, int vb, bf16x8 pa0, bf16x8 pa1, bf16x8 pa2, bf16x8 pa3) {
  const s16x4 l0 = tr_read<v_rd_off(D0, 0, 0)>(vb), h0 = tr_read<v_rd_off(D0, 0, 1)>(vb), l1 = tr_read<v_rd_off(D0, 1, 0)>(vb), h1 = tr_read<v_rd_off(D0, 1, 1)>(vb);
  const s16x4 l2 = tr_read<v_rd_off(D0, 2, 0)>(vb), h2 = tr_read<v_rd_off(D0, 2, 1)>(vb), l3 = tr_read<v_rd_off(D0, 3, 0)>(vb), h3 = tr_read<v_rd_off(D0, 3, 1)>(vb);
  asm volatile("s_waitcnt lgkmcnt(0)" ::: "memory"); SBAR();
#define PK(L, H) (bf16x8){L[0], L[1], L[2], L[3], H[0], H[1], H[2], H[3]}
  od = __builtin_amdgcn_mfma_f32_32x32x16_bf16(pa0, PK(l0, h0), od, 0, 0, 0);
  od = __builtin_amdgcn_mfma_f32_32x32x16_bf16(pa1, PK(l1, h1), od, 0, 0, 0);
  od = __builtin_amdgcn_mfma_f32_32x32x16_bf16(pa2, PK(l2, h2), od, 0, 0, 0);
  od = __builtin_amdgcn_mfma_f32_32x32x16_bf16(pa3, PK(l3, h3), od, 0, 0, 0);
#undef PK
}
__device__ __forceinline__ void pv_d0(f32x16* o, int vb, bf16x8 pa0, bf16x8 pa1, bf16x8 pa2, bf16x8 pa3) {
  pv_one<0>(o[0], vb, pa0, pa1, pa2, pa3); pv_one<1>(o[1], vb, pa0, pa1, pa2, pa3); pv_one<2>(o[2], vb, pa0, pa1, pa2, pa3); pv_one<3>(o[3], vb, pa0, pa1, pa2, pa3);
}
__device__ __forceinline__ void attn_unit(const bf16* __restrict__ Qb, const bf16* __restrict__ Kh, const bf16* __restrict__ Vh, bf16* __restrict__ Ob, int seq, float lam, const float* __restrict__ subln, char* lds) {
  constexpr int LDQ = 1024, LDK = 128;
  const int tid = threadIdx.x, wid = tid >> 6, lane = tid & 63, r32 = lane & 31, hi = lane >> 5;
  const int map = wid >> 2, qw = wid & 3;
  bf16* V_lds = (bf16*)lds; bf16* K_lds = (bf16*)(lds + 2 * SHM_V);
  float* ws = (float*)(lds + 2 * SHM_V + 2 * SHM_K) + wid * 64; float* li_l = ws; float* al_l = ws + 32;
  float m_reg = -1e30f, l_reg = 0; f32x16 o[4] = {}; bf16x8 qr[4];
  const bf16* Qw = Qb + (long)(qw * 32 + r32) * LDQ + map * 64 + hi * 8;
#pragma unroll
  for (int d0 = 0; d0 < 4; ++d0) qr[d0] = *reinterpret_cast<const bf16x8*>(Qw + d0 * 16);
  const int sr = tid >> 4, sc = (tid & 15) * 8, vst0 = v_st(sr, sc), vst1 = v_st(32 + sr, sc);
  const int vb0 = (int)(uintptr_t)V_lds + v_rd_base(lane);
  struct { bf16x8 vs0, vs1, ks0, ks1; } sr_[2];
#define LD8(p) (*reinterpret_cast<const bf16x8*>(p))
#define SLOAD(i, k0) do { sr_[i].vs0 = LD8(&Vh[(long)((k0) + sr) * LDK + sc]); sr_[i].vs1 = LD8(&Vh[(long)((k0) + 32 + sr) * LDK + sc]); \
    sr_[i].ks0 = LD8(&Kh[(long)((k0) + sr) * LDK + sc]); sr_[i].ks1 = LD8(&Kh[(long)((k0) + 32 + sr) * LDK + sc]); } while (0)
#define SWRITE(b, i) do { *(bf16x8*)((char*)V_lds + (b) * SHM_V + vst0) = sr_[i].vs0;          \
    *(bf16x8*)((char*)V_lds + (b) * SHM_V + vst1) = sr_[i].vs1; int kc = sc * 2;               \
    *(bf16x8*)((char*)K_lds + (b) * SHM_K + KSWZ(sr, kc)) = sr_[i].ks0;                       \
    *(bf16x8*)((char*)K_lds + (b) * SHM_K + KSWZ(32 + sr, kc)) = sr_[i].ks1; } while (0)
#define SWAIT() asm volatile("s_waitcnt vmcnt(4)" ::: "memory")
#define RESC(a) do { if (__any((a) < 1.f)) { if (hi == 0) al_l[r32] = (a); asm volatile("s_waitcnt lgkmcnt(0)" ::: "memory"); \
    _Pragma("unroll") for (int d = 0; d < 4; ++d) _Pragma("unroll") for (int r = 0; r < 16; ++r) o[d][r] *= al_l[crow(r, hi)]; } } while (0)
  f32x16 pA0, pA1, pB0, pB1; float mnA, mnB, alA, alB; bf16x8 pa0, pa1, pa2, pa3; const int NT = seq / KVBLK;
  constexpr int SE = 0, SO = 1;
  SLOAD(SE, 0); asm volatile("s_waitcnt vmcnt(0)" ::: "memory"); SWRITE(0, SE); __syncthreads();
  qkt(pA0, pA1, K_lds, qr, r32, hi, map); partialSM(pA0, pA1, m_reg, mnA, alA);
  SLOAD(SO, KVBLK); if (2 < NT) SLOAD(SE, 2 * KVBLK);
  SWAIT(); SWRITE(1, SO); __syncthreads();
  for (int j = 1; j + 1 < NT; j += 2) {
    SBAR(); qkt(pB0, pB1, (bf16*)((char*)K_lds + SHM_K), qr, r32, hi, map);
    finishSM(pA0, pA1, alA, l_reg, pa0, pa1, pa2, pa3); SBAR();
    SLOAD(SO, (j + 2) * KVBLK); SBAR();
    pv_d0(o, vb0, pa0, pa1, pa2, pa3); partialSM(pB0, pB1, m_reg, mnB, alB);
    __syncthreads(); SWAIT(); SWRITE(0, SE);
    RESC(alB); __syncthreads();
    SBAR(); qkt(pA0, pA1, K_lds, qr, r32, hi, map);
    finishSM(pB0, pB1, alB, l_reg, pa0, pa1, pa2, pa3); SBAR();
    if (j + 3 < NT) SLOAD(SE, (j + 3) * KVBLK); SBAR();
    pv_d0(o, vb0 + (int)SHM_V, pa0, pa1, pa2, pa3); partialSM(pA0, pA1, m_reg, mnA, alA);
    __syncthreads(); SWAIT(); SWRITE(1, SO);
    RESC(alA); __syncthreads();
  }
  SBAR(); qkt(pB0, pB1, (bf16*)((char*)K_lds + SHM_K), qr, r32, hi, map);
  finishSM(pA0, pA1, alA, l_reg, pa0, pa1, pa2, pa3); SBAR();
  pv_d0(o, vb0, pa0, pa1, pa2, pa3); partialSM(pB0, pB1, m_reg, mnB, alB);
  __syncthreads(); RESC(alB);
  finishSM(pB0, pB1, alB, l_reg, pa0, pa1, pa2, pa3); SBAR();
  pv_d0(o, vb0 + (int)SHM_V, pa0, pa1, pa2, pa3);
  if (hi == 0) li_l[r32] = l_reg; asm volatile("s_waitcnt lgkmcnt(0)" ::: "memory");
  float rli[16];
#pragma unroll
  for (int r = 0; r < 16; ++r) rli[r] = __builtin_amdgcn_rcpf(li_l[crow(r, hi)]);
  __syncthreads();
  int r32e = r32, hie = hi; asm volatile("" : "+v"(r32e), "+v"(hie));
  float* X = (float*)lds;
  if (map == 1) {
#pragma unroll
    for (int r = 0; r < 16; ++r)
#pragma unroll
      for (int d0 = 0; d0 < 4; ++d0) X[(qw * 32 + crow(r, hie)) * 128 + d0 * 32 + r32e] = o[d0][r] * rli[r];
  }
  __syncthreads();
  if (map == 0) {
    float sw[4];
#pragma unroll
    for (int d0 = 0; d0 < 4; ++d0) sw[d0] = subln[d0 * 32 + r32e] * 0.8f;
#pragma unroll
    for (int r = 0; r < 16; ++r) { float val[4]; float ss = 0.f;
#pragma unroll
      for (int d0 = 0; d0 < 4; ++d0) { val[d0] = o[d0][r] * rli[r] - lam * X[(qw * 32 + crow(r, hie)) * 128 + d0 * 32 + r32e]; ss += val[d0] * val[d0]; }
      ss += __shfl_xor(ss, 1); ss += __shfl_xor(ss, 2); ss += __shfl_xor(ss, 4); ss += __shfl_xor(ss, 8); ss += __shfl_xor(ss, 16);
      const float rs = rsqrtf(ss * (1.0f / 128.0f) + 1e-6f);
#pragma unroll
      for (int d0 = 0; d0 < 4; ++d0) ((unsigned short*)Ob)[(d0 >> 1) * 16384 + (pg8::lds_byte(qw * 32 + crow(r, hie), (d0 & 1) * 32 + r32e) >> 1)] = (unsigned short)(cvtpk(val[d0] * rs * sw[d0], 0.f) & 0xffffu); }
  }
  __syncthreads();
#undef LD8
#undef SLOAD
#undef SWRITE
#undef SWAIT
#undef RESC
}
#undef KSWZ
#undef SBAR
}

template <int CTRL> __device__ __forceinline__ float dppf(float v) { return __builtin_bit_cast(float, __builtin_amdgcn_update_dpp(0, __builtin_bit_cast(int, v), CTRL, 0xf, 0xf, true)); }
__device__ __forceinline__ float wave_sum_dpp(float v) {
    v += dppf<0xB1>(v); v += dppf<0x4E>(v); v += dppf<0x141>(v); v += dppf<0x140>(v);
    const int b = __builtin_bit_cast(int, v);
    return __builtin_bit_cast(float, __builtin_amdgcn_readlane(b, 0)) + __builtin_bit_cast(float, __builtin_amdgcn_readlane(b, 16)) + __builtin_bit_cast(float, __builtin_amdgcn_readlane(b, 32)) + __builtin_bit_cast(float, __builtin_amdgcn_readlane(b, 48));
}
namespace gdn {
using bf16x8 = __attribute__((ext_vector_type(8))) short;
constexpr int TS = 272;
constexpr int OFF_Q = 0, OFF_K = 64 * TS, OFF_V = 2 * 64 * TS, OFF_KK = 3 * 64 * TS, OFF_QK = OFF_KK + 64 * 65 * 4, OFF_L = OFF_QK + 64 * 65 * 4, LSTR = 68,
              OFF_VEC = OFF_L + 2 * 64 * LSTR * 4,
              OFF_D = OFF_KK, DSTR = 20;
static_assert(8 * 16 * DSTR * 4 <= 64 * 65 * 4 && OFF_VEC + 6 * 64 * 4 <= 131072, "gdn lds");
__device__ __forceinline__ void seq_info(int s, int& rowbase, int& L) { if (s < 16) { rowbase = s * 256; L = 256; } else { rowbase = NPROMPT + (s - 16) * 1024; L = 1024; } }
__device__ __forceinline__ int chunk_id(int s, int h, int c) { return s < 16 ? ((s * 8 + h) * 4 + c) : 512 + (((s - 16) * 8 + h) * 16 + c); }

__device__ __forceinline__ void cl_load(Frame& F, int s, int h, int c, unsigned (&raw)[3][12], float (&abv)[2]) {
    const bf16* QKVB = (const bf16*)(F.ws + WS_QKVB); const float* AB = (const float*)(F.ws + WS_AB);
    int rowbase, L; seq_info(s, rowbase, L);
    int lane = F.lane; asm volatile("" : "+v"(lane)); const int wid = F.wave; const int tok0 = 8 * wid;
    const bf16* rp = QKVB + ((long)(rowbase + c * 64 + tok0) - 2) * 3072 + h * 128 + 2 * lane;
#pragma unroll
    for (int j = 0; j < 12; ++j) { const int t = c * 64 + tok0 - 2 + j; const bool ok = (t >= 0) && (t < L);
#pragma unroll
        for (int x = 0; x < 3; ++x) raw[x][j] = ok ? *(const unsigned*)(rp + x * 1024) : 0u;
        rp += 3072; asm volatile("" : "+v"(rp)); }
    abv[0] = 0.f; abv[1] = 0.f;
    if (wid < 2) { const size_t row = (size_t)rowbase + c * 64 + lane; abv[0] = AB[row * 32 + wid * 8 + h]; abv[1] = AB[row * 32 + 16 + wid * 8 + h]; }
}
__device__ __forceinline__ void chunk_local(Frame& F, int s, int h, int c, unsigned (&raw)[3][12], float (&abv)[2], bool has_next, int ns, int nh, int nc) {
    const bf16* QKVB = (const bf16*)(F.ws + WS_QKVB); const float* AB = (const float*)(F.ws + WS_AB);
    const float* conv_w = F.inp[11]; const float* a_log = F.inp[12]; const float* dt_bias = F.inp[13];
    bf16* QHAT = (bf16*)(F.ws + WS_QHAT); bf16* KHT = (bf16*)(F.ws + WS_KHT); bf16* NWg = (bf16*)(F.ws + WS_NW); bf16* Ug = (bf16*)(F.ws + WS_U); bf16* INTRA = (bf16*)(F.ws + WS_INTRA);
    float* EVEC = (float*)(F.ws + WS_EVEC);
    int rowbase, L; seq_info(s, rowbase, L); const int cid = chunk_id(s, h, c);
    int tid = F.tid, lane = F.lane; const int wid = F.wave; asm volatile("" : "+v"(tid), "+v"(lane));
    LAS unsigned char* lds = F.lds;
    LAS float* vec = (LAS float*)(lds + OFF_VEC);
    {
        const int tok0 = 8 * wid;
        float cw[3][5][2];
#pragma unroll
        for (int x = 0; x < 3; ++x)
#pragma unroll
            for (int j = 0; j < 5; ++j) { const float* p = conv_w + j * 3072 + x * 1024 + h * 128 + 2 * lane; cw[x][j][0] = p[0]; cw[x][j][1] = p[1]; }
        unsigned kt[2][4];
        float val[8][3][2]; float sv[16];
#pragma unroll
        for (int tt = 0; tt < 8; ++tt) {
#pragma unroll
            for (int x = 0; x < 3; ++x) { pg8::f32x2 a2 = {0.f, 0.f};
#pragma unroll
                for (int j = 0; j < 5; ++j) { const pg8::f32x2 w2_ = {cw[x][j][0], cw[x][j][1]}; const pg8::f32x2 r2_ = {bflo(raw[x][tt + j]), bfhi(raw[x][tt + j])}; a2 = __builtin_elementwise_fma(w2_, r2_, a2); }
                val[tt][x][0] = silu_f(a2.x); val[tt][x][1] = silu_f(a2.y); }
            sv[tt] = val[tt][0][0] * val[tt][0][0] + val[tt][0][1] * val[tt][0][1];
            sv[8 + tt] = val[tt][1][0] * val[tt][1][0] + val[tt][1][1] * val[tt][1][1];
        }
        float tot[16];
        {
            float w8[8], u4[4];
#pragma unroll
            for (int i = 0; i < 8; ++i) { const auto r = __builtin_amdgcn_permlane32_swap(__builtin_bit_cast(unsigned, sv[i]), __builtin_bit_cast(unsigned, sv[i + 8]), false, false);
                const unsigned r0 = r[0], r1 = r[1]; w8[i] = __builtin_bit_cast(float, r0) + __builtin_bit_cast(float, r1); }
#pragma unroll
            for (int i = 0; i < 4; ++i) { const auto r = __builtin_amdgcn_permlane16_swap(__builtin_bit_cast(unsigned, w8[i]), __builtin_bit_cast(unsigned, w8[i + 4]), false, false);
                const unsigned r0 = r[0], r1 = r[1]; float v = __builtin_bit_cast(float, r0) + __builtin_bit_cast(float, r1);
                v += dppf<0xB1>(v); v += dppf<0x4E>(v); v += dppf<0x141>(v); v += dppf<0x140>(v); u4[i] = v; }
#pragma unroll
            for (int r = 0; r < 4; ++r)
#pragma unroll
                for (int i = 0; i < 4; ++i) tot[i + 4 * (r & 1) + 8 * (r >> 1)] = __builtin_bit_cast(float, __builtin_amdgcn_readlane(__builtin_bit_cast(int, u4[i]), 16 * r));
        }
#pragma unroll
        for (int tt = 0; tt < 8; ++tt) {
            const float rq = rsqrtf(tot[tt] + EPS) * 0.08838834764831845f, rk = rsqrtf(tot[8 + tt] + EPS);
            const unsigned qw_ = cvtpk(val[tt][0][0] * rq, val[tt][0][1] * rq), kw_ = cvtpk(val[tt][1][0] * rk, val[tt][1][1] * rk), vw_ = cvtpk(val[tt][2][0], val[tt][2][1]);
            const int tok = tok0 + tt;
            *(LAS unsigned*)(lds + OFF_Q + tok * TS + 4 * lane) = qw_;
            *(LAS unsigned*)(lds + OFF_K + tok * TS + 4 * lane) = kw_;
            *(LAS unsigned*)(lds + OFF_V + tok * TS + 4 * lane) = vw_;
            *(unsigned*)(QHAT + ((size_t)cid * 64 + tok) * 128 + 2 * lane) = qw_;
            if (tt & 1) { kt[0][tt >> 1] |= (kw_ << 16); kt[1][tt >> 1] |= (kw_ & 0xffff0000u); } else { kt[0][tt >> 1] = kw_ & 0xffffu; kt[1][tt >> 1] = kw_ >> 16; }
        }
#pragma unroll
        for (int e = 0; e < 2; ++e) { v4u w; w.x = kt[e][0]; w.y = kt[e][1]; w.z = kt[e][2]; w.w = kt[e][3];
            *(GAS v4u*)(KHT + ((size_t)cid * 128 + 2 * lane + e) * 64 + tok0) = w; }
    }
    if (wid < 2) {
        const int dir = wid, tok = lane; const size_t row = (size_t)rowbase + c * 64 + tok;
        const float a = abv[0], b = abv[1];
        const float xs = a + dt_bias[dir * 8 + h];
        const float sp = xs > 20.f ? xs : log1pf(__expf(xs));
        const float g = -__expf(a_log[dir * 8 + h]) * sp;
        const float beta = 1.0f / (1.0f + __expf(-b));
        float G = g;
        if (dir == 0) {
#pragma unroll
            for (int o = 1; o < 64; o <<= 1) { const float t = __shfl_up(G, o); if (lane >= o) G += t; }
        } else {
#pragma unroll
            for (int o = 1; o < 64; o <<= 1) { const float t = __shfl_down(G, o); if (lane + o < 64) G += t; }
        }
        const float gl = __shfl(G, dir == 0 ? 63 : 0);
        const float eG = __expf(G);
        vec[dir * 64 + tok] = beta; vec[128 + dir * 64 + tok] = G; vec[256 + dir * 64 + tok] = beta * eG;
        float* ev = EVEC + ((size_t)cid * 2 + dir) * 192;
        ev[tok] = eG; ev[64 + tok] = __expf(gl - G); if (lane == 0) ev[128] = __expf(gl);
    }
    if (has_next) cl_load(F, ns, nh, nc, raw, abv);
    LBAR();
    {
        const int r32 = lane & 31, hi = lane >> 5; const int mat = wid >> 2, bi = (wid >> 1) & 1, bj = wid & 1;
        const LAS unsigned char* ap = lds + (mat ? OFF_Q : OFF_K) + (32 * bi + r32) * TS + 16 * hi;
        const LAS unsigned char* bp = lds + OFF_K + (32 * bj + r32) * TS + 16 * hi;
        f32x16 acc = {};
#pragma unroll
        for (int st = 0; st < 8; ++st) { const bf16x8 a = *(const LAS bf16x8*)(ap + 32 * st), b = *(const LAS bf16x8*)(bp + 32 * st); acc = __builtin_amdgcn_mfma_f32_32x32x16_bf16(a, b, acc, 0, 0, 0); }
        LAS float* dst = (LAS float*)(lds + (mat ? OFF_QK : OFF_KK));
#pragma unroll
        for (int r = 0; r < 16; ++r) dst[(32 * bi + crow(r, hi)) * 65 + 32 * bj + r32] = acc[r];
    }
    LBAR();
    {
        const int dir = tid >> 8, i = (tid >> 2) & 63, j0 = (tid & 3) * 16;
        const LAS float* KKm = (const LAS float*)(lds + OFF_KK); const LAS float* QKm = (const LAS float*)(lds + OFF_QK);
        LAS float* Lm = (LAS float*)(lds + OFF_L) + dir * 64 * LSTR;
        const float bi_ = vec[dir * 64 + i], Gi = vec[128 + dir * 64 + i];
        unsigned iw[8];
#pragma unroll
        for (int jj = 0; jj < 16; ++jj) { const int j = j0 + jj; const float Gj = vec[128 + dir * 64 + j];
            const bool strict = dir ? (j > i) : (j < i); const bool incl = strict || (j == i);
            const float dec = incl ? __expf(Gi - Gj) : 0.f;
            const float lv = strict ? bi_ * KKm[i * 65 + j] * dec : 0.f;
            const float iv = QKm[i * 65 + j] * dec;
            if (dir) Lm[(63 - i) * LSTR + (63 - j)] = lv; else Lm[i * LSTR + j] = lv;
            const unsigned short bv = (unsigned short)(cvtpk(iv, 0.f) & 0xffffu);
            if (jj & 1) iw[jj >> 1] |= ((unsigned)bv << 16); else iw[jj >> 1] = bv; }
        bf16* ip = INTRA + (((size_t)cid * 2 + dir) * 64 + i) * 64 + j0;
        v4u w0, w1; w0.x = iw[0]; w0.y = iw[1]; w0.z = iw[2]; w0.w = iw[3]; w1.x = iw[4]; w1.y = iw[5]; w1.z = iw[6]; w1.w = iw[7];
        *(GAS v4u*)ip = w0; *(GAS v4u*)(ip + 8) = w1;
    }
    LBAR();
    if (tid < 128) {
        const int dir = tid >> 6, b = (tid >> 4) & 3, cidx = tid & 15;
        const LAS float* Lb = (const LAS float*)(lds + OFF_L) + dir * 64 * LSTR + (16 * b) * LSTR + 16 * b;
        LAS float* Dm = (LAS float*)(lds + OFF_D) + (dir * 4 + b) * 16 * DSTR;
        float d[16];
#pragma unroll
        for (int i = 0; i < 16; ++i) { float a = (i == cidx) ? 1.f : 0.f;
#pragma unroll
            for (int j = 0; j < i; ++j) a -= Lb[i * LSTR + j] * d[j];
            d[i] = a; Dm[i * DSTR + cidx] = a; }
    }
    LBAR();
    {
        const int dir = wid >> 2, wq = wid & 3; const bool isK = wq >= 2; const int cb = (wq & 1) * 64;
        const int n = lane & 15, g = lane >> 4;
        const LAS float* Lm = (const LAS float*)(lds + OFF_L) + dir * 64 * LSTR;
        const LAS float* Dall = (const LAS float*)(lds + OFF_D) + dir * 4 * 16 * DSTR;
        const LAS unsigned char* tile = lds + (isK ? OFF_K : OFF_V);
        const LAS float* scl = vec + (isK ? 256 : 0) + dir * 64;
        bf16* og = (isK ? NWg : Ug) + ((size_t)cid * 2 + dir) * 64 * 128;
        const float sgn = isK ? -1.f : 1.f;
        LAS unsigned char* stg = lds + OFF_Q + wid * 2176;
        u32x2 Xf[3][4];
#pragma unroll
        for (int b = 0; b < 4; ++b) {
            f32x4 R[4];
#pragma unroll
            for (int r = 0; r < 4; ++r) { const int p = 16 * b + 4 * g + r; const int tok = dir ? 63 - p : p; const float sc_ = scl[tok];
#pragma unroll
                for (int nt = 0; nt < 4; ++nt) R[nt][r] = bf2f(*(const LAS unsigned short*)(tile + tok * TS + 2 * (cb + 16 * nt + n))) * sc_; }
#pragma unroll
            for (int pr = 0; pr < 2; ++pr) if (2 * pr < b) {
                const int a0 = 2 * pr, a1 = 2 * pr + 1; const bool two = a1 < b;
                const f32x4 l0 = *(const LAS f32x4*)(Lm + (16 * b + n) * LSTR + 16 * a0 + 4 * g);
                f32x4 l1 = {0.f, 0.f, 0.f, 0.f}; if (two) l1 = *(const LAS f32x4*)(Lm + (16 * b + n) * LSTR + 16 * a1 + 4 * g);
                v4u aw; aw.x = cvtpk(-l0[0], -l0[1]); aw.y = cvtpk(-l0[2], -l0[3]); aw.z = cvtpk(-l1[0], -l1[1]); aw.w = cvtpk(-l1[2], -l1[3]);
                const bf16x8 af = __builtin_bit_cast(bf16x8, aw);
#pragma unroll
                for (int nt = 0; nt < 4; ++nt) { v4u bw; bw.x = Xf[a0][nt].x; bw.y = Xf[a0][nt].y; bw.z = two ? Xf[a1 < 3 ? a1 : 2][nt].x : 0u; bw.w = two ? Xf[a1 < 3 ? a1 : 2][nt].y : 0u;
                    R[nt] = __builtin_amdgcn_mfma_f32_16x16x32_bf16(af, __builtin_bit_cast(bf16x8, bw), R[nt], 0, 0, 0); }
            }
            const f32x4 df = *(const LAS f32x4*)(Dall + b * 16 * DSTR + n * DSTR + 4 * g);
            v4u dw; dw.x = cvtpk(df[0], df[1]); dw.y = cvtpk(df[2], df[3]); dw.z = 0u; dw.w = 0u;
            const bf16x8 dfr = __builtin_bit_cast(bf16x8, dw);
#pragma unroll
            for (int nt = 0; nt < 4; ++nt) {
                v4u rw; rw.x = cvtpk(R[nt][0], R[nt][1]); rw.y = cvtpk(R[nt][2], R[nt][3]); rw.z = 0u; rw.w = 0u;
                const f32x4 xb = __builtin_amdgcn_mfma_f32_16x16x32_bf16(dfr, __builtin_bit_cast(bf16x8, rw), (f32x4){0.f, 0.f, 0.f, 0.f}, 0, 0, 0);
                if (b < 3) { Xf[b][nt].x = cvtpk(xb[0], xb[1]); Xf[b][nt].y = cvtpk(xb[2], xb[3]); }
#pragma unroll
                for (int r = 0; r < 4; ++r) *(LAS unsigned short*)(stg + (4 * g + r) * 136 + 2 * (16 * nt + n)) = (unsigned short)(cvtpk(xb[r] * sgn, 0.f) & 0xffffu);
            }
            asm volatile("s_waitcnt lgkmcnt(0)" ::: "memory");
#pragma unroll
            for (int q = 0; q < 2; ++q) { const int piece = lane + 64 * q, lr = piece >> 3, ch = piece & 7; const int p = 16 * b + lr; const int tok = dir ? 63 - p : p;
                const u32x2 lo_ = *(const LAS u32x2*)(stg + lr * 136 + 16 * ch), hi_ = *(const LAS u32x2*)(stg + lr * 136 + 16 * ch + 8);
                v4u w; w.x = lo_.x; w.y = lo_.y; w.z = hi_.x; w.w = hi_.y;
                *(GAS v4u*)(og + tok * 128 + cb + 8 * ch) = w; }
            asm volatile("s_waitcnt lgkmcnt(0)" ::: "memory");
        }
    }
    LBAR();
}
}

namespace gscan {
using bf16x8 = __attribute__((ext_vector_type(8))) short;
constexpr int S128 = 264, S64 = 136;
constexpr int O_NW = 0, O_QH = 64 * S128, O_KHT = 2 * 64 * S128, O_IN = O_KHT + 128 * S64, O_EV = O_IN + 64 * S64, BUF = O_EV + 192 * 4;
static_assert(2 * BUF <= 131072 && (BUF % 8) == 0, "scan lds");
__device__ __forceinline__ bf16x8 afrag(const LAS unsigned char* p) { const u32x2 a = *(const LAS u32x2*)p, b = *(const LAS u32x2*)(p + 16); v4u w; w.x = a.x; w.y = a.y; w.z = b.x; w.w = b.y; return __builtin_bit_cast(bf16x8, w); }
__device__ __forceinline__ bf16x8 pack8(const f32x16& v, int s) { v4u w; w.x = cvtpk(v[8 * s + 0], v[8 * s + 1]); w.y = cvtpk(v[8 * s + 2], v[8 * s + 3]); w.z = cvtpk(v[8 * s + 4], v[8 * s + 5]); w.w = cvtpk(v[8 * s + 6], v[8 * s + 7]); return __builtin_bit_cast(bf16x8, w); }

#define SC_LOAD(T0, T1, T2, T3, EV, cid_) do { const int cidl_ = (cid_); const size_t cid2l_ = (size_t)cidl_ * 2 + dir; \
    _Pragma("unroll") for (int i_ = 0; i_ < 4; ++i_) { const int q_ = lt + 256 * i_; T0[i_] = *(const GAS v4u*)(NWg + cid2l_ * 8192 + (size_t)q_ * 8); T1[i_] = *(const GAS v4u*)(QHAT + (size_t)cidl_ * 8192 + (size_t)q_ * 8); T2[i_] = *(const GAS v4u*)(KHT + (size_t)cidl_ * 8192 + (size_t)q_ * 8); } \
    _Pragma("unroll") for (int i_ = 0; i_ < 2; ++i_) { const int q_ = lt + 256 * i_; T3[i_] = *(const GAS v4u*)(INTRA + cid2l_ * 4096 + (size_t)q_ * 8); } \
    EV = 0.f; if (lt < 192) EV = EVEC[cid2l_ * 192 + lt]; } while (0)
#define SC_WRITE(T0, T1, T2, T3, EV, b_) do { LAS unsigned char* Bw_ = lds + (b_) * BUF; \
    _Pragma("unroll") for (int i_ = 0; i_ < 4; ++i_) { const int q_ = lt + 256 * i_; const int r128_ = q_ >> 4, c128_ = q_ & 15, r64_ = q_ >> 3, c64_ = q_ & 7; \
        LAS unsigned char* d0_ = Bw_ + O_NW + r128_ * S128 + c128_ * 16; *(LAS u32x2*)d0_ = (u32x2){T0[i_].x, T0[i_].y}; *(LAS u32x2*)(d0_ + 8) = (u32x2){T0[i_].z, T0[i_].w}; \
        LAS unsigned char* d1_ = Bw_ + O_QH + r128_ * S128 + c128_ * 16; *(LAS u32x2*)d1_ = (u32x2){T1[i_].x, T1[i_].y}; *(LAS u32x2*)(d1_ + 8) = (u32x2){T1[i_].z, T1[i_].w}; \
        LAS unsigned char* d2_ = Bw_ + O_KHT + r64_ * S64 + c64_ * 16;  *(LAS u32x2*)d2_ = (u32x2){T2[i_].x, T2[i_].y}; *(LAS u32x2*)(d2_ + 8) = (u32x2){T2[i_].z, T2[i_].w}; } \
    _Pragma("unroll") for (int i_ = 0; i_ < 2; ++i_) { const int q_ = lt + 256 * i_; const int r64_ = q_ >> 3, c64_ = q_ & 7; \
        LAS unsigned char* d3_ = Bw_ + O_IN + r64_ * S64 + c64_ * 16; *(LAS u32x2*)d3_ = (u32x2){T3[i_].x, T3[i_].y}; *(LAS u32x2*)(d3_ + 8) = (u32x2){T3[i_].z, T3[i_].w}; } \
    if (lt < 192) *(LAS float*)(Bw_ + O_EV + 4 * lt) = EV; } while (0)
#define SC_ULOAD(UR, cid_) do { const unsigned short* up_ = (const unsigned short*)Ug + ((size_t)(cid_) * 2 + dir) * 8192 + (size_t)(4 * hi * 128 + n0 + r32); \
    _Pragma("unroll") for (int ib_ = 0; ib_ < 2; ++ib_) _Pragma("unroll") for (int r_ = 0; r_ < 16; ++r_) UR[ib_][r_] = up_[(32 * ib_ + (r_ & 3) + 8 * (r_ >> 2)) * 128]; } while (0)
#define SC_STEP(UR, b_, c_) do { const LAS unsigned char* B = lds + (b_) * BUF; \
    const LAS float* ev = (const LAS float*)(B + O_EV); \
    f32x16 vn[2] = {f32x16{}, f32x16{}}, qs[2] = {f32x16{}, f32x16{}}; \
    bf16x8 fa[4], fb[4]; \
      \
    _Pragma("unroll") for (int ib = 0; ib < 2; ++ib) { fa[ib] = afrag(B + O_NW + (32 * ib + r32) * S128 + (4 * hi) * 2); fa[2 + ib] = afrag(B + O_QH + (32 * ib + r32) * S128 + (4 * hi) * 2); } \
    _Pragma("unroll") for (int it = 0; it < 8; ++it) { const int mb = it >> 1, st = it & 1; \
        if (it + 1 < 8) { const int koffn = (32 * ((it + 1) >> 1) + 16 * ((it + 1) & 1) + 4 * hi) * 2; \
            _Pragma("unroll") for (int ib = 0; ib < 2; ++ib) { fb[ib] = afrag(B + O_NW + (32 * ib + r32) * S128 + koffn); fb[2 + ib] = afrag(B + O_QH + (32 * ib + r32) * S128 + koffn); } } \
        const bf16x8 sb = pack8(S[mb], st); \
        __builtin_amdgcn_sched_barrier(0); \
        _Pragma("unroll") for (int ib = 0; ib < 2; ++ib) { vn[ib] = __builtin_amdgcn_mfma_f32_32x32x16_bf16(fa[ib], sb, vn[ib], 0, 0, 0); qs[ib] = __builtin_amdgcn_mfma_f32_32x32x16_bf16(fa[2 + ib], sb, qs[ib], 0, 0, 0); } \
        __builtin_amdgcn_sched_barrier(0); \
        _Pragma("unroll") for (int q_ = 0; q_ < 4; ++q_) fa[q_] = fb[q_]; } \
      \
    _Pragma("unroll") for (int ib = 0; ib < 2; ++ib) fa[ib] = afrag(B + O_IN + (32 * ib + r32) * S64 + (4 * hi) * 2); \
    _Pragma("unroll") for (int ib = 0; ib < 2; ++ib) _Pragma("unroll") for (int r = 0; r < 16; ++r) { vn[ib][r] += bf2f(UR[ib][r]); qs[ib][r] *= ev[32 * ib + crow(r, hi)]; } \
      \
    _Pragma("unroll") for (int it = 0; it < 4; ++it) { const int jb = it >> 1, st = it & 1; \
        if (it + 1 < 4) { const int koffn = (32 * ((it + 1) >> 1) + 16 * ((it + 1) & 1) + 4 * hi) * 2; \
            _Pragma("unroll") for (int ib = 0; ib < 2; ++ib) fb[ib] = afrag(B + O_IN + (32 * ib + r32) * S64 + koffn); } \
        else { _Pragma("unroll") for (int mb = 0; mb < 4; ++mb) fb[mb] = afrag(B + O_KHT + (32 * mb + r32) * S64 + (4 * hi) * 2); }     \
        const bf16x8 vb = pack8(vn[jb], st); \
        __builtin_amdgcn_sched_barrier(0); \
        _Pragma("unroll") for (int ib = 0; ib < 2; ++ib) qs[ib] = __builtin_amdgcn_mfma_f32_32x32x16_bf16(fa[ib], vb, qs[ib], 0, 0, 0); \
        __builtin_amdgcn_sched_barrier(0); \
        if (it + 1 < 4) { fa[0] = fb[0]; fa[1] = fb[1]; } else { _Pragma("unroll") for (int q_ = 0; q_ < 4; ++q_) fa[q_] = fb[q_]; } } \
      \
    const float egl = ev[128]; \
    _Pragma("unroll") for (int mb = 0; mb < 4; ++mb) S[mb] *= egl; \
    _Pragma("unroll") for (int jb = 0; jb < 2; ++jb) _Pragma("unroll") for (int r = 0; r < 16; ++r) vn[jb][r] *= ev[64 + 32 * jb + crow(r, hi)]; \
    _Pragma("unroll") for (int it = 0; it < 4; ++it) { const int jb = it >> 1, st = it & 1; \
        if (it + 1 < 4) { const int koffn = (32 * ((it + 1) >> 1) + 16 * ((it + 1) & 1) + 4 * hi) * 2; \
            _Pragma("unroll") for (int mb = 0; mb < 4; ++mb) fb[mb] = afrag(B + O_KHT + (32 * mb + r32) * S64 + koffn); } \
        const bf16x8 vb = pack8(vn[jb], st); \
        __builtin_amdgcn_sched_barrier(0); \
        _Pragma("unroll") for (int mb = 0; mb < 4; ++mb) S[mb] = __builtin_amdgcn_mfma_f32_32x32x16_bf16(fa[mb], vb, S[mb], 0, 0, 0); \
        __builtin_amdgcn_sched_barrier(0); \
        _Pragma("unroll") for (int q_ = 0; q_ < 4; ++q_) fa[q_] = fb[q_]; } \
    unsigned short* op = (unsigned short*)OS + (size_t)(rowbase + 64 * (c_)) * 1024 + (size_t)(4 * hi * 1024 + h * 128 + n0 + r32); \
    _Pragma("unroll") for (int ib = 0; ib < 2; ++ib) _Pragma("unroll") for (int r = 0; r < 16; ++r) op[(32 * ib + (r & 3) + 8 * (r >> 2)) * 1024] = (unsigned short)(cvtpk(qs[ib][r], 0.f) & 0xffffu); } while (0)

__device__ __forceinline__ void scan_item(Frame& F, int s, int h, int dir) {
    const bf16* QHAT = (const bf16*)(F.ws + WS_QHAT); const bf16* KHT = (const bf16*)(F.ws + WS_KHT); const bf16* NWg = (const bf16*)(F.ws + WS_NW); const bf16* Ug = (const bf16*)(F.ws + WS_U);
    const bf16* INTRA = (const bf16*)(F.ws + WS_INTRA); const float* EVEC = (const float*)(F.ws + WS_EVEC);
    bf16* OS = dir ? (bf16*)((unsigned char*)F.out + YO_OB) : (bf16*)(F.ws + WS_OF);
    int rowbase, L; gdn::seq_info(s, rowbase, L); const int n = L / 64;
    const int wid = F.wave; int tid = F.tid, lane = F.lane; asm volatile("" : "+v"(tid), "+v"(lane));
    const int r32 = lane & 31, hi = lane >> 5; const int lt = tid - 256;
    LAS unsigned char* lds = F.lds;
    const bool loader = wid >= 4;
    const int n0 = 32 * (wid & 3);
#define SC_CID(j_) gdn::chunk_id(s, h, dir ? n - 1 - (j_) : (j_))
    if (loader) {
        v4u a0[4], a1[4], a2[4], a3[2], b0[4], b1[4], b2[4], b3[2]; float aev, bev;
        SC_LOAD(a0, a1, a2, a3, aev, SC_CID(0)); SC_WRITE(a0, a1, a2, a3, aev, 0);
        SC_LOAD(a0, a1, a2, a3, aev, SC_CID(1)); SC_LOAD(b0, b1, b2, b3, bev, SC_CID(2));
        LBAR();
        for (int i = 0; i < n; i += 2) {
            SC_WRITE(a0, a1, a2, a3, aev, 1);
            SC_LOAD(a0, a1, a2, a3, aev, SC_CID(i + 3 < n ? i + 3 : n - 1));
            LBAR();
            SC_WRITE(b0, b1, b2, b3, bev, 0);
            SC_LOAD(b0, b1, b2, b3, bev, SC_CID(i + 4 < n ? i + 4 : n - 1));
            LBAR();
        }
    } else {
        f32x16 S[4];
        if (s >= 16) { const float* sd = F.inp[4] + (((size_t)(s - 16) * 2 + dir) * 8 + h) * 16384 + (size_t)(4 * hi * 128 + n0 + r32);
#pragma unroll
            for (int mb = 0; mb < 4; ++mb)
#pragma unroll
                for (int r = 0; r < 16; ++r) S[mb][r] = sd[(32 * mb + (r & 3) + 8 * (r >> 2)) * 128];
        } else {
#pragma unroll
            for (int mb = 0; mb < 4; ++mb) S[mb] = f32x16{};
        }
        unsigned short ua[2][16], ub[2][16];
        SC_ULOAD(ua, SC_CID(0)); SC_ULOAD(ub, SC_CID(1));
        LBAR();
        for (int i = 0; i < n; i += 2) {
            SC_STEP(ua, 0, dir ? n - 1 - i : i);
            SC_ULOAD(ua, SC_CID(i + 2 < n ? i + 2 : n - 1));
            LBAR();
            SC_STEP(ub, 1, dir ? n - 2 - i : i + 1);
            SC_ULOAD(ub, SC_CID(i + 3 < n ? i + 3 : n - 1));
            LBAR();
        }
        if (s < 16) { float* so = F.out + OUT_S + (((size_t)s * 2 + dir) * 8 + h) * 16384 + (size_t)(4 * hi * 128 + n0 + r32);
#pragma unroll
            for (int mb = 0; mb < 4; ++mb)
#pragma unroll
                for (int r = 0; r < 16; ++r) so[(32 * mb + (r & 3) + 8 * (r >> 2)) * 128] = S[mb][r]; }
    }
#undef SC_CID
}
}

__device__ __forceinline__ void gdn_finalize(Frame& F, int row0, int nrows, int h) {
    const bf16* OFw = (const bf16*)(F.ws + WS_OF); const bf16* OBw = (const bf16*)((unsigned char*)F.out + YO_OB); const bf16* GATE = (const bf16*)((unsigned char*)F.out + YO_GATE);
    bf16* MIX = (bf16*)(F.ws + WS_MIX); const float* dn = F.inp[14];
    int lane = F.lane; asm volatile("" : "+v"(lane));
    const int tg = lane >> 3, cs = lane & 7; const int c0 = h * 128 + 16 * cs;
    float nw[16];
#pragma unroll
    for (int e = 0; e < 16; ++e) nw[e] = dn[16 * cs + e];
    const int npass = nrows >> 6;
    int row = row0 + 8 * F.wave + tg;
    for (int it0 = 0; it0 < npass; it0 += 4, row += 256) {
        v4u va[4][2], vb[4][2], vg[4][2];
#pragma unroll
        for (int u = 0; u < 4; ++u)
#pragma unroll
            for (int q = 0; q < 2; ++q) { const size_t off = (size_t)(row + 64 * u) * 1024 + c0 + 8 * q; va[u][q] = *(const GAS v4u*)(OFw + off); vb[u][q] = *(const GAS v4u*)(OBw + off); vg[u][q] = *(const GAS v4u*)(GATE + off); }
#pragma unroll
        for (int u = 0; u < 4; ++u) {
            float o[16], g[16]; float ss = 0.f;
#pragma unroll
            for (int q = 0; q < 2; ++q) { const unsigned aw[4] = {va[u][q].x, va[u][q].y, va[u][q].z, va[u][q].w}, bw[4] = {vb[u][q].x, vb[u][q].y, vb[u][q].z, vb[u][q].w}, gw_[4] = {vg[u][q].x, vg[u][q].y, vg[u][q].z, vg[u][q].w};
#pragma unroll
                for (int e = 0; e < 4; ++e) { o[8 * q + 2 * e] = bflo(aw[e]) + bflo(bw[e]); o[8 * q + 2 * e + 1] = bfhi(aw[e]) + bfhi(bw[e]); g[8 * q + 2 * e] = bflo(gw_[e]); g[8 * q + 2 * e + 1] = bfhi(gw_[e]); } }
#pragma unroll
            for (int e = 0; e < 16; ++e) ss += o[e] * o[e];
            ss += __shfl_xor(ss, 1); ss += __shfl_xor(ss, 2); ss += __shfl_xor(ss, 4);
            const float rs = rsqrtf(ss * (1.0f / 128.0f) + EPS);
            v4u w0, w1; unsigned ww[8];
#pragma unroll
            for (int e = 0; e < 8; ++e) ww[e] = cvtpk(o[2 * e] * rs * nw[2 * e] * silu_f(g[2 * e]), o[2 * e + 1] * rs * nw[2 * e + 1] * silu_f(g[2 * e + 1]));
            w0.x = ww[0]; w0.y = ww[1]; w0.z = ww[2]; w0.w = ww[3]; w1.x = ww[4]; w1.y = ww[5]; w1.z = ww[6]; w1.w = ww[7];
            const int rg_ = row + 64 * u;
            bf16* mo = MIX + (size_t)((rg_ >> 8) * 32 + 16 + 2 * h + (cs >> 2)) * 16384 + ((rg_ >> 7) & 1) * 8192;
            *(GAS v4u*)(mo + (pg8::lds_byte(rg_ & 127, 16 * (cs & 3)) >> 1)) = w0; *(GAS v4u*)(mo + (pg8::lds_byte(rg_ & 127, 16 * (cs & 3) + 8) >> 1)) = w1;
        }
    }
}
__device__ __forceinline__ void pair_sync(unsigned* mine, unsigned* theirs) {
    asm volatile("s_waitcnt vmcnt(0)" ::: "memory");
    __syncthreads();
    if (threadIdx.x == 0) {
        const bool same_xcc = __hip_atomic_load(theirs + 1, __ATOMIC_RELAXED, __HIP_MEMORY_SCOPE_AGENT) == xb_xcc_id() + 1u;
        if (!same_xcc) { __builtin_amdgcn_fence(__ATOMIC_RELEASE, "agent"); asm volatile("s_waitcnt vmcnt(0)" ::: "memory"); }
        __hip_atomic_store(mine, 1u, __ATOMIC_RELAXED, __HIP_MEMORY_SCOPE_AGENT);
        unsigned sp = 0u;
        while (__hip_atomic_load(theirs, __ATOMIC_RELAXED, __HIP_MEMORY_SCOPE_AGENT) == 0u) { __builtin_amdgcn_s_sleep(1); if (++sp > (1u << 22)) break; }
        __builtin_amdgcn_fence(__ATOMIC_ACQUIRE, "agent"); asm volatile("s_waitcnt vmcnt(0)" ::: "memory");
    }
    __syncthreads();
}
constexpr int N_PHASES = 10;
#ifndef MK_N_LAUNCHES
#define MK_N_LAUNCHES 1
#endif
constexpr int N_LAUNCHES = MK_N_LAUNCHES;
struct Args { const float* in[22]; float* out; unsigned char* ws; int ph_lo, ph_hi, li, pad; };
__global__ void __launch_bounds__(NWAVES * 64, 2) mega_fwd(Args args) {
    extern __shared__ __attribute__((aligned(16))) unsigned char lds[];
    Frame F;
    F.lds = (LAS unsigned char*)lds; F.ldsg = lds;
    F.MISC = (volatile LAS unsigned*)(F.lds + MISC_OFF);
    F.tid = threadIdx.x; F.lane = F.tid & 63; F.wave = __builtin_amdgcn_readfirstlane(F.tid >> 6);
    F.G = gridDim.x; { const int bx = blockIdx.x; F.vcu = (F.G % 8 == 0) ? (bx % 8) * (F.G / 8) + bx / 8 : bx; }
    F.ws = args.ws; F.out = args.out; F.ctl = (gu32*)(args.ws + WS_CTL);
    F.inp = args.in;
    for (int u = F.tid; u < (LDS_BYTES - LDSCTL_OFF) / 4; u += NWAVES * 64) ((LAS unsigned*)(F.lds + LDSCTL_OFF))[u] = 0u;
    __syncthreads();
    const int lo = args.ph_lo, hi = args.ph_hi;
    const bool use_bar = (hi - lo) > 1;
    XcdBarrier bar; bar.bar = (unsigned*)(F.ctl + CW_BAR); bar.x = 0; bar.st = nullptr;
    if (use_bar) bar = xcd_barrier_post((unsigned*)(F.ctl + CW_BAR), F.MISC + 8);
#define IN(k) (lo <= (k) && (k) < hi)
#define SEAM(k) do { if (IN(k) && IN((k) + 1)) xcd_barrier(bar); } while (0)
    if (IN(0)) { p0_phase(F); SEAM(0); }
    if (IN(1)) { p1_phase(F); SEAM(1); }
    if (IN(2)) {
        p2_ab(F);
        pg8::Gemm g{(const pg8::bf16_t*)(F.ws + WS_XN), (const pg8::bf16_t*)(F.ws + WS_WIN), MROWS, 7168, DM, 1}; pg8::QuadOrder S; S.init(MROWS, 7168, DM, F.G, (int)blockIdx.x);
        unsigned char* yb = (unsigned char*)F.out;
        pg8::EpiInProj E{(pg8::bf16_t*)(yb + YO_QA), (pg8::bf16_t*)(yb + YO_KP), (pg8::bf16_t*)(yb + YO_VP), (pg8::bf16_t*)(F.ws + WS_KS), (pg8::bf16_t*)(F.ws + WS_VS),
                         (pg8::bf16_t*)(F.ws + WS_QKVB), (pg8::bf16_t*)(yb + YO_GATE), F.out + OUT_K, F.out + OUT_V, (const float*)(F.ws + WS_ROPE)};
        pg8::gemm_phase<pg8::EpiInProj, pg8::QuadOrder, true, true, 3, 192>(F.lds + RING_OFF, g, S, E, (float*)(F.ws + WS_MIX), (unsigned*)(F.ctl + CW_FLAG + 2048));
        SEAM(2);
    }
    if (IN(3)) {
        const float* lp = F.inp[15];
        const float lam = __expf(wave_sum(lp[F.lane] * lp[64 + F.lane])) - __expf(wave_sum(lp[128 + F.lane] * lp[192 + F.lane])) + 0.2f;
        const bf16* QA = (const bf16*)((unsigned char*)F.out + YO_QA); bf16* MIX = (bf16*)(F.ws + WS_MIX);
        for (int u = 256 + F.vcu; u < 768; u += F.G) {
            const bf16 *Qp, *Kp, *Vp; bf16* Op; int nk;
            if (u < 256) { const int qb = u & 1, bh = u >> 1, b = bh >> 3, h = bh & 7; const size_t r0 = (size_t)(b * 256 + qb * 128);
                Qp = QA + r0 * 1024 + h * 128; Kp = (const bf16*)((unsigned char*)F.out + YO_KP) + (size_t)bh * 256 * 128; Vp = (const bf16*)((unsigned char*)F.out + YO_VP) + (size_t)bh * 256 * 128; Op = MIX + (size_t)((r0 >> 8) * 32 + 2 * h) * 16384 + ((r0 >> 7) & 1) * 8192; nk = 256;
            } else { const int su = (u < 512) ? 2 * (u - 256) : 2 * (u - 512) + 1; const int qb = su & 7, bh = su >> 3, b = bh >> 3, h = bh & 7; const size_t r0 = (size_t)(NPROMPT + b * 1024 + qb * 128);
                Qp = QA + r0 * 1024 + h * 128; Kp = (const bf16*)(F.ws + WS_KS) + (size_t)bh * 1536 * 128; Vp = (const bf16*)(F.ws + WS_VS) + (size_t)bh * 1536 * 128; Op = MIX + (size_t)((r0 >> 8) * 32 + 2 * h) * 16384 + ((r0 >> 7) & 1) * 8192; nk = 1536; }
            dattn::attn_unit(Qp, Kp, Vp, Op, nk, lam, F.inp[16], (char*)lds);
        }
        {
#define CL_DEC(it_, s_, h_, c_) do { if ((it_) < 512) { s_ = (it_) >> 5; h_ = ((it_) >> 2) & 7; c_ = (it_) & 3; } else { const int j_ = (it_) - 512; s_ = 16 + (j_ >> 7); h_ = (j_ >> 4) & 7; c_ = j_ & 15; } } while (0)
            unsigned raw[3][12]; float abv[2];
            int it = F.vcu; int s = 0, h = 0, c = 0;
            if (it < 1536) { CL_DEC(it, s, h, c); gdn::cl_load(F, s, h, c, raw, abv); }
            for (; it < 1536; it += F.G) {
                const int nit = it + F.G; int ns = 0, nh = 0, nc = 0; const bool hn = nit < 1536; if (hn) CL_DEC(nit, ns, nh, nc);
                gdn::chunk_local(F, s, h, c, raw, abv, hn, ns, nh, nc);
                s = ns; h = nh; c = nc;
            }
#undef CL_DEC
        }
        SEAM(3);
    }
    if (IN(4)) {
        if (F.vcu < 128 && F.tid == 0) __hip_atomic_store((unsigned*)(F.ctl + CW_PAIR + 64 * F.vcu) + 1, xb_xcc_id() + 1u, __ATOMIC_RELAXED, __HIP_MEMORY_SCOPE_AGENT);
        for (int k = 0; k < 2; ++k) {
            int s_, h_, d_;
            if (F.vcu < 128) { if (k) break; s_ = 16 + (F.vcu >> 4); h_ = (F.vcu >> 1) & 7; d_ = F.vcu & 1; }
            else { const int p = 2 * (F.vcu - 128) + k; if (p >= 256) break; s_ = p >> 4; h_ = (p >> 1) & 7; d_ = p & 1; }
            gscan::scan_item(F, s_, h_, d_);
        }
        { int fr0, fn, fh;
          if (F.vcu < 128) { pair_sync((unsigned*)(F.ctl + CW_PAIR + 64 * F.vcu), (unsigned*)(F.ctl + CW_PAIR + 64 * (F.vcu ^ 1))); fr0 = NPROMPT + (F.vcu >> 4) * 1024 + (F.vcu & 1) * 512; fn = 512; fh = (F.vcu >> 1) & 7; }
          else { asm volatile("s_waitcnt vmcnt(0)" ::: "memory"); __syncthreads(); const int p = 2 * (F.vcu - 128); fr0 = (p >> 4) * 256; fn = 256; fh = (p >> 1) & 7; }
          gdn_finalize(F, fr0, fn, fh); __syncthreads(); }
        if (F.vcu >= 128) {
            const float* lp = F.inp[15];
            const float lam = __expf(wave_sum(lp[F.lane] * lp[64 + F.lane])) - __expf(wave_sum(lp[128 + F.lane] * lp[192 + F.lane])) + 0.2f;
            const bf16* QA = (const bf16*)((unsigned char*)F.out + YO_QA); bf16* MIX = (bf16*)(F.ws + WS_MIX);
            for (int k = 0; k < 2; ++k) { const int u = 2 * (F.vcu - 128) + k; const int qb = u & 1, bh = u >> 1, b = bh >> 3, h = bh & 7; const size_t r0 = (size_t)(b * 256 + qb * 128);
                dattn::attn_unit(QA + r0 * 1024 + h * 128, (const bf16*)((unsigned char*)F.out + YO_KP) + (size_t)bh * 256 * 128, (const bf16*)((unsigned char*)F.out + YO_VP) + (size_t)bh * 256 * 128,
                                 MIX + (size_t)((r0 >> 8) * 32 + 2 * h) * 16384 + ((r0 >> 7) & 1) * 8192, 256, lam, F.inp[16], (char*)lds); }
        }
        SEAM(4);
    }
    if (IN(6)) {
        pg8::Gemm g{(const pg8::bf16_t*)(F.ws + WS_MIX), (const pg8::bf16_t*)(F.ws + WS_WOUT), MROWS, DM, DM, 1}; pg8::PairOrder S; S.init(MROWS, DM, DM, F.G, (int)blockIdx.x, 24);
        pg8::EpiOutProj E{F.inp[0], F.inp[1], (const float*)(F.ws + WS_MOD), F.inp[18], (pg8::bf16_t*)(F.ws + WS_HB), (pg8::bf16_t*)(F.ws + WS_HW), (float*)(F.ws + WS_PART)};
        pg8::gemm_phase<pg8::EpiOutProj, pg8::PairOrder, true, true>(F.lds + RING_OFF, g, S, E, (float*)(F.ws + WS_WIN), (unsigned*)(F.ctl + CW_FLAG), 116, (unsigned)((WS_INTRA - WS_WIN) - 116 * 262144));
        SEAM(6);
    }
    if (IN(7)) {
        pg8::Gemm g{(const pg8::bf16_t*)(F.ws + WS_HW), (const pg8::bf16_t*)(F.ws + WS_WFF1), MROWS, DFF, DM, 1}; pg8::StaticOrder S; S.init(MROWS, DFF, DM, F.G, (int)blockIdx.x);
        LAS float* rt = (LAS float*)(F.lds + RSTD_OFF); const float* PART = (const float*)(F.ws + WS_PART);
        { const int half = F.tid >> 8, rr = F.tid & 255;
            f32x4 pv[3][8]; bool ok[3];
#pragma unroll
            for (int j = 0; j < 3; ++j) { pg8::Unit u; ok[j] = S.next(2 * j + half, u); const float* p = PART + ((size_t)(ok[j] ? u.pm : 0) * 256 + rr) * 32;
#pragma unroll
                for (int q = 0; q < 8; ++q) pv[j][q] = *(const f32x4*)(p + 4 * q); }
#pragma unroll
            for (int j = 0; j < 3; ++j) { float s = 0.f;
#pragma unroll
                for (int q = 0; q < 8; ++q) s += (pv[j][q][0] + pv[j][q][1]) + (pv[j][q][2] + pv[j][q][3]);
                if (ok[j]) rt[(2 * j + half) * 256 + rr] = rsqrtf(s * (1.0f / DM) + EPS); } }
        __syncthreads();
        pg8::EpiFF1 E{(const float*)(F.ws + WS_C2), (pg8::bf16_t*)(F.ws + WS_FF), (const LAS float*)rt};
        pg8::gemm_phase<pg8::EpiFF1, pg8::StaticOrder, true, true>(F.lds + RING_OFF, g, S, E);
        SEAM(7);
    }
    if (IN(8)) {
        pg8::Gemm g{(const pg8::bf16_t*)(F.ws + WS_FF), (const pg8::bf16_t*)(F.ws + WS_WFF2), MROWS, DM, DFF, 1}; pg8::PairOrder S; S.init(MROWS, DM, DFF, F.G, (int)blockIdx.x, 76);
        pg8::EpiFF2 E{(const float*)(F.ws + WS_MOD), (const pg8::bf16_t*)(F.ws + WS_HB), F.out, (float*)(F.ws + WS_PART2), F.inp[21], (unsigned*)(F.ctl + CW_PANEL)};
        pg8::gemm_phase<pg8::EpiFF2, pg8::PairOrder, true, true>(F.lds + RING_OFF, g, S, E, (float*)(F.ws + WS_WIN), (unsigned*)(F.ctl + CW_FLAG + 1024), 116, (unsigned)((WS_INTRA - WS_WIN) - 116 * 262144));
    }
#undef IN
#undef SEAM
}

extern "C" void kernel_launch(void* const* d_in, const int* in_sizes, int n_in, void* d_out, int out_size, void* d_ws, size_t ws_size, hipStream_t stream) {
    static int grid = 0;
    if (grid == 0) {
        if (n_in != 22 || out_size != 37748736 || ws_size < WS_END) { fprintf(stderr, "kernel_launch: unexpected shapes: n_in %d out %d ws %zu (need %zu)\n", n_in, out_size, ws_size, (size_t)WS_END); grid = -1; return; }
        if (hipFuncSetAttribute((const void*)mega_fwd, hipFuncAttributeMaxDynamicSharedMemorySize, LDS_BYTES) != hipSuccess) { fprintf(stderr, "kernel_launch: hipFuncSetAttribute failed\n"); grid = -1; return; }
        int per_cu = 0; (void)hipOccupancyMaxActiveBlocksPerMultiprocessor(&per_cu, (const void*)mega_fwd, NWAVES * 64, LDS_BYTES); (void)hipGetLastError();
        if (per_cu < 1) fprintf(stderr, "kernel_launch: occupancy query reports %d blocks per CU\n", per_cu);
        grid = 256;
    }
    if (grid < 0) return;
    if (hipMemsetAsync((char*)d_ws + WS_CTL, 0, CTL_ZERO_BYTES, stream) != hipSuccess) { fprintf(stderr, "kernel_launch: memset failed\n"); return; }
    Args a{};
    for (int i = 0; i < 22; ++i) a.in[i] = (const float*)d_in[i];
    a.out = (float*)d_out; a.ws = (unsigned char*)d_ws;
    if (N_LAUNCHES == 1) { a.ph_lo = 0; a.ph_hi = N_PHASES; a.li = 0; hipLaunchKernelGGL(mega_fwd, dim3(grid), dim3(NWAVES * 64), LDS_BYTES, stream, a); }
    else { for (int li = 0; li < N_PHASES; ++li) { a.ph_lo = li; a.ph_hi = li + 1; a.li = li; hipLaunchKernelGGL(mega_fwd, dim3(grid), dim3(NWAVES * 64), LDS_BYTES, stream, a); } }
    const hipError_t le = hipPeekAtLastError();
    if (le != hipSuccess) fprintf(stderr, "kernel_launch: launch failed: %s\n", hipGetErrorName(le));
}
```

```cpp
#include <hip/hip_runtime.h>
#include <hip/hip_bf16.h>
#include <cstdio>
#include <cstdint>
#include <cmath>

namespace pg8 {
#define PG8_LAS __attribute__((address_space(3)))
typedef unsigned short bf16_t;
typedef short bf16x8 __attribute__((ext_vector_type(8)));
typedef float f32x4 __attribute__((ext_vector_type(4)));
typedef unsigned u32x4 __attribute__((ext_vector_type(4)));
constexpr int BM = 256, BK = 64, HALF = 128, HTB = HALF * BK * 2  , STAGE_BYTES = 8 * HTB, NXCD = 8, WGM = 4;

__host__ __device__ __forceinline__ int lds_byte(int r, int c) { const int st = (r >> 4) * 2 + (c >> 5), rr = r & 15, cc = c & 31, ob = rr * 64 + cc * 2; return st * 1024 + (ob ^ (((ob >> 9) & 1) << 5)); }
__host__ __device__ __forceinline__ void stage_rc(int b, int& R, int& C) { const int st = b / 1024, sb = b % 1024, swz = sb ^ (((sb >> 9) & 1) << 5); R = (st >> 1) * 16 + swz / 64; C = (st & 1) * 32 + (swz % 64) / 2; }
__host__ __device__ __forceinline__ int perm32inv(int v) { return 16 * ((v >> 2) & 1) + 4 * (v >> 3) + (v & 3); }
__host__ __device__ __forceinline__ int perm32(int rho) { const int n = rho >> 4, i = rho & 15; return 8 * (i >> 2) + 4 * n + (i & 3); }

struct Unit { int pm, pn, k0, nt, mode, slot, npart; };
struct Gemm { const bf16_t* A; const bf16_t* Bt; int M, N, K; int atiled; };

struct StaticOrder {
    int nM, nN, nwg, G, c, ntk;
    __host__ __device__ __forceinline__ void init(int M, int N, int K, int G_, int c_) { nM = M / BM; nN = N / BM; nwg = nM * nN; G = G_; c = c_; ntk = K / BK; }
    __host__ __device__ __forceinline__ bool next(int i, Unit& u) const {
        const long L = (long)i * G + c; if (L >= nwg) return false;
        int wgid = (int)L; { const int q = nwg / NXCD, r = nwg % NXCD, xcd = wgid % NXCD, off = wgid / NXCD; wgid = (xcd < r ? xcd * (q + 1) : r * (q + 1) + (xcd - r) * q) + off; }
        const int nig = WGM * nN, gid = wgid / nig, fm = gid * WGM, gsz = (nM - fm) < WGM ? (nM - fm) : WGM;
        u.pm = fm + ((wgid % nig) % gsz); u.pn = (wgid % nig) / gsz; u.k0 = 0; u.nt = ntk; u.mode = 0; u.slot = 0; u.npart = 0; return true;
    }
    __device__ __forceinline__ void a_ready(const Unit&) const {}
    __device__ __forceinline__ void done(const Unit&) const {}
};


typedef float cvt_f32x2 __attribute__((ext_vector_type(2))); typedef __bf16 cvt_bf16x2 __attribute__((ext_vector_type(2)));
__device__ __forceinline__ unsigned cvt_pk_bf16(float lo, float hi) { cvt_f32x2 v = {lo, hi}; cvt_bf16x2 b = __builtin_convertvector(v, cvt_bf16x2); return __builtin_bit_cast(unsigned, b); }

struct PairOrder {
    int c, ntk, G, ntp;
    __host__ __device__ __forceinline__ void init(int M, int N, int K, int G_, int c_, int ntp_) { c = c_; ntk = K / BK; G = G_; ntp = ntp_; }
    __host__ __device__ __forceinline__ bool next(int i, Unit& u) const {
        if (i >= 2 || G != 256) return false;
        const int x = c & 7, lc = c >> 3, jp = lc >> 1, j = x * 16 + jp, role = lc & 1;
        int T, k0 = 0, nt = ntk, mode = 0;
        if (role == 0) { if (i == 0) { T = 48 * x + 32 + jp; nt = ntp; mode = 1; } else T = 48 * x + 16 + jp; }
        else           { if (i == 0) T = 48 * x + jp; else { T = 48 * x + 32 + jp; k0 = ntp; nt = ntk - ntp; mode = 2; } }
        u.pm = T >> 3; u.pn = T & 7; u.k0 = k0; u.nt = nt; u.mode = mode; u.slot = j; u.npart = 1; return true;
    }
    __device__ __forceinline__ void a_ready(const Unit&) const {}
    __device__ __forceinline__ void done(const Unit&) const {}
};

struct QuadOrder {
    StaticOrder base; int c, ntk;
    __host__ __device__ __forceinline__ void init(int M, int N, int K, int G_, int c_) { base.init(M, N, K, G_, c_); c = c_; ntk = K / BK; }
    __host__ __device__ __forceinline__ bool next(int i, Unit& u) const {
        if (base.G != 256 || base.nwg != 1344) return base.next(i, u);
        const int role = c >> 6, t = c & 63, q = (ntk == 32) ? 10 : ntk / 4;
        if (i > 5) return false;
        const bool split = (role < 3) ? (i == 0) : (i == 5);
        if (!split) return base.next(role < 3 ? i - 1 : i, u);
        StaticOrder b2 = base; b2.c = t; b2.next(5, u);
        u.k0 = role * q; u.nt = (role < 3) ? q : ntk - 3 * q; u.mode = (role < 3) ? 1 : 2; u.slot = (role < 3) ? t * 3 + role : t * 3; u.npart = 3; return true;
    }
    __device__ __forceinline__ void a_ready(const Unit&) const {}
    __device__ __forceinline__ void done(const Unit&) const {}
};

typedef float f32x2 __attribute__((ext_vector_type(2)));
typedef unsigned u32x2 __attribute__((ext_vector_type(2)));
__device__ __forceinline__ u32x2 pack4(const f32x4 v) { u32x2 w; w.x = cvt_pk_bf16(v[0], v[1]); w.y = cvt_pk_bf16(v[2], v[3]); return w; }
struct EpiInProj {
    static constexpr bool PERM = true, AFTER_DRAIN = false;
    bf16_t *QA, *KP, *VP, *KS, *VS, *QKVB, *GATE; float *outK, *outV; const float* rope;
    __device__ __forceinline__ void operator()(const f32x4 (&acc)[2][2][4][2], const Unit& u, int ui, int wr, int wc, int fr_, int fq_) const {
        int fr = fr_, fq = fq_; asm volatile("" : "+v"(fr), "+v"(fq));
        const int pm = u.pm, pn = u.pn; const bool sample = pm >= 16;
        const int tq = (pm - 16) & 3, bs = (pm - 16) >> 2;
        if (pn >= 12) {
            bf16_t* base; int ld, c0;
            if (pn < 24) { base = QKVB; ld = 3072; c0 = (pn - 12) * 256; } else { base = GATE; ld = 1024; c0 = (pn - 24) * 256; }
#pragma unroll
            for (int ai = 0; ai < 2; ++ai)
#pragma unroll
                for (int m = 0; m < 4; ++m) { const size_t row = (size_t)pm * 256 + ai * 128 + wr * 64 + m * 16 + fr;
#pragma unroll
                    for (int bj = 0; bj < 2; ++bj) { const u32x2 lo = pack4(acc[ai][bj][m][0]), hi = pack4(acc[ai][bj][m][1]); u32x4 w; w.x = lo.x; w.y = lo.y; w.z = hi.x; w.w = hi.y;
                        *(u32x4*)(base + row * ld + c0 + bj * 128 + wc * 32 + 8 * fq) = w; } }
        } else if (pn >= 8) {
#pragma unroll
            for (int bj = 0; bj < 2; ++bj) { const int h = 2 * (pn - 8) + bj;
#pragma unroll
                for (int ai = 0; ai < 2; ++ai)
#pragma unroll
                    for (int m = 0; m < 4; ++m) { const int tl = ai * 128 + wr * 64 + m * 16 + fr; const int d = wc * 32 + 8 * fq;
                        const f32x4 v0 = acc[ai][bj][m][0], v1 = acc[ai][bj][m][1];
                        const u32x2 lo = pack4(v0), hi = pack4(v1); u32x4 w; w.x = lo.x; w.y = lo.y; w.z = hi.x; w.w = hi.y;
                        if (!sample) { const size_t idx = ((size_t)(pm * 8 + h) * 256 + tl) * 128 + d; *(f32x4*)(outV + idx) = v0; *(f32x4*)(outV + idx + 4) = v1; *(u32x4*)(VP + idx) = w; }
                        else { const size_t idx = ((size_t)(bs * 8 + h) * 1536 + 512 + tq * 256 + tl) * 128 + d; *(u32x4*)(VS + idx) = w; } } }
        } else {
            const bool isK = pn >= 4; const bool colrot = (wc & 1) != 0; const bool upper = fq >= 2;
            const int i0 = 8 * (fq & 1);
            const float sgn = upper ? 1.f : -1.f;
#pragma unroll
            for (int ai = 0; ai < 2; ++ai) {
                f32x4 cr0 = {1.f, 1.f, 1.f, 1.f}, cr1 = cr0, sr0 = {0.f, 0.f, 0.f, 0.f}, sr1 = sr0;
                if (sample && !colrot) { const int pos = tq * 4 + ai * 2 + wr; cr0 = *(const f32x4*)(rope + pos * 16 + i0); cr1 = *(const f32x4*)(rope + pos * 16 + i0 + 4); sr0 = *(const f32x4*)(rope + 1024 + pos * 16 + i0); sr1 = *(const f32x4*)(rope + 1024 + pos * 16 + i0 + 4); }
#pragma unroll
                for (int m = 0; m < 4; ++m) { const int tl = ai * 128 + wr * 64 + m * 16 + fr;
                    f32x4 c0v = cr0, c1v = cr1, s0v = sr0, s1v = sr1;
                    if (sample && colrot) { const int pos = m * 16 + fr; c0v = *(const f32x4*)(rope + pos * 16 + i0); c1v = *(const f32x4*)(rope + pos * 16 + i0 + 4); s0v = *(const f32x4*)(rope + 1024 + pos * 16 + i0); s1v = *(const f32x4*)(rope + 1024 + pos * 16 + i0 + 4); }
#pragma unroll
                    for (int bj = 0; bj < 2; ++bj) { f32x4 o0 = acc[ai][bj][m][0], o1 = acc[ai][bj][m][1];
                        if (sample) {
                            f32x4 p0, p1;
#pragma unroll
                            for (int e = 0; e < 4; ++e) { p0[e] = __shfl_xor(o0[e], 32); p1[e] = __shfl_xor(o1[e], 32); }
                            o0 = o0 * c0v + p0 * s0v * sgn; o1 = o1 * c1v + p1 * s1v * sgn; }
                        const int d = wc * 32 + 8 * fq;
                        const u32x2 lo = pack4(o0), hi = pack4(o1); u32x4 w; w.x = lo.x; w.y = lo.y; w.z = hi.x; w.w = hi.y;
                        if (!isK) { *(u32x4*)(QA + ((size_t)pm * 256 + tl) * 1024 + pn * 256 + bj * 128 + d) = w; }
                        else { const int h = 2 * (pn - 4) + bj;
                            if (!sample) { const size_t idx = ((size_t)(pm * 8 + h) * 256 + tl) * 128 + d; *(f32x4*)(outK + idx) = o0; *(f32x4*)(outK + idx + 4) = o1; *(u32x4*)(KP + idx) = w; }
                            else { const size_t idx = ((size_t)(bs * 8 + h) * 1536 + 512 + tq * 256 + tl) * 128 + d; *(u32x4*)(KS + idx) = w; } } } } }
        }
    }
};
struct EpiOutProj {
    static constexpr bool PERM = true, AFTER_DRAIN = false;
    const float *xp, *xs, *mod, *norm2; bf16_t* HB; bf16_t* HW; float* PART;
    __device__ __forceinline__ void operator()(const f32x4 (&acc)[2][2][4][2], const Unit& u, int ui, int wr, int wc, int fr_, int fq_) const {
        int fr = fr_, fq = fq_; asm volatile("" : "+v"(fr), "+v"(fq));
        const int pm = u.pm, pn = u.pn; const int mb = pm < 16 ? 0 : 1 + ((pm - 16) >> 2);
        const float* xb = pm < 16 ? xp + (size_t)pm * 256 * 2048 : xs + (size_t)(pm - 16) * 256 * 2048;
        const float* g1 = mod + mb * 12288 + 2 * 2048; const float* sc2 = mod + mb * 12288 + 4 * 2048;
        bf16_t* hbt = HB + (size_t)(pm * 8 + pn) * 65536 + (((wr * 4 + wc) * 4 + fq) * 16 + fr) * 8;
        f32x4 g1v[2][2], w2v[2][2];
#pragma unroll
        for (int bj = 0; bj < 2; ++bj)
#pragma unroll
            for (int n = 0; n < 2; ++n) { const int col = pn * 256 + bj * 128 + wc * 32 + 8 * fq + 4 * n; g1v[bj][n] = *(const f32x4*)(g1 + col);
                const f32x4 a = *(const f32x4*)(norm2 + col), b = *(const f32x4*)(sc2 + col); w2v[bj][n] = a * (b + 1.0f); }
#pragma unroll
        for (int am = 0; am < 4; ++am) { const int ai = am >> 1, m0 = (am & 1) * 2;
            f32x4 xin[2][2][2];
#pragma unroll
            for (int mm = 0; mm < 2; ++mm)
#pragma unroll
                for (int bj = 0; bj < 2; ++bj)
#pragma unroll
                    for (int n = 0; n < 2; ++n) xin[mm][bj][n] = __builtin_nontemporal_load((const f32x4*)(xb + (size_t)(ai * 128 + wr * 64 + (m0 + mm) * 16 + fr) * 2048 + pn * 256 + bj * 128 + wc * 32 + 8 * fq + 4 * n));
#pragma unroll
            for (int mm = 0; mm < 2; ++mm) { const int m = m0 + mm; const int rl = ai * 128 + wr * 64 + m * 16 + fr; const size_t row = (size_t)pm * 256 + rl; float s = 0.f;
#pragma unroll
                for (int bj = 0; bj < 2; ++bj) { const int col = pn * 256 + bj * 128 + wc * 32 + 8 * fq;
                    const f32x4 h0 = xin[mm][bj][0] + g1v[bj][0] * acc[ai][bj][m][0], h1 = xin[mm][bj][1] + g1v[bj][1] * acc[ai][bj][m][1];
                    s += (h0[0] * h0[0] + h0[1] * h0[1]) + (h0[2] * h0[2] + h0[3] * h0[3]) + (h1[0] * h1[0] + h1[1] * h1[1]) + (h1[2] * h1[2] + h1[3] * h1[3]);
                    { const u32x2 lo = pack4(h0), hi = pack4(h1); u32x4 w; w.x = lo.x; w.y = lo.y; w.z = hi.x; w.w = hi.y; *(u32x4*)(hbt + ((ai * 2 + bj) * 4 + m) * 4096) = w; }
                    { const u32x2 lo = pack4(h0 * w2v[bj][0]), hi = pack4(h1 * w2v[bj][1]); u32x4 w; w.x = lo.x; w.y = lo.y; w.z = hi.x; w.w = hi.y; *(u32x4*)(HW + (size_t)(pm * 32 + pn * 4 + bj * 2 + (wc >> 1)) * 16384 + ai * 8192 + (lds_byte(wr * 64 + m * 16 + fr, (wc & 1) * 32 + 8 * fq) >> 1)) = w; } }
                s += __shfl_xor(s, 16); s += __shfl_xor(s, 32);
                if (fq == 0) PART[row * 32 + pn * 4 + wc] = s; }
            asm volatile("" ::: "memory"); }
    }
};
struct EpiFF1 {
    static constexpr bool PERM = true, AFTER_DRAIN = false;
    const float* c2; bf16_t* FF; const PG8_LAS float* rstd;
    __device__ __forceinline__ void operator()(const f32x4 (&acc)[2][2][4][2], const Unit& u, int ui, int wr, int wc, int fr_, int fq_) const {
        int fr = fr_, fq = fq_; asm volatile("" : "+v"(fr), "+v"(fq));
        const int pm = u.pm, pn = u.pn; const int mb = pm < 16 ? 0 : 1 + ((pm - 16) >> 2);
        f32x4 cv[2][2];
#pragma unroll
        for (int bj = 0; bj < 2; ++bj)
#pragma unroll
            for (int n = 0; n < 2; ++n) cv[bj][n] = *(const f32x4*)(c2 + mb * 8192 + pn * 256 + bj * 128 + wc * 32 + 8 * fq + 4 * n);
#pragma unroll
        for (int ai = 0; ai < 2; ++ai)
#pragma unroll
            for (int m = 0; m < 4; ++m) { const int rl = ai * 128 + wr * 64 + m * 16 + fr; const float r = rstd[ui * 256 + rl];
                bf16_t* rowp = FF + (size_t)(pm * 128 + pn * 4 + (wc >> 1)) * 16384 + ai * 8192 + (lds_byte(wr * 64 + m * 16 + fr, (wc & 1) * 32 + 8 * fq) >> 1);
#pragma unroll
                for (int bj = 0; bj < 2; ++bj) { f32x4 v0 = acc[ai][bj][m][0] * r + cv[bj][0], v1 = acc[ai][bj][m][1] * r + cv[bj][1];
#pragma unroll
                    for (int e = 0; e < 4; ++e) { const float a = fmaxf(v0[e], 0.f), b = fmaxf(v1[e], 0.f); v0[e] = a * a; v1[e] = b * b; }
                    u32x4 w; w.x = cvt_pk_bf16(v0[0], v0[1]); w.y = cvt_pk_bf16(v0[2], v0[3]); w.z = cvt_pk_bf16(v1[0], v1[1]); w.w = cvt_pk_bf16(v1[2], v1[3]);
                    *(u32x4*)(rowp + bj * 2 * 16384) = w; } }
    }
};
struct EpiFF2 {
    static constexpr bool PERM = true, AFTER_DRAIN = false;
    const float* mod; const bf16_t* HB; float* out; float* PART; const float* nf; unsigned* cnt;
    __device__ __forceinline__ void operator()(const f32x4 (&acc)[2][2][4][2], const Unit& u, int ui, int wr, int wc, int fr_, int fq_) const {
        int fr = fr_, fq = fq_; asm volatile("" : "+v"(fr), "+v"(fq));
        const int pm = u.pm, pn = u.pn; const int mb = pm < 16 ? 0 : 1 + ((pm - 16) >> 2);
        const __amdgpu_buffer_rsrc_t pr = __builtin_amdgcn_make_buffer_rsrc(PART, 0, 0x7fffffff, 0x00020000);
        const float* g2 = mod + mb * 12288 + 5 * 2048;
        f32x4 gv[2][2];
#pragma unroll
        for (int bj = 0; bj < 2; ++bj)
#pragma unroll
            for (int n = 0; n < 2; ++n) gv[bj][n] = *(const f32x4*)(g2 + pn * 256 + bj * 128 + wc * 32 + 8 * fq + 4 * n);
#define FF2_H(hw_) const f32x4 h0 = {__builtin_bit_cast(float, hw_.x << 16), __builtin_bit_cast(float, hw_.x & 0xffff0000u), __builtin_bit_cast(float, hw_.y << 16), __builtin_bit_cast(float, hw_.y & 0xffff0000u)}; \
                   const f32x4 h1 = {__builtin_bit_cast(float, hw_.z << 16), __builtin_bit_cast(float, hw_.z & 0xffff0000u), __builtin_bit_cast(float, hw_.w << 16), __builtin_bit_cast(float, hw_.w & 0xffff0000u)}
#pragma unroll
        for (int ai = 0; ai < 2; ++ai) {
            u32x4 hin[4][2];
#pragma unroll
            for (int m = 0; m < 4; ++m)
#pragma unroll
                for (int bj = 0; bj < 2; ++bj) hin[m][bj] = *(const u32x4*)(HB + (size_t)(pm * 8 + pn) * 65536 + (((wr * 4 + wc) * 4 + fq) * 16 + fr) * 8 + ((ai * 2 + bj) * 4 + m) * 4096);
#pragma unroll
            for (int m = 0; m < 4; ++m) { const int row = pm * 256 + ai * 128 + wr * 64 + m * 16 + fr; float s = 0.f;
#pragma unroll
                for (int bj = 0; bj < 2; ++bj) { const u32x4 hw_ = hin[m][bj]; FF2_H(hw_);
                    const f32x4 y0 = h0 + gv[bj][0] * acc[ai][bj][m][0], y1 = h1 + gv[bj][1] * acc[ai][bj][m][1];
                    s += (y0[0] * y0[0] + y0[1] * y0[1]) + (y0[2] * y0[2] + y0[3] * y0[3]) + (y1[0] * y1[0] + y1[1] * y1[1]) + (y1[2] * y1[2] + y1[3] * y1[3]); }
                s += __shfl_xor(s, 16); s += __shfl_xor(s, 32);
                if (fq == 0) __builtin_amdgcn_raw_buffer_store_b32(__builtin_bit_cast(unsigned, s), pr, (unsigned)(row * 32 + pn * 4 + wc) * 4u, 0, 16); }
            asm volatile("" ::: "memory"); }
        asm volatile("s_waitcnt vmcnt(0)" ::: "memory");
        unsigned* pc = cnt + pm * 64;
        if (fr == 0 && fq == 0) __hip_atomic_fetch_add(pc, 1u, __ATOMIC_RELAXED, __HIP_MEMORY_SCOPE_AGENT);
        { unsigned spins = 0;
          while ((unsigned)__builtin_amdgcn_readfirstlane((int)__hip_atomic_load(pc, __ATOMIC_RELAXED, __HIP_MEMORY_SCOPE_AGENT)) < 64u) { __builtin_amdgcn_s_sleep(2); if (++spins > (1u << 22)) break; } }
        asm volatile("" : "+v"(fr), "+v"(fq) :: "memory");
        asm volatile("" : "+v"(gv[0][0]), "+v"(gv[0][1]), "+v"(gv[1][0]), "+v"(gv[1][1]));
        float rs[2][4];
#pragma unroll
        for (int ai = 0; ai < 2; ++ai) { u32x4 pa[4][2];
#pragma unroll
            for (int m = 0; m < 4; ++m) { const int row = pm * 256 + ai * 128 + wr * 64 + m * 16 + fr;
#pragma unroll
                for (int q = 0; q < 2; ++q) pa[m][q] = __builtin_amdgcn_raw_buffer_load_b128(pr, (unsigned)(row * 32 + fq * 8 + 4 * q) * 4u, 0, 16); }
#pragma unroll
            for (int m = 0; m < 4; ++m) { const f32x4 a = __builtin_bit_cast(f32x4, pa[m][0]), b = __builtin_bit_cast(f32x4, pa[m][1]);
                float s = (a[0] + a[1]) + (a[2] + a[3]) + (b[0] + b[1]) + (b[2] + b[3]);
                s += __shfl_xor(s, 16); s += __shfl_xor(s, 32);
                rs[ai][m] = __builtin_amdgcn_rsqf(s * (1.0f / 2048.0f) + 1e-6f); }
            asm volatile("" ::: "memory"); }
        f32x4 nv[2][2];
#pragma unroll
        for (int bj = 0; bj < 2; ++bj)
#pragma unroll
            for (int n = 0; n < 2; ++n) nv[bj][n] = *(const f32x4*)(nf + pn * 256 + bj * 128 + wc * 32 + 8 * fq + 4 * n);
#pragma unroll
        for (int ai = 0; ai < 2; ++ai) { u32x4 hin[4][2];
#pragma unroll
            for (int m = 0; m < 4; ++m)
#pragma unroll
                for (int bj = 0; bj < 2; ++bj) hin[m][bj] = *(const u32x4*)(HB + (size_t)(pm * 8 + pn) * 65536 + (((wr * 4 + wc) * 4 + fq) * 16 + fr) * 8 + ((ai * 2 + bj) * 4 + m) * 4096);
#pragma unroll
            for (int m = 0; m < 4; ++m) { const size_t row = (size_t)pm * 256 + ai * 128 + wr * 64 + m * 16 + fr; const float r = rs[ai][m];
#pragma unroll
                for (int bj = 0; bj < 2; ++bj) { const u32x4 hw_ = hin[m][bj]; FF2_H(hw_);
                    const f32x4 y0 = h0 + gv[bj][0] * acc[ai][bj][m][0], y1 = h1 + gv[bj][1] * acc[ai][bj][m][1];
                    float* p = out + row * 2048 + pn * 256 + bj * 128 + wc * 32 + 8 * fq;
                    *(f32x4*)p = y0 * r * nv[bj][0]; *(f32x4*)(p + 4) = y1 * r * nv[bj][1]; } }
            asm volatile("" ::: "memory"); }
#undef FF2_H
    }
};

template <class Epi, class Sched, bool ALIGN_EPI = false, bool SP2 = false, int NPART = 1, int NSLOTS = 128>
__device__ __forceinline__ void gemm_phase(PG8_LAS unsigned char* lds, const Gemm g, const Sched& S, const Epi& E, float* partial = nullptr, unsigned* flags = nullptr, int pslot_split = 1 << 30, unsigned pslot_gap = 0u) {
    const int tid = threadIdx.x, wid = __builtin_amdgcn_readfirstlane(tid >> 6), lane = tid & 63, wr = wid >> 2, wc = wid & 3, fr = lane & 15, fq = lane >> 4;
    const int K = g.K;
    unsigned voffA[2], voffB[2];
    static_assert(Epi::PERM, "the weight images are stored with the perm32 row order");
#pragma unroll
    for (int i = 0; i < 2; ++i) { int R, C; stage_rc(tid * 16 + i * 8192, R, C);
        voffA[i] = g.atiled ? (unsigned)(tid * 16 + i * 8192) : (unsigned)(R * K + C) * 2u; voffB[i] = (unsigned)(tid * 16 + i * 8192); }
    const size_t kstep = (size_t)(BK * 2);
    const size_t hstep = (size_t)HALF * K * 2;
    const size_t tstep = 2 * hstep;
    const size_t kstepA = g.atiled ? (size_t)(BM * BK * 2) : kstep;
    const size_t hstepA = g.atiled ? (size_t)(HALF * BK * 2) : hstep;
    const size_t kstepB = (size_t)(BM * BK * 2), hstepB = (size_t)(HALF * BK * 2);
    const unsigned ldsw = (unsigned)wid * 1024u;
    const int aoff = lds_byte(wr * 64 + fr, fq * 8), boff = lds_byte(wc * 32 + fr, fq * 8);
#define PG8_SA(b, h) (((b) * 2 + (h)) * HTB)
#define PG8_SB(b, h) ((4 + (b) * 2 + (h)) * HTB)
#define PG8_STAGE(bufoff, gbase, voff) do { _Pragma("unroll") for (int _i = 0; _i < 2; ++_i) \
        __builtin_amdgcn_global_load_lds((const unsigned*)((const char*)(gbase) + (voff)[_i]), (PG8_LAS unsigned*)(lds + (bufoff) + ldsw + _i * 8192), 16, 0, 0); } while (0)
#define PG8_LDA(dst, b, h) do { _Pragma("unroll") for (int m = 0; m < 4; ++m) _Pragma("unroll") for (int k = 0; k < 2; ++k) dst[m][k] = *(const PG8_LAS bf16x8*)(lds + PG8_SA(b, h) + aoff + m * 2048 + k * 1024); } while (0)
#define PG8_LDB(dst, b, h) do { _Pragma("unroll") for (int n = 0; n < 2; ++n) _Pragma("unroll") for (int k = 0; k < 2; ++k) dst[n][k] = *(const PG8_LAS bf16x8*)(lds + PG8_SB(b, h) + boff + n * 2048 + k * 1024); } while (0)
#define PG8_MMA(ai, bj, At, Bt) do { __builtin_amdgcn_s_setprio(1); _Pragma("unroll") for (int m = 0; m < 4; ++m) _Pragma("unroll") for (int n = 0; n < 2; ++n) _Pragma("unroll") for (int k = 0; k < 2; ++k) \
        acc[ai][bj][m][n] = __builtin_amdgcn_mfma_f32_16x16x32_bf16(Bt[n][k], At[m][k], acc[ai][bj][m][n], 0, 0, 0); __builtin_amdgcn_s_setprio(0); } while (0)
#define PG8_WAIT_V(n) asm volatile("s_waitcnt vmcnt(" #n ")" ::: "memory")
#define PG8_WAIT_L(n) asm volatile("s_waitcnt lgkmcnt(" #n ")" ::: "memory")
#define PG8_BAR __builtin_amdgcn_s_barrier()
#define PG8_SCHED __builtin_amdgcn_sched_barrier(0)
    Unit cur, nxt; int ui = 0;
    if (!S.next(0, cur)) return;
    f32x4 acc[2][2][4][2];
#pragma unroll
    for (int a = 0; a < 2; ++a)
#pragma unroll
        for (int b = 0; b < 2; ++b)
#pragma unroll
            for (int m = 0; m < 4; ++m)
#pragma unroll
                for (int n = 0; n < 2; ++n) acc[a][b][m][n] = (f32x4){0.f, 0.f, 0.f, 0.f};
    bf16x8 At[4][2], B0[2][2], B1[2][2];
    const char* cA = (const char*)g.A + (size_t)cur.pm * tstep + (size_t)cur.k0 * kstepA; const char* cB = (const char*)g.Bt + (size_t)cur.pn * tstep + (size_t)cur.k0 * kstepB;
    S.a_ready(cur);
    if constexpr (SP2) {
        PG8_STAGE(PG8_SB(0, 0), cB, voffB); PG8_STAGE(PG8_SB(0, 1), cB + hstepB, voffB); PG8_STAGE(PG8_SA(0, 0), cA, voffA); PG8_STAGE(PG8_SA(0, 1), cA + hstepA, voffA);
        if (wr == 1) PG8_BAR;
        PG8_WAIT_V(2); PG8_BAR;
        PG8_STAGE(PG8_SB(1, 0), cB + kstepB, voffB); PG8_STAGE(PG8_SA(1, 0), cA + kstepA, voffA); PG8_STAGE(PG8_SB(1, 1), cB + hstepB + kstepB, voffB);
        PG8_WAIT_V(6); PG8_BAR;
    } else {
        PG8_STAGE(PG8_SB(0, 0), cB, voffB); PG8_STAGE(PG8_SA(0, 0), cA, voffA); PG8_STAGE(PG8_SB(0, 1), cB + hstepB, voffB); PG8_STAGE(PG8_SA(0, 1), cA + hstepA, voffA);
        if (wr == 1) PG8_BAR;
        PG8_WAIT_V(4); PG8_BAR;
        PG8_STAGE(PG8_SB(1, 0), cB + kstepB, voffB); PG8_STAGE(PG8_SA(1, 0), cA + kstepA, voffA); PG8_STAGE(PG8_SB(1, 1), cB + hstepB + kstepB, voffB);
        PG8_WAIT_V(6); PG8_BAR;
    }
    for (;;) {
        const bool has_next = S.next(ui + 1, nxt);
        const char* nA = has_next ? (const char*)g.A + (size_t)nxt.pm * tstep + (size_t)nxt.k0 * kstepA : cA; const char* nB = has_next ? (const char*)g.Bt + (size_t)nxt.pn * tstep + (size_t)nxt.k0 * kstepB : cB;
        const int nt = cur.nt;
        for (int t = 0; t < nt; t += 2) {
            const bool last = (t == nt - 2);
            const char* a1 = cA + (size_t)(t + 1) * kstepA;
            const char* a2 = last ? nA : cA + (size_t)(t + 2) * kstepA; const char* b2 = last ? nB : cB + (size_t)(t + 2) * kstepB;
            const char* a3 = a2 + kstepA; const char* b3 = b2 + kstepB;
            if (last && has_next) S.a_ready(nxt);
            if constexpr (SP2) {
            PG8_LDB(B0, 0, 0); PG8_LDB(B1, 0, 1); PG8_SCHED; PG8_LDA(At, 0, 0); PG8_STAGE(PG8_SA(1, 1), a1 + hstepA, voffA);
            PG8_WAIT_V(8); PG8_WAIT_L(0); PG8_BAR; PG8_MMA(0, 0, At, B0); PG8_MMA(0, 1, At, B1); PG8_BAR; PG8_SCHED;
            PG8_LDA(At, 0, 1); PG8_STAGE(PG8_SB(0, 0), b2, voffB); PG8_STAGE(PG8_SB(0, 1), b2 + hstepB, voffB); PG8_STAGE(PG8_SA(0, 0), a2, voffA);
            PG8_WAIT_V(8); PG8_WAIT_L(0); PG8_BAR; PG8_MMA(1, 0, At, B0); PG8_MMA(1, 1, At, B1); PG8_BAR; PG8_SCHED;
            PG8_LDB(B0, 1, 0); PG8_LDB(B1, 1, 1); PG8_SCHED; PG8_LDA(At, 1, 0); PG8_STAGE(PG8_SA(0, 1), a2 + hstepA, voffA);
            PG8_WAIT_V(8); PG8_WAIT_L(0); PG8_BAR; PG8_MMA(0, 0, At, B0); PG8_MMA(0, 1, At, B1); PG8_BAR; PG8_SCHED;
            PG8_LDA(At, 1, 1); PG8_STAGE(PG8_SB(1, 0), b3, voffB); PG8_STAGE(PG8_SB(1, 1), b3 + hstepB, voffB); PG8_STAGE(PG8_SA(1, 0), a3, voffA);
            PG8_WAIT_V(8); PG8_WAIT_L(0); PG8_BAR; PG8_MMA(1, 0, At, B0); PG8_MMA(1, 1, At, B1); PG8_BAR; PG8_SCHED;
            } else {
            PG8_LDB(B0, 0, 0); PG8_SCHED; PG8_LDA(At, 0, 0); PG8_STAGE(PG8_SA(1, 1), a1 + hstepA, voffA);
            PG8_WAIT_L(8); PG8_BAR; PG8_WAIT_L(0); PG8_MMA(0, 0, At, B0); PG8_BAR; PG8_SCHED;
            PG8_LDB(B1, 0, 1); PG8_STAGE(PG8_SB(0, 0), b2, voffB);
            PG8_BAR; PG8_WAIT_L(0); PG8_MMA(0, 1, At, B1); PG8_BAR;
            PG8_LDA(At, 0, 1); PG8_STAGE(PG8_SA(0, 0), a2, voffA);
            PG8_BAR; PG8_WAIT_L(0); PG8_MMA(1, 0, At, B0); PG8_BAR; PG8_SCHED;
            PG8_STAGE(PG8_SB(0, 1), b2 + hstepB, voffB);
            PG8_WAIT_V(6); PG8_BAR; PG8_MMA(1, 1, At, B1); PG8_BAR;
            PG8_LDB(B0, 1, 0); PG8_SCHED; PG8_LDA(At, 1, 0); PG8_STAGE(PG8_SA(0, 1), a2 + hstepA, voffA);
            PG8_WAIT_L(8); PG8_BAR; PG8_WAIT_L(0); PG8_MMA(0, 0, At, B0); PG8_BAR; PG8_SCHED;
            PG8_LDB(B1, 1, 1); PG8_STAGE(PG8_SB(1, 0), b3, voffB);
            PG8_BAR; PG8_WAIT_L(0); PG8_MMA(0, 1, At, B1); PG8_BAR;
            PG8_LDA(At, 1, 1); PG8_STAGE(PG8_SA(1, 0), a3, voffA);
            PG8_BAR; PG8_WAIT_L(0); PG8_MMA(1, 0, At, B0); PG8_BAR; PG8_SCHED;
            PG8_STAGE(PG8_SB(1, 1), b3 + hstepB, voffB);
            PG8_WAIT_V(6); PG8_BAR; PG8_MMA(1, 1, At, B1); PG8_BAR;
            }
        }
        if constexpr (ALIGN_EPI) { if (wr == 0) PG8_BAR; }
        if constexpr (!Epi::AFTER_DRAIN) {
            if (partial != nullptr) {
                int tid_o = tid; asm volatile("" : "+v"(tid_o));
                const unsigned pb = (unsigned)cur.slot * 262144u + (cur.slot >= pslot_split ? pslot_gap : 0u) + (unsigned)tid_o * 16u;
                const bool m2 = cur.mode == 2;
                if (m2) {
                    unsigned spins = 0;
                    for (;;) { unsigned ok = 1u;
#pragma unroll
                        for (int p = 0; p < NPART; ++p) if (p < cur.npart) ok &= (__hip_atomic_load(flags + (cur.slot + p) * 8 + wid, __ATOMIC_RELAXED, __HIP_MEMORY_SCOPE_AGENT) != 0u) ? 1u : 0u;
                        if (__builtin_amdgcn_readfirstlane(ok) != 0u) break;
                        __builtin_amdgcn_s_sleep(8); if (++spins > (1u << 22)) break; }
                }
#pragma unroll 1
                for (int p = 0; p < (m2 ? cur.npart : 0); ++p) {
                    const __amdgpu_buffer_rsrc_t prl = __builtin_amdgcn_make_buffer_rsrc(partial, 0, 0x7fffffff, 0x00020000);
                    const unsigned pbp = pb + (unsigned)p * 262144u;
#pragma unroll
                    for (int a = 0; a < 2; ++a) { u32x4 pv_[2][4];
#pragma unroll
                        for (int b = 0; b < 2; ++b)
#pragma unroll
                            for (int m = 0; m < 4; ++m) pv_[b][m] = __builtin_amdgcn_raw_buffer_load_b128(prl, pbp, ((a * 2 + b) * 4 + m) * 8192, 16);
#pragma unroll
                        for (int b = 0; b < 2; ++b)
#pragma unroll
                            for (int m = 0; m < 4; ++m) { const u32x4 w = pv_[b][m];
                                acc[a][b][m][0] += (f32x4){__builtin_bit_cast(float, w.x << 16), __builtin_bit_cast(float, w.x & 0xffff0000u), __builtin_bit_cast(float, w.y << 16), __builtin_bit_cast(float, w.y & 0xffff0000u)};
                                acc[a][b][m][1] += (f32x4){__builtin_bit_cast(float, w.z << 16), __builtin_bit_cast(float, w.z & 0xffff0000u), __builtin_bit_cast(float, w.w << 16), __builtin_bit_cast(float, w.w & 0xffff0000u)}; }
                        asm volatile("" ::: "memory"); }
                }
            }
            {
                if (partial != nullptr && cur.mode == 1) {
                    int tid_o = tid; asm volatile("" : "+v"(tid_o));
                    const unsigned pb = (unsigned)cur.slot * 262144u + (cur.slot >= pslot_split ? pslot_gap : 0u) + (unsigned)tid_o * 16u;
                    const __amdgpu_buffer_rsrc_t pr_ = __builtin_amdgcn_make_buffer_rsrc(partial, 0, 0x7fffffff, 0x00020000);
#pragma unroll
                    for (int a = 0; a < 2; ++a)
#pragma unroll
                        for (int b = 0; b < 2; ++b)
#pragma unroll
                            for (int m = 0; m < 4; ++m) { const u32x2 lo = pack4(acc[a][b][m][0]), hi = pack4(acc[a][b][m][1]); u32x4 w; w.x = lo.x; w.y = lo.y; w.z = hi.x; w.w = hi.y;
                                __builtin_amdgcn_raw_buffer_store_b128(w, pr_, pb, ((a * 2 + b) * 4 + m) * 8192, 16); }
                    asm volatile("s_waitcnt vmcnt(0)" ::: "memory");
                    if (lane == 0) __hip_atomic_store(flags + cur.slot * 8 + wid, 1u, __ATOMIC_RELAXED, __HIP_MEMORY_SCOPE_AGENT);
                } else E(acc, cur, ui, wr, wc, fr, fq);
            }
            S.done(cur);
        }
        if (!has_next) break;
#pragma unroll
        for (int a = 0; a < 2; ++a)
#pragma unroll
            for (int b = 0; b < 2; ++b)
#pragma unroll
                for (int m = 0; m < 4; ++m)
#pragma unroll
                    for (int n = 0; n < 2; ++n) acc[a][b][m][n] = (f32x4){0.f, 0.f, 0.f, 0.f};
        cur = nxt; cA = nA; cB = nB; ++ui;
        if constexpr (ALIGN_EPI) { if (wr == 1) PG8_BAR; }
    }
    PG8_WAIT_V(0);
    if constexpr (!ALIGN_EPI) { if (wr == 0) PG8_BAR; }
    PG8_BAR;
    if constexpr (Epi::AFTER_DRAIN) { E.fused(acc, cur, wr, wc, fr, fq, lds, wid, lane); S.done(cur); }
#undef PG8_SA
#undef PG8_SB
#undef PG8_STAGE
#undef PG8_LDA
#undef PG8_LDB
#undef PG8_MMA
#undef PG8_WAIT_V
#undef PG8_WAIT_L
#undef PG8_BAR
#undef PG8_SCHED
}
}

#define GAS __attribute__((address_space(1)))
#define LAS __attribute__((address_space(3)))
typedef unsigned short bf16;
typedef unsigned v4u __attribute__((ext_vector_type(4)));
typedef float f32x4 __attribute__((ext_vector_type(4)));
typedef short bf16x8 __attribute__((ext_vector_type(8)));
typedef GAS unsigned gu32;
typedef GAS unsigned long long gu64;
#define RLX_AGENT __ATOMIC_RELAXED, __HIP_MEMORY_SCOPE_AGENT
#define LBAR() asm volatile("s_waitcnt lgkmcnt(0)\n\ts_barrier" ::: "memory")
#define LDS_WAIT() asm volatile("s_waitcnt lgkmcnt(0)" ::: "memory")
#define VM_WAIT() asm volatile("s_waitcnt vmcnt(0)" ::: "memory")
__device__ __forceinline__ unsigned long long rt() { return __builtin_amdgcn_s_memrealtime(); }
__device__ __forceinline__ unsigned f2bf(float f) { unsigned u = __builtin_bit_cast(unsigned, f); return (u + 0x7fffu + ((u >> 16) & 1u)) >> 16; }
__device__ __forceinline__ unsigned pk2(float lo, float hi) { return f2bf(lo) | (f2bf(hi) << 16); }

#define XB_TMO      128
#define XB_XCNT(j)  (256  + 64 * (j))
#define XB_XSUB(j)  (1280 + 64 * (j))
#define XB_XGEN(j)  (2304 + 64 * (j))
#define XB_TOP      3328
#define XB_TOPGEN   3392
#define XCD_BAR_WORDS 3456
#define XB_SPIN_CAP (1u << 18)

__device__ __forceinline__ unsigned xb_ld(unsigned* p)              { return __hip_atomic_load(p, __ATOMIC_RELAXED, __HIP_MEMORY_SCOPE_AGENT); }
__device__ __forceinline__ unsigned xb_add(unsigned* p, unsigned v) { return __hip_atomic_fetch_add(p, v, __ATOMIC_RELAXED, __HIP_MEMORY_SCOPE_AGENT); }
__device__ __forceinline__ unsigned xb_xcc_id() { return (unsigned)__builtin_amdgcn_s_getreg((3 << 11) | 20) & 0xFu; }
#define XB_SPIN(cond, bar) do { unsigned _sp = 0; while (cond) { __builtin_amdgcn_s_sleep(1); \
    if ((++_sp & 255u) == 0u) { if (xb_ld(&(bar)[XB_TMO])) break; if (_sp > XB_SPIN_CAP) { atomicAdd(&(bar)[XB_TMO], 1u); break; } } } } while (0)

struct XcdBarrier {
    unsigned* bar; unsigned x;
    volatile LAS unsigned* st;
};

__device__ __forceinline__ XcdBarrier xcd_barrier_post(unsigned* bar, volatile LAS unsigned* st) {
    XcdBarrier b; b.bar = bar; b.x = xb_xcc_id(); b.st = st;
    if (threadIdx.x == 0) (void)xb_add(&bar[XB_XCNT(b.x)], 1u);
    return b;
}
__device__ __forceinline__ void xcd_barrier_complete(unsigned* bar, unsigned x, unsigned& nloc, unsigned& nx) {
    const unsigned G = gridDim.x * gridDim.y * gridDim.z;
    unsigned sum, cnt, mine, sp = 0u;
    for (;;) {
        sum = 0u; cnt = 0u; mine = 0u;
#pragma unroll
        for (unsigned j = 0; j < 16; ++j) { const unsigned c = xb_ld(&bar[XB_XCNT(j)]); sum += c; cnt += (c > 0u) ? 1u : 0u; mine = (j == x) ? c : mine; }
        if (sum == G) break;
        __builtin_amdgcn_s_sleep(1);
        if ((++sp & 255u) == 0u) { if (xb_ld(&bar[XB_TMO])) break; if (sp > XB_SPIN_CAP) { atomicAdd(&bar[XB_TMO], 1u); break; } }
    }
    nloc = mine > 0u ? mine : 1u; nx = cnt > 0u ? cnt : 1u;
}

__device__ __forceinline__ void xcd_barrier(const XcdBarrier& b) {
    asm volatile("s_waitcnt vmcnt(0)" ::: "memory");
    __syncthreads();
    if (threadIdx.x == 0) {
        unsigned* bar = b.bar;
        __builtin_amdgcn_s_waitcnt(0);
        unsigned nloc = b.st[0], nx = b.st[1];
        if (nloc == 0u) { xcd_barrier_complete(bar, b.x, nloc, nx); b.st[0] = nloc; b.st[1] = nx; }
        const unsigned old = xb_add(&bar[XB_XSUB(b.x)], 1u);
        const unsigned gen = old / nloc;
        if (old + 1u == (gen + 1u) * nloc) {
            __builtin_amdgcn_fence(__ATOMIC_RELEASE, "agent");
            asm volatile("s_waitcnt vmcnt(0)" ::: "memory");
            const unsigned og = xb_add(&bar[XB_TOP], 1u);
            const unsigned tg = og / nx;
            if (og + 1u == (tg + 1u) * nx) xb_add(&bar[XB_TOPGEN], 1u);
            else XB_SPIN(xb_ld(&bar[XB_TOPGEN]) == tg, bar);
            __builtin_amdgcn_fence(__ATOMIC_ACQUIRE, "agent");
            xb_add(&bar[XB_XGEN(b.x)], 1u);
            asm volatile("s_waitcnt vmcnt(0)" ::: "memory");
        } else {
            XB_SPIN(xb_ld(&bar[XB_XGEN(b.x)]) == gen, bar);
            __builtin_amdgcn_fence(__ATOMIC_ACQUIRE, "agent");
            asm volatile("s_waitcnt vmcnt(0)" ::: "memory");
        }
    }
    __syncthreads();
}

constexpr int NWAVES = 8;
constexpr int DM = 2048, NPROMPT = 4096, NSAMPLE = 8192, MROWS = 12288, DFF = 8192, INC = 7200, NMOD = 12288;
constexpr float EPS = 1e-6f;
constexpr size_t MiB = 1u << 20;
constexpr size_t WS_CTL = 0, CTL_ZERO_BYTES = 128 * 1024;
constexpr size_t WS_MOD = 1 * MiB;
constexpr size_t WS_C2 = WS_MOD + 9 * 12288 * 4;
constexpr size_t WS_ROPE = WS_C2 + 9 * 8192 * 4;
constexpr size_t WS_PART = 2 * MiB, WS_PART2 = 4 * MiB, WS_AB = 6 * MiB;
constexpr size_t WS_EVEC = 8 * MiB;
constexpr size_t WS_WOUT = 12 * MiB, WS_WFF1 = 20 * MiB, WS_WFF2 = 52 * MiB, WS_WIN = 84 * MiB;
constexpr size_t WS_QHAT = 84 * MiB;
constexpr size_t WS_KS = 113 * MiB, WS_VS = 137 * MiB;
constexpr size_t WS_QKVB = 161 * MiB;
constexpr size_t WS_HB = 113 * MiB;
constexpr size_t WS_OF = 161 * MiB;
constexpr size_t WS_HW = 161 * MiB;
constexpr size_t WS_MIX = 233 * MiB;
constexpr size_t WS_KHT = 281 * MiB;
constexpr size_t WS_XN = 305 * MiB;
constexpr size_t WS_NW = 305 * MiB;
constexpr size_t WS_U = 353 * MiB;
constexpr size_t WS_INTRA = 401 * MiB;
constexpr size_t WS_FF = 209 * MiB;
constexpr size_t WS_END = 425 * MiB;
static_assert(WS_ROPE + 2048 * 4 <= WS_PART && WS_EVEC + 3072 * 192 * 4 <= WS_WOUT && WS_WIN + (size_t)INC * DM * 2 <= WS_KS && WS_FF + (size_t)MROWS * DFF * 2 <= WS_INTRA + 24 * MiB, "ws map");
static_assert(WS_HW + 48 * MiB <= WS_FF, "HW below FF");
constexpr size_t YO_QA = 0, YO_GATE = 24 * MiB, YO_KP = 48 * MiB, YO_VP = 56 * MiB, YO_OF = 48 * MiB, YO_OB = 72 * MiB;
constexpr size_t OUT_Y = 0, OUT_K = 25165824, OUT_V = OUT_K + 4194304, OUT_S = OUT_V + 4194304;
constexpr int CW_TMO = 0, CW_BAR = 4096, CW_FLAG = 16384, CW_PANEL = 20480, CW_PAIR = 24576;
constexpr int RING_OFF = 0, RING_BYTES = 131072, P0_SCR_BYTES = 8 * 16640, RSTD_OFF = 135168, LDSCTL_OFF = 146432, MISC_OFF = LDSCTL_OFF + 320, LDS_BYTES = 147456;
static_assert(P0_SCR_BYTES <= RSTD_OFF && RSTD_OFF + 6 * 256 * 4 <= LDSCTL_OFF && MISC_OFF + 128 <= LDS_BYTES, "LDS map");

typedef unsigned short bf16;
typedef unsigned u32x2 __attribute__((ext_vector_type(2)));
typedef float f32x16 __attribute__((ext_vector_type(16)));
typedef short s16x4 __attribute__((ext_vector_type(4)));
__device__ __forceinline__ float bf2f(unsigned short v) { return __builtin_bit_cast(float, (unsigned)v << 16); }
__device__ __forceinline__ float bflo(unsigned w) { return __builtin_bit_cast(float, w << 16); }
__device__ __forceinline__ float bfhi(unsigned w) { return __builtin_bit_cast(float, w & 0xffff0000u); }
__device__ __forceinline__ unsigned cvtpk(float lo, float hi) { return pg8::cvt_pk_bf16(lo, hi); }
__device__ __forceinline__ float wave_sum(float v) {
#pragma unroll
    for (int o = 1; o < 64; o <<= 1) v += __shfl_xor(v, o);
    return v;
}
__device__ __forceinline__ int crow(int r, int hi) { return (r & 3) + 8 * (r >> 2) + 4 * hi; }
__device__ __forceinline__ float silu_f(float x) { return x * __builtin_amdgcn_rcpf(1.0f + __expf(-x)); }

struct Frame {
    LAS unsigned char* lds; unsigned char* ldsg;
    volatile LAS unsigned* MISC;
    gu32* ctl;
    int tid, lane, wave, vcu, G;
    const float* const* inp; float* out; unsigned char* ws;
};

struct TileSrc { const float* src; bf16* dst; int K, N, n0; bool cval; };
__device__ __forceinline__ TileSrc p0_tile(Frame& F, int it, int lane) {
    constexpr int I_IN = (DM / 64) * ((INC + 63) / 64), I_OUT = (DM / 64) * (DM / 64), I_F1 = (DM / 64) * (DFF / 64);
    const float* W; bf16* WT; int K, N; int r = it;
    if (r < I_IN) { W = F.inp[10]; WT = (bf16*)(F.ws + WS_WIN); K = DM; N = INC; }
    else if ((r -= I_IN) < I_OUT) { W = F.inp[17]; WT = (bf16*)(F.ws + WS_WOUT); K = DM; N = DM; }
    else if ((r -= I_OUT) < I_F1) { W = F.inp[19]; WT = (bf16*)(F.ws + WS_WFF1); K = DM; N = DFF; }
    else { r -= I_F1; W = F.inp[20]; WT = (bf16*)(F.ws + WS_WFF2); K = DFF; N = DM; }
    const int nblk = (N + 63) / 64, kb = r / nblk, nb = r % nblk, k0 = 64 * kb, n0 = 64 * nb; const int c = 4 * (lane & 15);
    TileSrc t; t.src = W + (size_t)(k0 + (lane >> 4)) * N + n0 + c; t.dst = WT + (size_t)((n0 >> 8) * (K >> 6) + kb) * 16384; t.K = K;     t.N = N; t.n0 = n0; t.cval = (n0 + c) < N; return t;
}
__device__ __forceinline__ void p0_tile_load(Frame& F, int it, int lane, f32x4 (&v)[16]) {
    const TileSrc t = p0_tile(F, it, lane);
    const float* p = t.src; const size_t step = (size_t)4 * t.N;
#pragma unroll
    for (int i = 0; i < 16; ++i) { v[i] = (f32x4){0.f, 0.f, 0.f, 0.f}; if (t.cval) v[i] = __builtin_nontemporal_load((const GAS f32x4*)p);     p += step; asm volatile("" : "+v"(p)); }
}
__device__ __forceinline__ void p0_tile_store(Frame& F, int it, const f32x4 (&v)[16], LAS float* scr, int lane) {
    const TileSrc t = p0_tile(F, it, lane);
    const int c = 4 * (lane & 15);
#pragma unroll
    for (int i = 0; i < 16; ++i) { LAS float* d = scr + (4 * i + (lane >> 4)) * 65 + c; d[0] = v[i][0]; d[1] = v[i][1]; d[2] = v[i][2]; d[3] = v[i][3]; }
    LDS_WAIT(); asm volatile("" ::: "memory");
    const int c8 = lane & 7;
#pragma unroll
    for (int j = 0; j < 8; ++j) { const int n = (lane >> 3) + 8 * j; const LAS float* s_ = scr + (8 * c8) * 65 + n;
        v4u o; o.x = cvtpk(s_[0 * 65], s_[1 * 65]); o.y = cvtpk(s_[2 * 65], s_[3 * 65]); o.z = cvtpk(s_[4 * 65], s_[5 * 65]); o.w = cvtpk(s_[6 * 65], s_[7 * 65]);
        const int nb_ = (t.n0 & 255) + n, ri_ = (nb_ & 96) + pg8::perm32inv(nb_ & 31);
        bf16* dp_ = t.dst + (nb_ >> 7) * 8192 + (pg8::lds_byte(ri_, 8 * c8) >> 1);
        if (t.n0 + n < t.N) { if (t.N == INC) *(GAS v4u*)dp_ = o; else __builtin_nontemporal_store(o, (GAS v4u*)dp_); }
        if (j & 1) __builtin_amdgcn_sched_barrier(0); }
    LDS_WAIT(); asm volatile("" ::: "memory");
}
__device__ __forceinline__ void p0_phase(Frame& F) {
    const float* c_lat = F.inp[5]; const float* c_ctx = F.inp[6]; const float* w_mod = F.inp[7]; const float* b_mod = F.inp[8];
    float* MOD = (float*)(F.ws + WS_MOD);
    const int bid = F.vcu;
    if (bid < 192) {
        LAS float* sil = (LAS float*)(F.lds);
        LAS float* red = (LAS float*)(F.lds + 9 * 2048 * 4);
        for (int idx = F.tid; idx < 9 * 2048; idx += 512) { const int b = idx >> 11, k = idx & 2047; const float cv = (b == 0) ? c_ctx[k] : c_lat[(b - 1) * 2048 + k]; sil[idx] = silu_f(cv); }
        __syncthreads();
        const int c0 = 64 * bid + 4 * (F.lane & 15);
        f32x4 acc[9];
#pragma unroll
        for (int b = 0; b < 9; ++b) acc[b] = (f32x4){0.f, 0.f, 0.f, 0.f};
        const int kbase = 256 * F.wave + (F.lane >> 4);
        for (int it0 = 0; it0 < 64; it0 += 16) {
            f32x4 wv[16];
#pragma unroll
            for (int u = 0; u < 16; ++u) wv[u] = __builtin_nontemporal_load((const f32x4*)(w_mod + (size_t)(kbase + 4 * (it0 + u)) * NMOD + c0));
#pragma unroll
            for (int u = 0; u < 16; ++u) { const int k = kbase + 4 * (it0 + u);
#pragma unroll
                for (int b = 0; b < 9; ++b) { const float s_ = sil[b * 2048 + k]; acc[b] += wv[u] * s_; }
                if ((u & 1) == 1) __builtin_amdgcn_sched_barrier(0); }
        }
#pragma unroll
        for (int b = 0; b < 9; ++b)
#pragma unroll
            for (int e = 0; e < 4; ++e) { float v = acc[b][e]; v += __shfl_xor(v, 16); v += __shfl_xor(v, 32); acc[b][e] = v; }
        if (F.lane < 16) {
#pragma unroll
            for (int b = 0; b < 9; ++b)
#pragma unroll
                for (int e = 0; e < 4; ++e) red[(F.wave * 9 + b) * 64 + 4 * F.lane + e] = acc[b][e]; }
        __syncthreads();
        for (int idx = F.tid; idx < 9 * 64; idx += 512) { const int b = idx >> 6, cc = idx & 63; float s_ = b_mod[64 * bid + cc];
#pragma unroll
            for (int w = 0; w < 8; ++w) s_ += red[(w * 9 + b) * 64 + cc];
            MOD[b * NMOD + 64 * bid + cc] = s_; }
        __syncthreads();
    } else if (bid == 255) { float* rope = (float*)(F.ws + WS_ROPE);
        for (int idx = F.tid; idx < 1024; idx += 512) { const int pos = idx >> 4, i = idx & 15; const float inv = 1.0f / powf(10000.0f, (float)i * (1.0f / 16.0f)); const float ang = (float)pos * inv;
            rope[idx] = cosf(ang); rope[1024 + idx] = sinf(ang); } }
    const int myslots = (bid < 192) ? 5 : 7;
    const int slot0 = (bid < 192) ? (bid * NWAVES + F.wave) * 5 : 192 * NWAVES * 5 + ((bid - 192) * NWAVES + F.wave) * 7;
    constexpr int NSLOT = 192 * NWAVES * 5 + 64 * NWAVES * 7;
    {
        LAS float* scr = (LAS float*)(F.lds + F.wave * 16640);
        constexpr int NITEMS = (DM / 64) * ((INC + 63) / 64) + (DM / 64) * (DM / 64) + (DM / 64) * (DFF / 64) + (DFF / 64) * (DM / 64);
        f32x4 ta[16], tb[16];
        const int gw_ = bid * NWAVES + F.wave, NGW_ = F.G * NWAVES;
        constexpr int QLAST = NITEMS / (256 * NWAVES);
        const int gwl_ = (F.G == 256) ? ((bid >= 192) ? (bid - 192) * NWAVES + F.wave : 64 * NWAVES + gw_) : gw_;
#define P0_ITEM(q) (((q) == QLAST ? gwl_ : gw_) + NGW_ * (q))
        int q = 0; int ia = P0_ITEM(0);
        if (ia < NITEMS) { p0_tile_load(F, ia, F.lane, ta);
            for (;;) {
                const int ib = P0_ITEM(q + 1); const bool hb = ib < NITEMS;
                if (hb) p0_tile_load(F, ib, F.lane, tb);
                p0_tile_store(F, ia, ta, scr, F.lane);
                if (!hb) break;
                const int ic = P0_ITEM(q + 2); const bool hc = ic < NITEMS;
                if (hc) p0_tile_load(F, ic, F.lane, ta);
                p0_tile_store(F, ib, tb, scr, F.lane);
                if (!hc) break;
                q += 2; ia = ic;
            }
        }
#undef P0_ITEM
    }
    {
        const float* ck = F.inp[2]; const float* cv = F.inp[3];
        bf16* KS = (bf16*)(F.ws + WS_KS); bf16* VS = (bf16*)(F.ws + WS_VS);
        for (int s_ = 0; s_ < myslots; ++s_)
            for (int base = slot0 + s_; base < 2 * 8192; base += 4 * NSLOT) {
                f32x4 a[4], b[4];
#pragma unroll
                for (int u = 0; u < 4; ++u) { const int it = base + u * NSLOT; if (it < 2 * 8192) { const bool isV = it >= 8192; const int j = isV ? it - 8192 : it; const float* src = (isV ? cv : ck) + (size_t)j * 512 + 8 * F.lane; a[u] = __builtin_nontemporal_load((const f32x4*)src); b[u] = __builtin_nontemporal_load((const f32x4*)(src + 4)); } }
#pragma unroll
                for (int u = 0; u < 4; ++u) { const int it = base + u * NSLOT; if (it < 2 * 8192) { const bool isV = it >= 8192; const int j = isV ? it - 8192 : it;
                    const size_t e0 = (size_t)j * 512 + 8 * F.lane; const int bh = (int)(e0 >> 16); const size_t rem = e0 & 65535;
                    v4u o; o.x = cvtpk(a[u][0], a[u][1]); o.y = cvtpk(a[u][2], a[u][3]); o.z = cvtpk(b[u][0], b[u][1]); o.w = cvtpk(b[u][2], b[u][3]);
                    __builtin_nontemporal_store(o, (GAS v4u*)((isV ? VS : KS) + (size_t)bh * 1536 * 128 + rem)); } }
            }
    }
}
__device__ __forceinline__ float wsum64(float v) {
    v += __builtin_bit_cast(float, __builtin_amdgcn_update_dpp(0, __builtin_bit_cast(int, v), 0xB1, 0xf, 0xf, true));
    v += __builtin_bit_cast(float, __builtin_amdgcn_update_dpp(0, __builtin_bit_cast(int, v), 0x4E, 0xf, 0xf, true));
    v += __builtin_bit_cast(float, __builtin_amdgcn_update_dpp(0, __builtin_bit_cast(int, v), 0x141, 0xf, 0xf, true));
    v += __builtin_bit_cast(float, __builtin_amdgcn_update_dpp(0, __builtin_bit_cast(int, v), 0x140, 0xf, 0xf, true));
    const int b = __builtin_bit_cast(int, v);
    return __builtin_bit_cast(float, __builtin_amdgcn_readlane(b, 0)) + __builtin_bit_cast(float, __builtin_amdgcn_readlane(b, 16)) + __builtin_bit_cast(float, __builtin_amdgcn_readlane(b, 32)) + __builtin_bit_cast(float, __builtin_amdgcn_readlane(b, 48));
}
__device__ __forceinline__ void p1_phase(Frame& F) {
    const float* MOD = (const float*)(F.ws + WS_MOD); const float* norm1 = F.inp[9];
    bf16* XN = (bf16*)(F.ws + WS_XN);
    const int gw = F.vcu * NWAVES + F.wave, NGW = F.G * NWAVES;
    {
        const bf16* W1t = (const bf16*)(F.ws + WS_WFF1); float* C2 = (float*)(F.ws + WS_C2);
        const int n = F.lane & 15, g = F.lane >> 4;
        LAS float* red = (LAS float*)F.lds;
        for (int id = F.vcu; id < DFF / 16; id += F.G) {
            const int f_ = id * 16 + n;
            const int fb_ = f_ & 255, fri_ = (fb_ & 96) + pg8::perm32inv(fb_ & 31);
            const bf16* bp = W1t + (size_t)((f_ >> 8) * 32 + 4 * F.wave) * 16384 + (fb_ >> 7) * 8192;
            const float* ap = MOD + (size_t)(n < 9 ? n : 0) * NMOD + 3 * DM + 256 * F.wave + 8 * g;
            f32x4 acc = {0.f, 0.f, 0.f, 0.f};
#pragma unroll
            for (int st = 0; st < 8; ++st) {
                const bf16x8 bfr = *(const bf16x8*)(bp + (st >> 1) * 16384 + (pg8::lds_byte(fri_, 32 * (st & 1) + 8 * g) >> 1));
                f32x4 a0 = *(const f32x4*)(ap + 32 * st), a1 = *(const f32x4*)(ap + 32 * st + 4);
                if (n >= 9) { a0 = (f32x4){0.f, 0.f, 0.f, 0.f}; a1 = a0; }
                v4u aw; aw.x = cvtpk(a0[0], a0[1]); aw.y = cvtpk(a0[2], a0[3]); aw.z = cvtpk(a1[0], a1[1]); aw.w = cvtpk(a1[2], a1[3]);
                acc = __builtin_amdgcn_mfma_f32_16x16x32_bf16(__builtin_bit_cast(bf16x8, aw), bfr, acc, 0, 0, 0);
            }
#pragma unroll
            for (int r = 0; r < 4; ++r) red[(F.wave * 16 + 4 * g + r) * 17 + n] = acc[r];
            __syncthreads();
            if (F.tid < 9 * 16) { const int mb = F.tid >> 4, cc = F.tid & 15; float v = 0.f;
#pragma unroll
                for (int w = 0; w < 8; ++w) v += red[(w * 16 + mb) * 17 + cc];
                C2[mb * DFF + id * 16 + cc] = v; }
            __syncthreads();
        }
    }
    {
        const int rpw = (MROWS + NGW - 1) / NGW; const int row0 = gw * rpw; const int rend = (row0 + rpw) < MROWS ? (row0 + rpw) : MROWS;
        int lane = F.lane; asm volatile("" : "+v"(lane));
        f32x4 v[8], vn[8], gsv[8], bv[8]; int cmb = -1;
        if (row0 < rend) { const float* xr = (row0 < NPROMPT ? F.inp[0] + (size_t)row0 * DM : F.inp[1] + (size_t)(row0 - NPROMPT) * DM) + 8 * lane;
#pragma unroll
            for (int j = 0; j < 4; ++j) { v[2 * j] = __builtin_nontemporal_load((const f32x4*)(xr + 512 * j)); v[2 * j + 1] = __builtin_nontemporal_load((const f32x4*)(xr + 512 * j + 4)); } }
        for (int row = row0; row < rend; ++row) {
            const int nrow = row + 1;
            if (nrow < rend) { const float* xr = (nrow < NPROMPT ? F.inp[0] + (size_t)nrow * DM : F.inp[1] + (size_t)(nrow - NPROMPT) * DM) + 8 * lane;
#pragma unroll
                for (int j = 0; j < 4; ++j) { vn[2 * j] = __builtin_nontemporal_load((const f32x4*)(xr + 512 * j)); vn[2 * j + 1] = __builtin_nontemporal_load((const f32x4*)(xr + 512 * j + 4)); } }
            const int mb = row < NPROMPT ? 0 : 1 + ((row - NPROMPT) >> 10);
            if (mb != cmb) { cmb = mb; const float* sh1 = MOD + mb * NMOD + 8 * lane; const float* sc1 = sh1 + DM; const float* n1 = norm1 + 8 * lane;
#pragma unroll
                for (int j = 0; j < 8; ++j) { const int k = 512 * (j >> 1) + 4 * (j & 1); const f32x4 g = *(const f32x4*)(n1 + k), s_ = *(const f32x4*)(sc1 + k); gsv[j] = g * (s_ + 1.0f); bv[j] = *(const f32x4*)(sh1 + k); } }
            float ss = 0.f;
#pragma unroll
            for (int j = 0; j < 8; ++j) ss += (v[j][0] * v[j][0] + v[j][1] * v[j][1]) + (v[j][2] * v[j][2] + v[j][3] * v[j][3]);
            const float rstd = rsqrtf(wsum64(ss) * (1.0f / DM) + EPS);
            bf16* xo = XN + (size_t)row * DM + 8 * lane;
#pragma unroll
            for (int j = 0; j < 4; ++j) { const f32x4 o0 = v[2 * j] * rstd * gsv[2 * j] + bv[2 * j], o1 = v[2 * j + 1] * rstd * gsv[2 * j + 1] + bv[2 * j + 1];
                v4u w; w.x = cvtpk(o0[0], o0[1]); w.y = cvtpk(o0[2], o0[3]); w.z = cvtpk(o1[0], o1[1]); w.w = cvtpk(o1[2], o1[3]); *(GAS v4u*)(xo + 512 * j) = w; }
#pragma unroll
            for (int j = 0; j < 8; ++j) v[j] = vn[j];
        }
    }
}
__device__ __forceinline__ void p2_ab(Frame& F) {
    const bf16* XN = (const bf16*)(F.ws + WS_XN); const bf16* Wab = (const bf16*)(F.ws + WS_WIN) + (size_t)28 * 32 * 16384;   float* AB = (float*)(F.ws + WS_AB);
    const int r32 = F.lane & 31, hi = F.lane >> 5;
    LAS float* red = (LAS float*)F.lds;
    for (int rb = F.vcu; rb < MROWS / 32; rb += F.G) {
        const bf16* ap = XN + (size_t)(rb * 32 + r32) * DM + 256 * F.wave + 8 * hi; const bf16* bp = Wab + (size_t)(4 * F.wave) * 16384; const int bri = pg8::perm32inv(r32);
        f32x16 acc = {};
#pragma unroll
        for (int s_ = 0; s_ < 16; ++s_) { const bf16x8 a = *(const bf16x8*)(ap + 16 * s_), b = *(const bf16x8*)(bp + (s_ >> 2) * 16384 + (pg8::lds_byte(bri, 16 * (s_ & 3) + 8 * hi) >> 1)); acc = __builtin_amdgcn_mfma_f32_32x32x16_bf16(a, b, acc, 0, 0, 0); }
#pragma unroll
        for (int r = 0; r < 16; ++r) red[(F.wave * 32 + crow(r, hi)) * 33 + r32] = acc[r];
        __syncthreads();
        for (int o = F.tid; o < 1024; o += 512) { const int row = o >> 5, col = o & 31; float v = 0.f;
#pragma unroll
            for (int w = 0; w < 8; ++w) v += red[(w * 32 + row) * 33 + col];
            AB[(size_t)(rb * 32 + row) * 32 + col] = v; }
        __syncthreads();
    }
}
namespace dattn {
using bf16x8 = __attribute__((ext_vector_type(8))) short;
using u32x4 = __attribute__((ext_vector_type(4))) unsigned;
using u32x2_t = __attribute__((ext_vector_type(2))) unsigned;
template <int CTRL> __device__ __forceinline__ float adpp(float v) { return __builtin_bit_cast(float, __builtin_amdgcn_update_dpp(0, __builtin_bit_cast(int, v), CTRL, 0xf, 0xf, true)); }
constexpr int KVBLK = 64; constexpr float SCALE = 0.125f; constexpr float THR = 8.f;
constexpr int SHM_V = 64 * 128 * 2, SHM_K = 64 * 128 * 2;
#define KSWZ(row, colB) ((row) * 256 + ((colB) ^ (((row) & 7) << 4)))
#define SBAR() __builtin_amdgcn_sched_barrier(0)
__device__ __forceinline__ void partialSM(f32x16& p0, f32x16& p1, float& m_reg, float& mn, float& alpha) {
  constexpr float C = SCALE * 1.4426950408889634f;
  float pmax = p0[0];
#pragma unroll
  for (int r = 1; r < 16; ++r) pmax = fmaxf(pmax, p0[r]);
#pragma unroll
  for (int r = 0; r < 16; ++r) pmax = fmaxf(pmax, p1[r]);
  { auto rr = __builtin_amdgcn_permlane32_swap(__float_as_uint(pmax), __float_as_uint(pmax), false, false);
    pmax = fmaxf(__uint_as_float(rr[0]), __uint_as_float(rr[1])); }
  if (__builtin_expect(__all(pmax - m_reg <= THR / SCALE), 1)) { mn = m_reg; alpha = 1.f; }
  else { mn = fmaxf(m_reg, pmax); alpha = __builtin_amdgcn_exp2f((m_reg - mn) * C); m_reg = mn; }
  float mnC = -mn * C;
#pragma unroll
  for (int r = 0; r < 16; ++r) p0[r] = fmaf(p0[r], C, mnC);
#pragma unroll
  for (int r = 0; r < 16; ++r) p1[r] = fmaf(p1[r], C, mnC);
#pragma unroll
  for (int r = 0; r < 16; ++r) p0[r] = __builtin_amdgcn_exp2f(p0[r]);
}
__device__ __forceinline__ void finishSM(f32x16& p0, f32x16& p1, float alpha, float& l_reg, bf16x8& pa0, bf16x8& pa1, bf16x8& pa2, bf16x8& pa3) {
#pragma unroll
  for (int r = 0; r < 16; ++r) p1[r] = __builtin_amdgcn_exp2f(p1[r]);
  float ps = 0;
#pragma unroll
  for (int r = 0; r < 16; ++r) ps += p0[r];
#pragma unroll
  for (int r = 0; r < 16; ++r) ps += p1[r];
  { auto rr = __builtin_amdgcn_permlane32_swap(__float_as_uint(ps), __float_as_uint(ps), false, false);
    ps = __uint_as_float(rr[0]) + __uint_as_float(rr[1]); }
  l_reg = l_reg * alpha + ps;
#define PK4(P, BASE, OUT) do { unsigned a0 = cvtpk(P[BASE + 0], P[BASE + 1]), a1 = cvtpk(P[BASE + 2], P[BASE + 3]);   \
    unsigned b0 = cvtpk(P[BASE + 4], P[BASE + 5]), b1 = cvtpk(P[BASE + 6], P[BASE + 7]);                              \
    auto r0 = __builtin_amdgcn_permlane32_swap(a0, b0, false, false); auto r1 = __builtin_amdgcn_permlane32_swap(a1, b1, false, false); \
    u32x4 w = {r0[0], r1[0], r0[1], r1[1]}; OUT = *reinterpret_cast<bf16x8*>(&w); } while (0)
  PK4(p0, 0, pa0); PK4(p0, 8, pa1); PK4(p1, 0, pa2); PK4(p1, 8, pa3);
#undef PK4
}
__device__ __forceinline__ void qkt(f32x16& p0, f32x16& p1, const bf16* Ks, const bf16x8* qr, int r32, int hi, int map) {
  p0 = f32x16{}; p1 = f32x16{};
#pragma unroll
  for (int d0 = 0; d0 < 4; ++d0) { int cb = (map * 64 + d0 * 16 + hi * 8) * 2;
    bf16x8 b0 = *reinterpret_cast<const bf16x8*>((const char*)Ks + KSWZ(r32, cb));
    bf16x8 b1 = *reinterpret_cast<const bf16x8*>((const char*)Ks + KSWZ(32 + r32, cb));
    p0 = __builtin_amdgcn_mfma_f32_32x32x16_bf16(b0, qr[d0], p0, 0, 0, 0);
    p1 = __builtin_amdgcn_mfma_f32_32x32x16_bf16(b1, qr[d0], p1, 0, 0, 0); }
}
__device__ __forceinline__ int v_st(int k, int c) { const int kk = (k & ~0xC) | ((k & 4) << 1) | ((k & 8) >> 1); return ((kk >> 3) * 4 + (c >> 5)) * 512 + ((kk & 7) * 32 + (c & 31)) * 2; }
__device__ __forceinline__ int v_rd_base(int lane) { return ((lane & 3) << 3) | (((lane >> 2) & 3) << 6) | (((lane >> 4) & 1) << 5) | (((lane >> 5) & 1) << 8); }
constexpr int v_rd_off(int d0, int ks, int half) { return d0 * 512 + ks * 4096 + half * 2048; }
template <int OFF> __device__ __forceinline__ s16x4 tr_read(int vb) {
  s16x4 r; asm volatile("ds_read_b64_tr_b16 %0, %1 offset:%2" : "=&v"(r) : "v"(vb), "i"(OFF) : "memory"); return r;
}
template <int D0> __device__ __forceinline__ void pv_one(f32x16& od, int vb, bf16x8 pa0, bf16x8 pa1, bf16x8 pa2, bf16x8 pa3) {
  const s16x4 l0 = tr_read<v_rd_off(D0, 0, 0)>(vb), h0 = tr_read<v_rd_off(D0, 0, 1)>(vb), l1 = tr_read<v_rd_off(D0, 1, 0)>(vb), h1 = tr_read<v_rd_off(D0, 1, 1)>(vb);
  const s16x4 l2 = tr_read<v_rd_off(D0, 2, 0)>(vb), h2 = tr_read<v_rd_off(D0, 2, 1)>(vb), l3 = tr_read<v_rd_off(D0, 3, 0)>(vb), h3 = tr_read<v_rd_off(D0, 3, 1)>(vb);
  asm volatile("s_waitcnt lgkmcnt(0)" ::: "memory"); SBAR();
#define PK(L, H) (bf16x8){L[0], L[1], L[2], L[3], H[0], H[1], H[2], H[3]}
  od = __builtin_amdgcn_mfma_f32_32x32x16_bf16(pa0, PK(l0, h0), od, 0, 0, 0);
  od = __builtin_amdgcn_mfma_f32_32x32x16_bf16(pa1, PK(l1, h1), od, 0, 0, 0);
  od = __builtin_amdgcn_mfma_f32_32x32x16_bf16(pa2, PK(l2, h2), od, 0, 0, 0);
  od = __builtin_amdgcn_mfma_f32_32x32x16_bf16(pa3, PK(l3, h3), od, 0, 0, 0);
#undef PK
}
__device__ __forceinline__ void pv_d0(f32x16* o, int vb, bf16x8 pa0, bf16x8 pa1, bf16x8 pa2, bf16x8 pa3) {
  pv_one<0>(o[0], vb, pa0, pa1, pa2, pa3); pv_one<1>(o[1], vb, pa0, pa1, pa2, pa3); pv_one<2>(o[2], vb, pa0, pa1, pa2, pa3); pv_one<3>(o[3], vb, pa0, pa1, pa2, pa3);
}
__device__ __forceinline__ void attn_unit(const bf16* __restrict__ Qb, const bf16* __restrict__ Kh, const bf16* __restrict__ Vh, bf16* __restrict__ Ob, int seq, float lam, const float* __restrict__ subln, char* lds) {
  constexpr int LDQ = 1024, LDK = 128;
  const int tid = threadIdx.x, wid = tid >> 6, lane = tid & 63, r32 = lane & 31, hi = lane >> 5;
  const int map = wid >> 2, qw = wid & 3;
  bf16* V_lds = (bf16*)lds; bf16* K_lds = (bf16*)(lds + 2 * SHM_V);
  float* ws = (float*)(lds + 2 * SHM_V + 2 * SHM_K) + wid * 64; float* li_l = ws; float* al_l = ws + 32;
  float m_reg = -1e30f, l_reg = 0; f32x16 o[4] = {}; bf16x8 qr[4];
  const bf16* Qw = Qb + (long)(qw * 32 + r32) * LDQ + map * 64 + hi * 8;
#pragma unroll
  for (int d0 = 0; d0 < 4; ++d0) qr[d0] = *reinterpret_cast<const bf16x8*>(Qw + d0 * 16);
  const int sr = tid >> 4, sc = (tid & 15) * 8, vst0 = v_st(sr, sc), vst1 = v_st(32 + sr, sc);
  const int vb0 = (int)(uintptr_t)V_lds + v_rd_base(lane);
  struct { bf16x8 vs0, vs1, ks0, ks1; } sr_[2];
#define LD8(p) (*reinterpret_cast<const bf16x8*>(p))
#define SLOAD(i, k0) do { sr_[i].vs0 = LD8(&Vh[(long)((k0) + sr) * LDK + sc]); sr_[i].vs1 = LD8(&Vh[(long)((k0) + 32 + sr) * LDK + sc]); \
    sr_[i].ks0 = LD8(&Kh[(long)((k0) + sr) * LDK + sc]); sr_[i].ks1 = LD8(&Kh[(long)((k0) + 32 + sr) * LDK + sc]); } while (0)
#define SWRITE(b, i) do { *(bf16x8*)((char*)V_lds + (b) * SHM_V + vst0) = sr_[i].vs0;          \
    *(bf16x8*)((char*)V_lds + (b) * SHM_V + vst1) = sr_[i].vs1; int kc = sc * 2;               \
    *(bf16x8*)((char*)K_lds + (b) * SHM_K + KSWZ(sr, kc)) = sr_[i].ks0;                       \
    *(bf16x8*)((char*)K_lds + (b) * SHM_K + KSWZ(32 + sr, kc)) = sr_[i].ks1; } while (0)
#define SWAIT() asm volatile("s_waitcnt vmcnt(4)" ::: "memory")
#define RESC(a) do { if (__any((a) < 1.f)) { if (hi == 0) al_l[r32] = (a); asm volatile("s_waitcnt lgkmcnt(0)" ::: "memory"); \
    _Pragma("unroll") for (int d = 0; d < 4; ++d) _Pragma("unroll") for (int r = 0; r < 16; ++r) o[d][r] *= al_l[crow(r, hi)]; } } while (0)
  f32x16 pA0, pA1, pB0, pB1; float mnA, mnB, alA, alB; bf16x8 pa0, pa1, pa2, pa3; const int NT = seq / KVBLK;
  constexpr int SE = 0, SO = 1;
  SLOAD(SE, 0); SLOAD(SO, KVBLK);
  asm volatile("s_waitcnt vmcnt(4)" ::: "memory"); SWRITE(0, SE); __syncthreads();
  qkt(pA0, pA1, K_lds, qr, r32, hi, map); partialSM(pA0, pA1, m_reg, mnA, alA);
  if (2 < NT) SLOAD(SE, 2 * KVBLK);
  SWAIT(); SWRITE(1, SO); __syncthreads();
  for (int j = 1; j + 1 < NT; j += 2) {
    SBAR(); qkt(pB0, pB1, (bf16*)((char*)K_lds + SHM_K), qr, r32, hi, map);
    finishSM(pA0, pA1, alA, l_reg, pa0, pa1, pa2, pa3); SBAR();
    SLOAD(SO, (j + 2) * KVBLK); SBAR();
    pv_d0(o, vb0, pa0, pa1, pa2, pa3); partialSM(pB0, pB1, m_reg, mnB, alB);
    __syncthreads(); SWAIT(); SWRITE(0, SE);
    RESC(alB); __syncthreads();
    SBAR(); qkt(pA0, pA1, K_lds, qr, r32, hi, map);
    finishSM(pB0, pB1, alB, l_reg, pa0, pa1, pa2, pa3); SBAR();
    if (j + 3 < NT) SLOAD(SE, (j + 3) * KVBLK); SBAR();
    pv_d0(o, vb0 + (int)SHM_V, pa0, pa1, pa2, pa3); partialSM(pA0, pA1, m_reg, mnA, alA);
    __syncthreads(); SWAIT(); SWRITE(1, SO);
    RESC(alA); __syncthreads();
  }
  SBAR(); qkt(pB0, pB1, (bf16*)((char*)K_lds + SHM_K), qr, r32, hi, map);
  finishSM(pA0, pA1, alA, l_reg, pa0, pa1, pa2, pa3); SBAR();
  pv_d0(o, vb0, pa0, pa1, pa2, pa3); partialSM(pB0, pB1, m_reg, mnB, alB);
  __syncthreads(); RESC(alB);
  finishSM(pB0, pB1, alB, l_reg, pa0, pa1, pa2, pa3); SBAR();
  pv_d0(o, vb0 + (int)SHM_V, pa0, pa1, pa2, pa3);
  if (hi == 0) li_l[r32] = l_reg; asm volatile("s_waitcnt lgkmcnt(0)" ::: "memory");
  float rli[16];
#pragma unroll
  for (int r = 0; r < 16; ++r) rli[r] = __builtin_amdgcn_rcpf(li_l[crow(r, hi)]);
  __syncthreads();
  int r32e = r32, hie = hi; asm volatile("" : "+v"(r32e), "+v"(hie));
  float* X = (float*)lds;
  char* otile = lds + 73728 + qw * 8448;
  if (map == 1) {
#pragma unroll
    for (int r = 0; r < 16; ++r)
#pragma unroll
      for (int d0 = 0; d0 < 4; ++d0) X[(qw * 32 + crow(r, hie)) * 128 + d0 * 32 + r32e] = o[d0][r] * rli[r];
  }
  __syncthreads();
  if (map == 0) {
    float sw[4];
#pragma unroll
    for (int d0 = 0; d0 < 4; ++d0) sw[d0] = subln[d0 * 32 + r32e] * 0.8f;
#pragma unroll
    for (int r = 0; r < 16; ++r) { float val[4]; float ss = 0.f;
#pragma unroll
      for (int d0 = 0; d0 < 4; ++d0) { val[d0] = o[d0][r] * rli[r] - lam * X[(qw * 32 + crow(r, hie)) * 128 + d0 * 32 + r32e]; ss += val[d0] * val[d0]; }
      ss += adpp<0xB1>(ss); ss += adpp<0x4E>(ss); ss += adpp<0x141>(ss); ss += adpp<0x140>(ss);
      { const auto pr_ = __builtin_amdgcn_permlane16_swap(__float_as_uint(ss), __float_as_uint(ss), false, false); const unsigned p0_ = pr_[0], p1_ = pr_[1]; ss = __uint_as_float(p0_) + __uint_as_float(p1_); }
      const float rs = rsqrtf(ss * (1.0f / 128.0f) + 1e-6f);
#pragma unroll
      for (int d0 = 0; d0 < 4; ++d0) *(unsigned short*)(otile + crow(r, hie) * 264 + 2 * (d0 * 32 + r32e)) = (unsigned short)(cvtpk(val[d0] * rs * sw[d0], 0.f) & 0xffffu); }
    int lane_e = lane; asm volatile("" : "+v"(lane_e));
#pragma unroll
    for (int j = 0; j < 8; ++j) { const int p_ = lane_e + 64 * j, row_ = p_ >> 4, pc_ = p_ & 15; const char* sp_ = otile + row_ * 264 + 16 * pc_;
      const u32x2_t lo_ = *(const u32x2_t*)sp_, hi_ = *(const u32x2_t*)(sp_ + 8); u32x4 w_; w_.x = lo_.x; w_.y = lo_.y; w_.z = hi_.x; w_.w = hi_.y;
      *(u32x4*)((unsigned short*)Ob + (pc_ >> 3) * 16384 + (pg8::lds_byte(qw * 32 + row_, 8 * (pc_ & 7)) >> 1)) = w_; }
  }
  __syncthreads();
#undef LD8
#undef SLOAD
#undef SWRITE
#undef SWAIT
#undef RESC
}
#undef KSWZ
#undef SBAR
}

template <int CTRL> __device__ __forceinline__ float dppf(float v) { return __builtin_bit_cast(float, __builtin_amdgcn_update_dpp(0, __builtin_bit_cast(int, v), CTRL, 0xf, 0xf, true)); }
__device__ __forceinline__ float wave_sum_dpp(float v) {
    v += dppf<0xB1>(v); v += dppf<0x4E>(v); v += dppf<0x141>(v); v += dppf<0x140>(v);
    const int b = __builtin_bit_cast(int, v);
    return __builtin_bit_cast(float, __builtin_amdgcn_readlane(b, 0)) + __builtin_bit_cast(float, __builtin_amdgcn_readlane(b, 16)) + __builtin_bit_cast(float, __builtin_amdgcn_readlane(b, 32)) + __builtin_bit_cast(float, __builtin_amdgcn_readlane(b, 48));
}
namespace gdn {
using bf16x8 = __attribute__((ext_vector_type(8))) short;
constexpr int TS = 272;
constexpr int OFF_Q = 0, OFF_K = 64 * TS, OFF_V = 2 * 64 * TS, OFF_KK = 3 * 64 * TS, OFF_QK = OFF_KK + 64 * 65 * 4, OFF_L = OFF_QK + 64 * 65 * 4, LSTR = 68,
              OFF_VEC = OFF_L + 2 * 64 * LSTR * 4,
              OFF_D = OFF_KK, DSTR = 20;
static_assert(8 * 16 * DSTR * 4 <= 64 * 65 * 4 && OFF_VEC + 6 * 64 * 4 <= 131072, "gdn lds");
__device__ __forceinline__ void seq_info(int s, int& rowbase, int& L) { if (s < 16) { rowbase = s * 256; L = 256; } else { rowbase = NPROMPT + (s - 16) * 1024; L = 1024; } }
__device__ __forceinline__ int chunk_id(int s, int h, int c) { return s < 16 ? ((s * 8 + h) * 4 + c) : 512 + (((s - 16) * 8 + h) * 16 + c); }

__device__ __forceinline__ void cl_load(Frame& F, int s, int h, int c, unsigned (&raw)[3][12], float (&abv)[2]) {
    const bf16* QKVB = (const bf16*)(F.ws + WS_QKVB); const float* AB = (const float*)(F.ws + WS_AB);
    int rowbase, L; seq_info(s, rowbase, L);
    int lane = F.lane; asm volatile("" : "+v"(lane)); const int wid = F.wave; const int tok0 = 8 * wid;
    const bf16* rp = QKVB + ((long)(rowbase + c * 64 + tok0) - 2) * 3072 + h * 128 + 2 * lane;
#pragma unroll
    for (int j = 0; j < 12; ++j) { const int t = c * 64 + tok0 - 2 + j; const bool ok = (t >= 0) && (t < L);
#pragma unroll
        for (int x = 0; x < 3; ++x) raw[x][j] = ok ? *(const GAS unsigned*)(rp + x * 1024) : 0u;
        rp += 3072; asm volatile("" : "+v"(rp)); }
    abv[0] = 0.f; abv[1] = 0.f;
    if (wid < 2) { const size_t row = (size_t)rowbase + c * 64 + lane; abv[0] = *(const GAS float*)(AB + row * 32 + wid * 8 + h); abv[1] = *(const GAS float*)(AB + row * 32 + 16 + wid * 8 + h); }
}
__device__ __forceinline__ void chunk_local(Frame& F, int s, int h, int c, unsigned (&raw)[3][12], float (&abv)[2], bool has_next, int ns, int nh, int nc) {
    const bf16* QKVB = (const bf16*)(F.ws + WS_QKVB); const float* AB = (const float*)(F.ws + WS_AB);
    const float* conv_w = F.inp[11]; const float* a_log = F.inp[12]; const float* dt_bias = F.inp[13];
    bf16* QHAT = (bf16*)(F.ws + WS_QHAT); bf16* KHT = (bf16*)(F.ws + WS_KHT); bf16* NWg = (bf16*)(F.ws + WS_NW); bf16* Ug = (bf16*)(F.ws + WS_U); bf16* INTRA = (bf16*)(F.ws + WS_INTRA);
    float* EVEC = (float*)(F.ws + WS_EVEC);
    int rowbase, L; seq_info(s, rowbase, L); const int cid = chunk_id(s, h, c);
    int tid = F.tid, lane = F.lane; const int wid = F.wave; asm volatile("" : "+v"(tid), "+v"(lane));
    LAS unsigned char* lds = F.lds;
    LAS float* vec = (LAS float*)(lds + OFF_VEC);
    {
        const int tok0 = 8 * wid;
        float cw[3][5][2];
#pragma unroll
        for (int x = 0; x < 3; ++x)
#pragma unroll
            for (int j = 0; j < 5; ++j) { const float* p = conv_w + j * 3072 + x * 1024 + h * 128 + 2 * lane; cw[x][j][0] = p[0]; cw[x][j][1] = p[1]; }
        unsigned kt[2][4];
        float val[8][3][2]; float sv[16];
#pragma unroll
        for (int tt = 0; tt < 8; ++tt) {
#pragma unroll
            for (int x = 0; x < 3; ++x) { pg8::f32x2 a2 = {0.f, 0.f};
#pragma unroll
                for (int j = 0; j < 5; ++j) { const pg8::f32x2 w2_ = {cw[x][j][0], cw[x][j][1]}; const pg8::f32x2 r2_ = {bflo(raw[x][tt + j]), bfhi(raw[x][tt + j])}; a2 = __builtin_elementwise_fma(w2_, r2_, a2); }
                val[tt][x][0] = silu_f(a2.x); val[tt][x][1] = silu_f(a2.y); }
            sv[tt] = val[tt][0][0] * val[tt][0][0] + val[tt][0][1] * val[tt][0][1];
            sv[8 + tt] = val[tt][1][0] * val[tt][1][0] + val[tt][1][1] * val[tt][1][1];
        }
        float tot[16];
        {
            float w8[8], u4[4];
#pragma unroll
            for (int i = 0; i < 8; ++i) { const auto r = __builtin_amdgcn_permlane32_swap(__builtin_bit_cast(unsigned, sv[i]), __builtin_bit_cast(unsigned, sv[i + 8]), false, false);
                const unsigned r0 = r[0], r1 = r[1]; w8[i] = __builtin_bit_cast(float, r0) + __builtin_bit_cast(float, r1); }
#pragma unroll
            for (int i = 0; i < 4; ++i) { const auto r = __builtin_amdgcn_permlane16_swap(__builtin_bit_cast(unsigned, w8[i]), __builtin_bit_cast(unsigned, w8[i + 4]), false, false);
                const unsigned r0 = r[0], r1 = r[1]; float v = __builtin_bit_cast(float, r0) + __builtin_bit_cast(float, r1);
                v += dppf<0xB1>(v); v += dppf<0x4E>(v); v += dppf<0x141>(v); v += dppf<0x140>(v); u4[i] = v; }
#pragma unroll
            for (int r = 0; r < 4; ++r)
#pragma unroll
                for (int i = 0; i < 4; ++i) tot[i + 4 * (r & 1) + 8 * (r >> 1)] = __builtin_bit_cast(float, __builtin_amdgcn_readlane(__builtin_bit_cast(int, u4[i]), 16 * r));
        }
#pragma unroll
        for (int tt = 0; tt < 8; ++tt) {
            const float rq = rsqrtf(tot[tt] + EPS) * 0.08838834764831845f, rk = rsqrtf(tot[8 + tt] + EPS);
            const unsigned qw_ = cvtpk(val[tt][0][0] * rq, val[tt][0][1] * rq), kw_ = cvtpk(val[tt][1][0] * rk, val[tt][1][1] * rk), vw_ = cvtpk(val[tt][2][0], val[tt][2][1]);
            const int tok = tok0 + tt;
            *(LAS unsigned*)(lds + OFF_Q + tok * TS + 4 * lane) = qw_;
            *(LAS unsigned*)(lds + OFF_K + tok * TS + 4 * lane) = kw_;
            *(LAS unsigned*)(lds + OFF_V + tok * TS + 4 * lane) = vw_;
            *(unsigned*)(QHAT + ((size_t)cid * 64 + tok) * 128 + 2 * lane) = qw_;
            if (tt & 1) { kt[0][tt >> 1] |= (kw_ << 16); kt[1][tt >> 1] |= (kw_ & 0xffff0000u); } else { kt[0][tt >> 1] = kw_ & 0xffffu; kt[1][tt >> 1] = kw_ >> 16; }
        }
#pragma unroll
        for (int e = 0; e < 2; ++e) { v4u w; w.x = kt[e][0]; w.y = kt[e][1]; w.z = kt[e][2]; w.w = kt[e][3];
            *(GAS v4u*)(KHT + ((size_t)cid * 128 + 2 * lane + e) * 64 + tok0) = w; }
    }
    if (wid < 2) {
        const int dir = wid, tok = lane; const size_t row = (size_t)rowbase + c * 64 + tok;
        const float a = abv[0], b = abv[1];
        const float xs = a + dt_bias[dir * 8 + h];
        const float sp = xs > 20.f ? xs : log1pf(__expf(xs));
        const float g = -__expf(a_log[dir * 8 + h]) * sp;
        const float beta = 1.0f / (1.0f + __expf(-b));
        float G = g;
        if (dir == 0) {
#pragma unroll
            for (int o = 1; o < 64; o <<= 1) { const float t = __shfl_up(G, o); if (lane >= o) G += t; }
        } else {
#pragma unroll
            for (int o = 1; o < 64; o <<= 1) { const float t = __shfl_down(G, o); if (lane + o < 64) G += t; }
        }
        const float gl = __shfl(G, dir == 0 ? 63 : 0);
        const float eG = __expf(G);
        vec[dir * 64 + tok] = beta; vec[128 + dir * 64 + tok] = G; vec[256 + dir * 64 + tok] = beta * eG;
        float* ev = EVEC + ((size_t)cid * 2 + dir) * 192;
        ev[tok] = eG; ev[64 + tok] = __expf(gl - G); if (lane == 0) ev[128] = __expf(gl);
    }
    if (has_next) cl_load(F, ns, nh, nc, raw, abv);
    LBAR();
    {
        const int r32 = lane & 31, hi = lane >> 5; const int mat = wid >> 2, bi = (wid >> 1) & 1, bj = wid & 1;
        const LAS unsigned char* ap = lds + (mat ? OFF_Q : OFF_K) + (32 * bi + r32) * TS + 16 * hi;
        const LAS unsigned char* bp = lds + OFF_K + (32 * bj + r32) * TS + 16 * hi;
        f32x16 acc = {};
#pragma unroll
        for (int st = 0; st < 8; ++st) { const bf16x8 a = *(const LAS bf16x8*)(ap + 32 * st), b = *(const LAS bf16x8*)(bp + 32 * st); acc = __builtin_amdgcn_mfma_f32_32x32x16_bf16(a, b, acc, 0, 0, 0); }
        LAS float* dst = (LAS float*)(lds + (mat ? OFF_QK : OFF_KK));
#pragma unroll
        for (int r = 0; r < 16; ++r) dst[(32 * bi + crow(r, hi)) * 65 + 32 * bj + r32] = acc[r];
    }
    LBAR();
    {
        const int dir = tid >> 8, i = (tid >> 2) & 63, j0 = (tid & 3) * 16;
        const LAS float* KKm = (const LAS float*)(lds + OFF_KK); const LAS float* QKm = (const LAS float*)(lds + OFF_QK);
        LAS float* Lm = (LAS float*)(lds + OFF_L) + dir * 64 * LSTR;
        const float bi_ = vec[dir * 64 + i], Gi = vec[128 + dir * 64 + i];
        unsigned iw[8];
#pragma unroll
        for (int jj = 0; jj < 16; ++jj) { const int j = j0 + jj; const float Gj = vec[128 + dir * 64 + j];
            const bool strict = dir ? (j > i) : (j < i); const bool incl = strict || (j == i);
            const float dec = incl ? __expf(Gi - Gj) : 0.f;
            const float lv = strict ? bi_ * KKm[i * 65 + j] * dec : 0.f;
            const float iv = QKm[i * 65 + j] * dec;
            if (dir) Lm[(63 - i) * LSTR + (63 - j)] = lv; else Lm[i * LSTR + j] = lv;
            const unsigned short bv = (unsigned short)(cvtpk(iv, 0.f) & 0xffffu);
            if (jj & 1) iw[jj >> 1] |= ((unsigned)bv << 16); else iw[jj >> 1] = bv; }
        bf16* ip = INTRA + (((size_t)cid * 2 + dir) * 64 + i) * 64 + j0;
        v4u w0, w1; w0.x = iw[0]; w0.y = iw[1]; w0.z = iw[2]; w0.w = iw[3]; w1.x = iw[4]; w1.y = iw[5]; w1.z = iw[6]; w1.w = iw[7];
        *(GAS v4u*)ip = w0; *(GAS v4u*)(ip + 8) = w1;
    }
    LBAR();
    if (tid < 128) {
        const int dir = tid >> 6, b = (tid >> 4) & 3, cidx = tid & 15;
        const LAS float* Lb = (const LAS float*)(lds + OFF_L) + dir * 64 * LSTR + (16 * b) * LSTR + 16 * b;
        LAS float* Dm = (LAS float*)(lds + OFF_D) + (dir * 4 + b) * 16 * DSTR;
        float d[16];
#pragma unroll
        for (int i = 0; i < 16; ++i) { float a = (i == cidx) ? 1.f : 0.f;
#pragma unroll
            for (int j = 0; j < i; ++j) a -= Lb[i * LSTR + j] * d[j];
            d[i] = a; Dm[i * DSTR + cidx] = a; }
    }
    LBAR();
    {
        const int dir = wid >> 2, wq = wid & 3; const bool isK = wq >= 2; const int cb = (wq & 1) * 64;
        const int n = lane & 15, g = lane >> 4;
        const LAS float* Lm = (const LAS float*)(lds + OFF_L) + dir * 64 * LSTR;
        const LAS float* Dall = (const LAS float*)(lds + OFF_D) + dir * 4 * 16 * DSTR;
        const LAS unsigned char* tile = lds + (isK ? OFF_K : OFF_V);
        const LAS float* scl = vec + (isK ? 256 : 0) + dir * 64;
        bf16* og = (isK ? NWg : Ug) + ((size_t)cid * 2 + dir) * 64 * 128;
        const float sgn = isK ? -1.f : 1.f;
        LAS unsigned char* stg = lds + OFF_Q + wid * 2176;
        u32x2 Xf[3][4];
#pragma unroll
        for (int b = 0; b < 4; ++b) {
            f32x4 R[4];
#pragma unroll
            for (int r = 0; r < 4; ++r) { const int p = 16 * b + 4 * g + r; const int tok = dir ? 63 - p : p; const float sc_ = scl[tok];
#pragma unroll
                for (int nt = 0; nt < 4; ++nt) R[nt][r] = bf2f(*(const LAS unsigned short*)(tile + tok * TS + 2 * (cb + 16 * nt + n))) * sc_; }
#pragma unroll
            for (int pr = 0; pr < 2; ++pr) if (2 * pr < b) {
                const int a0 = 2 * pr, a1 = 2 * pr + 1; const bool two = a1 < b;
                const f32x4 l0 = *(const LAS f32x4*)(Lm + (16 * b + n) * LSTR + 16 * a0 + 4 * g);
                f32x4 l1 = {0.f, 0.f, 0.f, 0.f}; if (two) l1 = *(const LAS f32x4*)(Lm + (16 * b + n) * LSTR + 16 * a1 + 4 * g);
                v4u aw; aw.x = cvtpk(-l0[0], -l0[1]); aw.y = cvtpk(-l0[2], -l0[3]); aw.z = cvtpk(-l1[0], -l1[1]); aw.w = cvtpk(-l1[2], -l1[3]);
                const bf16x8 af = __builtin_bit_cast(bf16x8, aw);
#pragma unroll
                for (int nt = 0; nt < 4; ++nt) { v4u bw; bw.x = Xf[a0][nt].x; bw.y = Xf[a0][nt].y; bw.z = two ? Xf[a1 < 3 ? a1 : 2][nt].x : 0u; bw.w = two ? Xf[a1 < 3 ? a1 : 2][nt].y : 0u;
                    R[nt] = __builtin_amdgcn_mfma_f32_16x16x32_bf16(af, __builtin_bit_cast(bf16x8, bw), R[nt], 0, 0, 0); }
            }
            const f32x4 df = *(const LAS f32x4*)(Dall + b * 16 * DSTR + n * DSTR + 4 * g);
            v4u dw; dw.x = cvtpk(df[0], df[1]); dw.y = cvtpk(df[2], df[3]); dw.z = 0u; dw.w = 0u;
            const bf16x8 dfr = __builtin_bit_cast(bf16x8, dw);
#pragma unroll
            for (int nt = 0; nt < 4; ++nt) {
                v4u rw; rw.x = cvtpk(R[nt][0], R[nt][1]); rw.y = cvtpk(R[nt][2], R[nt][3]); rw.z = 0u; rw.w = 0u;
                const f32x4 xb = __builtin_amdgcn_mfma_f32_16x16x32_bf16(dfr, __builtin_bit_cast(bf16x8, rw), (f32x4){0.f, 0.f, 0.f, 0.f}, 0, 0, 0);
                if (b < 3) { Xf[b][nt].x = cvtpk(xb[0], xb[1]); Xf[b][nt].y = cvtpk(xb[2], xb[3]); }
#pragma unroll
                for (int r = 0; r < 4; ++r) *(LAS unsigned short*)(stg + (4 * g + r) * 136 + 2 * (16 * nt + n)) = (unsigned short)(cvtpk(xb[r] * sgn, 0.f) & 0xffffu);
            }
            asm volatile("s_waitcnt lgkmcnt(0)" ::: "memory");
#pragma unroll
            for (int q = 0; q < 2; ++q) { const int piece = lane + 64 * q, lr = piece >> 3, ch = piece & 7; const int p = 16 * b + lr; const int tok = dir ? 63 - p : p;
                const u32x2 lo_ = *(const LAS u32x2*)(stg + lr * 136 + 16 * ch), hi_ = *(const LAS u32x2*)(stg + lr * 136 + 16 * ch + 8);
                v4u w; w.x = lo_.x; w.y = lo_.y; w.z = hi_.x; w.w = hi_.y;
                *(GAS v4u*)(og + tok * 128 + cb + 8 * ch) = w; }
            asm volatile("s_waitcnt lgkmcnt(0)" ::: "memory");
        }
    }
    LBAR();
}
}

namespace gscan {
using bf16x8 = __attribute__((ext_vector_type(8))) short;
constexpr int S128 = 264, S64 = 136;
constexpr int O_NW = 0, O_QH = 64 * S128, O_KHT = 2 * 64 * S128, O_IN = O_KHT + 128 * S64, O_EV = O_IN + 64 * S64, BUF = O_EV + 192 * 4;
static_assert(2 * BUF + 4 * 4608 <= 146432 && (BUF % 8) == 0, "scan lds");
__device__ __forceinline__ bf16x8 afrag(const LAS unsigned char* p) { const u32x2 a = *(const LAS u32x2*)p, b = *(const LAS u32x2*)(p + 16); v4u w; w.x = a.x; w.y = a.y; w.z = b.x; w.w = b.y; return __builtin_bit_cast(bf16x8, w); }
__device__ __forceinline__ bf16x8 pack8(const f32x16& v, int s) { v4u w; w.x = cvtpk(v[8 * s + 0], v[8 * s + 1]); w.y = cvtpk(v[8 * s + 2], v[8 * s + 3]); w.z = cvtpk(v[8 * s + 4], v[8 * s + 5]); w.w = cvtpk(v[8 * s + 6], v[8 * s + 7]); return __builtin_bit_cast(bf16x8, w); }

#define SC_LOAD(T0, T1, T2, T3, EV, cid_) do { const int cidl_ = (cid_); const size_t cid2l_ = (size_t)cidl_ * 2 + dir; \
    _Pragma("unroll") for (int i_ = 0; i_ < 4; ++i_) { const int q_ = lt + 256 * i_; T0[i_] = *(const GAS v4u*)(NWg + cid2l_ * 8192 + (size_t)q_ * 8); T1[i_] = *(const GAS v4u*)(QHAT + (size_t)cidl_ * 8192 + (size_t)q_ * 8); T2[i_] = *(const GAS v4u*)(KHT + (size_t)cidl_ * 8192 + (size_t)q_ * 8); } \
    _Pragma("unroll") for (int i_ = 0; i_ < 2; ++i_) { const int q_ = lt + 256 * i_; T3[i_] = *(const GAS v4u*)(INTRA + cid2l_ * 4096 + (size_t)q_ * 8); } \
    EV = 0.f; if (lt < 192) EV = EVEC[cid2l_ * 192 + lt]; } while (0)
#define SC_WRITE(T0, T1, T2, T3, EV, b_) do { LAS unsigned char* Bw_ = lds + (b_) * BUF; \
    _Pragma("unroll") for (int i_ = 0; i_ < 4; ++i_) { const int q_ = lt + 256 * i_; const int r128_ = q_ >> 4, c128_ = q_ & 15, r64_ = q_ >> 3, c64_ = q_ & 7; \
        LAS unsigned char* d0_ = Bw_ + O_NW + r128_ * S128 + c128_ * 16; *(LAS u32x2*)d0_ = (u32x2){T0[i_].x, T0[i_].y}; *(LAS u32x2*)(d0_ + 8) = (u32x2){T0[i_].z, T0[i_].w}; \
        LAS unsigned char* d1_ = Bw_ + O_QH + r128_ * S128 + c128_ * 16; *(LAS u32x2*)d1_ = (u32x2){T1[i_].x, T1[i_].y}; *(LAS u32x2*)(d1_ + 8) = (u32x2){T1[i_].z, T1[i_].w}; \
        LAS unsigned char* d2_ = Bw_ + O_KHT + r64_ * S64 + c64_ * 16;  *(LAS u32x2*)d2_ = (u32x2){T2[i_].x, T2[i_].y}; *(LAS u32x2*)(d2_ + 8) = (u32x2){T2[i_].z, T2[i_].w}; } \
    _Pragma("unroll") for (int i_ = 0; i_ < 2; ++i_) { const int q_ = lt + 256 * i_; const int r64_ = q_ >> 3, c64_ = q_ & 7; \
        LAS unsigned char* d3_ = Bw_ + O_IN + r64_ * S64 + c64_ * 16; *(LAS u32x2*)d3_ = (u32x2){T3[i_].x, T3[i_].y}; *(LAS u32x2*)(d3_ + 8) = (u32x2){T3[i_].z, T3[i_].w}; } \
    if (lt < 192) *(LAS float*)(Bw_ + O_EV + 4 * lt) = EV; } while (0)
#define SC_ULOAD(UR, cid_) do { const bf16* up_ = Ug + ((size_t)(cid_) * 2 + dir) * 8192 + (size_t)((lane >> 2) * 128 + n0 + 8 * (lane & 3)); \
    _Pragma("unroll") for (int q_ = 0; q_ < 4; ++q_) UR[q_] = *(const GAS v4u*)(up_ + q_ * 16 * 128); } while (0)
#define SC_STEP(UR, b_, c_) do { const LAS unsigned char* B = lds + (b_) * BUF; \
    const LAS float* ev = (const LAS float*)(B + O_EV); \
    f32x16 vn[2] = {f32x16{}, f32x16{}}, qs[2] = {f32x16{}, f32x16{}}; \
      \
      \
    const float egl = ev[128]; \
    bf16x8 fa[4], fb[4]; \
      \
    _Pragma("unroll") for (int ib = 0; ib < 2; ++ib) { fa[ib] = afrag(B + O_NW + (32 * ib + r32) * S128 + (4 * hi) * 2); fa[2 + ib] = afrag(B + O_QH + (32 * ib + r32) * S128 + (4 * hi) * 2); } \
    _Pragma("unroll") for (int it = 0; it < 8; ++it) { const int mb = it >> 1, st = it & 1; \
        if (it + 1 < 8) { const int koffn = (32 * ((it + 1) >> 1) + 16 * ((it + 1) & 1) + 4 * hi) * 2; \
            _Pragma("unroll") for (int ib = 0; ib < 2; ++ib) { fb[ib] = afrag(B + O_NW + (32 * ib + r32) * S128 + koffn); fb[2 + ib] = afrag(B + O_QH + (32 * ib + r32) * S128 + koffn); } } \
        const bf16x8 sb = pack8(S[mb], st); \
        __builtin_amdgcn_sched_barrier(0); \
        _Pragma("unroll") for (int ib = 0; ib < 2; ++ib) { vn[ib] = __builtin_amdgcn_mfma_f32_32x32x16_bf16(fa[ib], sb, vn[ib], 0, 0, 0); qs[ib] = __builtin_amdgcn_mfma_f32_32x32x16_bf16(fa[2 + ib], sb, qs[ib], 0, 0, 0); } \
        __builtin_amdgcn_sched_barrier(0); \
        _Pragma("unroll") for (int q_ = 0; q_ < 4; ++q_) fa[q_] = fb[q_]; } \
      \
    _Pragma("unroll") for (int ib = 0; ib < 2; ++ib) fa[ib] = afrag(B + O_IN + (32 * ib + r32) * S64 + (4 * hi) * 2); \
      \
    _Pragma("unroll") for (int ib = 0; ib < 2; ++ib) { f32x4 eq_[4]; \
        _Pragma("unroll") for (int i_ = 0; i_ < 4; ++i_) eq_[i_] = *(const LAS f32x4*)(ev + 32 * ib + 8 * i_ + 4 * hi); \
        if (ib == 0) { _Pragma("unroll") for (int q_ = 0; q_ < 4; ++q_) { LAS unsigned char* d_ = wst + ((lane >> 2) + 16 * q_) * 72 + 16 * (lane & 3); *(LAS u32x2*)d_ = (u32x2){UR[q_].x, UR[q_].y}; *(LAS u32x2*)(d_ + 8) = (u32x2){UR[q_].z, UR[q_].w}; } } \
        _Pragma("unroll") for (int r = 0; r < 16; ++r) vn[ib][r] += bf2f(*(const LAS unsigned short*)(wst + (32 * ib + crow(r, hi)) * 72 + 2 * r32)); \
        _Pragma("unroll") for (int r = 0; r < 16; ++r) qs[ib][r] *= eq_[r >> 2][r & 3]; } \
      \
    _Pragma("unroll") for (int it = 0; it < 4; ++it) { const int jb = it >> 1, st = it & 1; \
        if (it + 1 < 4) { const int koffn = (32 * ((it + 1) >> 1) + 16 * ((it + 1) & 1) + 4 * hi) * 2; \
            _Pragma("unroll") for (int ib = 0; ib < 2; ++ib) fb[ib] = afrag(B + O_IN + (32 * ib + r32) * S64 + koffn); } \
        else { _Pragma("unroll") for (int mb = 0; mb < 4; ++mb) fb[mb] = afrag(B + O_KHT + (32 * mb + r32) * S64 + (4 * hi) * 2); }     \
        const bf16x8 vb = pack8(vn[jb], st); \
        __builtin_amdgcn_sched_barrier(0); \
        _Pragma("unroll") for (int ib = 0; ib < 2; ++ib) qs[ib] = __builtin_amdgcn_mfma_f32_32x32x16_bf16(fa[ib], vb, qs[ib], 0, 0, 0); \
        __builtin_amdgcn_sched_barrier(0); \
        if (it + 1 < 4) { fa[0] = fb[0]; fa[1] = fb[1]; } else { _Pragma("unroll") for (int q_ = 0; q_ < 4; ++q_) fa[q_] = fb[q_]; } } \
      \
    _Pragma("unroll") for (int mb = 0; mb < 4; ++mb) S[mb] *= egl; \
    _Pragma("unroll") for (int jb = 0; jb < 2; ++jb) { f32x4 ek_[4]; \
        _Pragma("unroll") for (int i_ = 0; i_ < 4; ++i_) ek_[i_] = *(const LAS f32x4*)(ev + 64 + 32 * jb + 8 * i_ + 4 * hi); \
        _Pragma("unroll") for (int r = 0; r < 16; ++r) vn[jb][r] *= ek_[r >> 2][r & 3]; } \
    _Pragma("unroll") for (int it = 0; it < 4; ++it) { const int jb = it >> 1, st = it & 1; \
        if (it + 1 < 4) { const int koffn = (32 * ((it + 1) >> 1) + 16 * ((it + 1) & 1) + 4 * hi) * 2; \
            _Pragma("unroll") for (int mb = 0; mb < 4; ++mb) fb[mb] = afrag(B + O_KHT + (32 * mb + r32) * S64 + koffn); } \
        const bf16x8 vb = pack8(vn[jb], st); \
        __builtin_amdgcn_sched_barrier(0); \
        _Pragma("unroll") for (int mb = 0; mb < 4; ++mb) S[mb] = __builtin_amdgcn_mfma_f32_32x32x16_bf16(fa[mb], vb, S[mb], 0, 0, 0); \
        __builtin_amdgcn_sched_barrier(0); \
        _Pragma("unroll") for (int q_ = 0; q_ < 4; ++q_) fa[q_] = fb[q_]; } \
    _Pragma("unroll") for (int ib = 0; ib < 2; ++ib) _Pragma("unroll") for (int r = 0; r < 16; ++r) *(LAS unsigned short*)(wst + (32 * ib + crow(r, hi)) * 72 + 2 * r32) = (unsigned short)(cvtpk(qs[ib][r], 0.f) & 0xffffu); \
    bf16* op = OS + (size_t)(rowbase + 64 * (c_) + (lane >> 2)) * 1024 + (size_t)(h * 128 + n0 + 8 * (lane & 3)); \
    _Pragma("unroll") for (int q_ = 0; q_ < 4; ++q_) { const LAS unsigned char* s_ = wst + ((lane >> 2) + 16 * q_) * 72 + 16 * (lane & 3); const u32x2 lo_ = *(const LAS u32x2*)s_, hi_ = *(const LAS u32x2*)(s_ + 8); \
        v4u w_; w_.x = lo_.x; w_.y = lo_.y; w_.z = hi_.x; w_.w = hi_.y; *(GAS v4u*)(op + (size_t)q_ * 16 * 1024) = w_; } } while (0)

__device__ __forceinline__ void scan_item(Frame& F, int s, int h, int dir) {
    const bf16* QHAT = (const bf16*)(F.ws + WS_QHAT); const bf16* KHT = (const bf16*)(F.ws + WS_KHT); const bf16* NWg = (const bf16*)(F.ws + WS_NW); const bf16* Ug = (const bf16*)(F.ws + WS_U);
    const bf16* INTRA = (const bf16*)(F.ws + WS_INTRA); const float* EVEC = (const float*)(F.ws + WS_EVEC);
    bf16* OS = dir ? (bf16*)((unsigned char*)F.out + YO_OB) : (bf16*)(F.ws + WS_OF);
    int rowbase, L; gdn::seq_info(s, rowbase, L); const int n = L / 64;
    const int wid = F.wave; int tid = F.tid, lane = F.lane; asm volatile("" : "+v"(tid), "+v"(lane));
    const int r32 = lane & 31, hi = lane >> 5; const int lt = tid - 256;
    LAS unsigned char* lds = F.lds;
    const bool loader = wid >= 4;
    const int n0 = 32 * (wid & 3);
#define SC_CID(j_) gdn::chunk_id(s, h, dir ? n - 1 - (j_) : (j_))
    if (loader) {
        v4u a0[4], a1[4], a2[4], a3[2], b0[4], b1[4], b2[4], b3[2]; float aev, bev;
        SC_LOAD(a0, a1, a2, a3, aev, SC_CID(0)); SC_WRITE(a0, a1, a2, a3, aev, 0);
        SC_LOAD(a0, a1, a2, a3, aev, SC_CID(1)); SC_LOAD(b0, b1, b2, b3, bev, SC_CID(2));
        LBAR();
        for (int i = 0; i < n; i += 2) {
            SC_WRITE(a0, a1, a2, a3, aev, 1);
            SC_LOAD(a0, a1, a2, a3, aev, SC_CID(i + 3 < n ? i + 3 : n - 1));
            LBAR();
            SC_WRITE(b0, b1, b2, b3, bev, 0);
            SC_LOAD(b0, b1, b2, b3, bev, SC_CID(i + 4 < n ? i + 4 : n - 1));
            LBAR();
        }
    } else {
        f32x16 S[4];
        if (s >= 16) { const float* sd = F.inp[4] + (((size_t)(s - 16) * 2 + dir) * 8 + h) * 16384 + (size_t)(4 * hi * 128 + n0 + r32);
#pragma unroll
            for (int mb = 0; mb < 4; ++mb)
#pragma unroll
                for (int r = 0; r < 16; ++r) S[mb][r] = sd[(32 * mb + (r & 3) + 8 * (r >> 2)) * 128];
        } else {
#pragma unroll
            for (int mb = 0; mb < 4; ++mb) S[mb] = f32x16{};
        }
        v4u ua[4], ub[4];
        LAS unsigned char* wst = lds + 2 * BUF + wid * 4608;
        SC_ULOAD(ua, SC_CID(0)); SC_ULOAD(ub, SC_CID(1));
        LBAR();
        for (int i = 0; i < n; i += 2) {
            SC_STEP(ua, 0, dir ? n - 1 - i : i);
            SC_ULOAD(ua, SC_CID(i + 2 < n ? i + 2 : n - 1));
            LBAR();
            SC_STEP(ub, 1, dir ? n - 2 - i : i + 1);
            SC_ULOAD(ub, SC_CID(i + 3 < n ? i + 3 : n - 1));
            LBAR();
        }
        if (s < 16) { float* so = F.out + OUT_S + (((size_t)s * 2 + dir) * 8 + h) * 16384 + (size_t)(4 * hi * 128 + n0 + r32);
#pragma unroll
            for (int mb = 0; mb < 4; ++mb)
#pragma unroll
                for (int r = 0; r < 16; ++r) so[(32 * mb + (r & 3) + 8 * (r >> 2)) * 128] = S[mb][r]; }
    }
#undef SC_CID
}
}

__device__ __forceinline__ void gdn_finalize(Frame& F, int row0, int nrows, int h) {
    const bf16* OFw = (const bf16*)(F.ws + WS_OF); const bf16* OBw = (const bf16*)((unsigned char*)F.out + YO_OB); const bf16* GATE = (const bf16*)((unsigned char*)F.out + YO_GATE);
    bf16* MIX = (bf16*)(F.ws + WS_MIX); const float* dn = F.inp[14];
    int lane = F.lane; asm volatile("" : "+v"(lane));
    const int tg = lane >> 3, cs = lane & 7; const int c0 = h * 128 + 16 * cs;
    float nw[16];
#pragma unroll
    for (int e = 0; e < 16; ++e) nw[e] = dn[16 * cs + e];
    const int npass = nrows >> 6;
    int row = row0 + 8 * F.wave + tg;
    for (int it0 = 0; it0 < npass; it0 += 4, row += 256) {
        v4u va[4][2], vb[4][2], vg[4][2];
#pragma unroll
        for (int u = 0; u < 4; ++u)
#pragma unroll
            for (int q = 0; q < 2; ++q) { const size_t off = (size_t)(row + 64 * u) * 1024 + c0 + 8 * q; va[u][q] = *(const GAS v4u*)(OFw + off); vb[u][q] = *(const GAS v4u*)(OBw + off); vg[u][q] = *(const GAS v4u*)(GATE + off); }
#pragma unroll
        for (int u = 0; u < 4; ++u) {
            float o[16], g[16]; float ss = 0.f;
#pragma unroll
            for (int q = 0; q < 2; ++q) { const unsigned aw[4] = {va[u][q].x, va[u][q].y, va[u][q].z, va[u][q].w}, bw[4] = {vb[u][q].x, vb[u][q].y, vb[u][q].z, vb[u][q].w}, gw_[4] = {vg[u][q].x, vg[u][q].y, vg[u][q].z, vg[u][q].w};
#pragma unroll
                for (int e = 0; e < 4; ++e) { o[8 * q + 2 * e] = bflo(aw[e]) + bflo(bw[e]); o[8 * q + 2 * e + 1] = bfhi(aw[e]) + bfhi(bw[e]); g[8 * q + 2 * e] = bflo(gw_[e]); g[8 * q + 2 * e + 1] = bfhi(gw_[e]); } }
#pragma unroll
            for (int e = 0; e < 16; ++e) ss += o[e] * o[e];
            ss += __shfl_xor(ss, 1); ss += __shfl_xor(ss, 2); ss += __shfl_xor(ss, 4);
            const float rs = rsqrtf(ss * (1.0f / 128.0f) + EPS);
            v4u w0, w1; unsigned ww[8];
#pragma unroll
            for (int e = 0; e < 8; ++e) ww[e] = cvtpk(o[2 * e] * rs * nw[2 * e] * silu_f(g[2 * e]), o[2 * e + 1] * rs * nw[2 * e + 1] * silu_f(g[2 * e + 1]));
            w0.x = ww[0]; w0.y = ww[1]; w0.z = ww[2]; w0.w = ww[3]; w1.x = ww[4]; w1.y = ww[5]; w1.z = ww[6]; w1.w = ww[7];
            const int rg_ = row + 64 * u;
            bf16* mo = MIX + (size_t)((rg_ >> 8) * 32 + 16 + 2 * h + (cs >> 2)) * 16384 + ((rg_ >> 7) & 1) * 8192;
            *(GAS v4u*)(mo + (pg8::lds_byte(rg_ & 127, 16 * (cs & 3)) >> 1)) = w0; *(GAS v4u*)(mo + (pg8::lds_byte(rg_ & 127, 16 * (cs & 3) + 8) >> 1)) = w1;
        }
    }
}
__device__ __forceinline__ void pair_sync(unsigned* mine, unsigned* theirs) {
    asm volatile("s_waitcnt vmcnt(0)" ::: "memory");
    __syncthreads();
    if (threadIdx.x == 0) {
        const bool same_xcc = __hip_atomic_load(theirs + 1, __ATOMIC_RELAXED, __HIP_MEMORY_SCOPE_AGENT) == xb_xcc_id() + 1u;
        if (!same_xcc) { __builtin_amdgcn_fence(__ATOMIC_RELEASE, "agent"); asm volatile("s_waitcnt vmcnt(0)" ::: "memory"); }
        __hip_atomic_store(mine, 1u, __ATOMIC_RELAXED, __HIP_MEMORY_SCOPE_AGENT);
        unsigned sp = 0u;
        while (__hip_atomic_load(theirs, __ATOMIC_RELAXED, __HIP_MEMORY_SCOPE_AGENT) == 0u) { __builtin_amdgcn_s_sleep(1); if (++sp > (1u << 22)) break; }
        __builtin_amdgcn_fence(__ATOMIC_ACQUIRE, "agent"); asm volatile("s_waitcnt vmcnt(0)" ::: "memory");
    }
    __syncthreads();
}
constexpr int N_PHASES = 10;
#ifndef MK_N_LAUNCHES
#define MK_N_LAUNCHES 1
#endif
constexpr int N_LAUNCHES = MK_N_LAUNCHES;
struct Args { const float* in[22]; float* out; unsigned char* ws; int ph_lo, ph_hi, li, pad; };
__global__ void __launch_bounds__(NWAVES * 64, 2) mega_fwd(Args args) {
    extern __shared__ __attribute__((aligned(16))) unsigned char lds[];
    Frame F;
    F.lds = (LAS unsigned char*)lds; F.ldsg = lds;
    F.MISC = (volatile LAS unsigned*)(F.lds + MISC_OFF);
    F.tid = threadIdx.x; F.lane = F.tid & 63; F.wave = __builtin_amdgcn_readfirstlane(F.tid >> 6);
    F.G = gridDim.x; { const int bx = blockIdx.x; F.vcu = (F.G % 8 == 0) ? (bx % 8) * (F.G / 8) + bx / 8 : bx; }
    F.ws = args.ws; F.out = args.out; F.ctl = (gu32*)(args.ws + WS_CTL);
    F.inp = args.in;
    for (int u = F.tid; u < (LDS_BYTES - LDSCTL_OFF) / 4; u += NWAVES * 64) ((LAS unsigned*)(F.lds + LDSCTL_OFF))[u] = 0u;
    __syncthreads();
    const int lo = args.ph_lo, hi = args.ph_hi;
    const bool use_bar = (hi - lo) > 1;
    XcdBarrier bar; bar.bar = (unsigned*)(F.ctl + CW_BAR); bar.x = 0; bar.st = nullptr;
    if (use_bar) bar = xcd_barrier_post((unsigned*)(F.ctl + CW_BAR), F.MISC + 8);
#define IN(k) (lo <= (k) && (k) < hi)
#define SEAM(k) do { if (IN(k) && IN((k) + 1)) xcd_barrier(bar); } while (0)
    if (IN(0)) { p0_phase(F); SEAM(0); }
    if (IN(1)) { p1_phase(F); SEAM(1); }
    if (IN(2)) {
        p2_ab(F);
        pg8::Gemm g{(const pg8::bf16_t*)(F.ws + WS_XN), (const pg8::bf16_t*)(F.ws + WS_WIN), MROWS, 7168, DM, 0}; pg8::QuadOrder S; S.init(MROWS, 7168, DM, F.G, (int)blockIdx.x);
        unsigned char* yb = (unsigned char*)F.out;
        pg8::EpiInProj E{(pg8::bf16_t*)(yb + YO_QA), (pg8::bf16_t*)(yb + YO_KP), (pg8::bf16_t*)(yb + YO_VP), (pg8::bf16_t*)(F.ws + WS_KS), (pg8::bf16_t*)(F.ws + WS_VS),
                         (pg8::bf16_t*)(F.ws + WS_QKVB), (pg8::bf16_t*)(yb + YO_GATE), F.out + OUT_K, F.out + OUT_V, (const float*)(F.ws + WS_ROPE)};
        pg8::gemm_phase<pg8::EpiInProj, pg8::QuadOrder, true, true, 3, 192>(F.lds + RING_OFF, g, S, E, (float*)(F.ws + WS_MIX), (unsigned*)(F.ctl + CW_FLAG + 2048));
        SEAM(2);
    }
    if (IN(3)) {
        const float* lp = F.inp[15];
        const float lam = __expf(wave_sum(lp[F.lane] * lp[64 + F.lane])) - __expf(wave_sum(lp[128 + F.lane] * lp[192 + F.lane])) + 0.2f;
        const bf16* QA = (const bf16*)((unsigned char*)F.out + YO_QA); bf16* MIX = (bf16*)(F.ws + WS_MIX);
        const bool cl_first = ((F.vcu >> 2) & 1) != 0;
        if (!cl_first) {
        for (int u = 256 + F.vcu; u < 768; u += F.G) {
            const bf16 *Qp, *Kp, *Vp; bf16* Op; int nk;
            if (u < 256) { const int qb = u & 1, bh = u >> 1, b = bh >> 3, h = bh & 7; const size_t r0 = (size_t)(b * 256 + qb * 128);
                Qp = QA + r0 * 1024 + h * 128; Kp = (const bf16*)((unsigned char*)F.out + YO_KP) + (size_t)bh * 256 * 128; Vp = (const bf16*)((unsigned char*)F.out + YO_VP) + (size_t)bh * 256 * 128; Op = MIX + (size_t)((r0 >> 8) * 32 + 2 * h) * 16384 + ((r0 >> 7) & 1) * 8192; nk = 256;
            } else { const int su = (u < 512) ? 2 * (u - 256) : 2 * (u - 512) + 1; const int qb = su & 7, bh = su >> 3, b = bh >> 3, h = bh & 7; const size_t r0 = (size_t)(NPROMPT + b * 1024 + qb * 128);
                Qp = QA + r0 * 1024 + h * 128; Kp = (const bf16*)(F.ws + WS_KS) + (size_t)bh * 1536 * 128; Vp = (const bf16*)(F.ws + WS_VS) + (size_t)bh * 1536 * 128; Op = MIX + (size_t)((r0 >> 8) * 32 + 2 * h) * 16384 + ((r0 >> 7) & 1) * 8192; nk = 1536; }
            dattn::attn_unit(Qp, Kp, Vp, Op, nk, lam, F.inp[16], (char*)lds);
        }
        }
        __syncthreads();
        {
#define CL_DEC(it_, s_, h_, c_) do { if ((it_) < 512) { s_ = (it_) >> 5; h_ = ((it_) >> 2) & 7; c_ = (it_) & 3; } else { const int j_ = (it_) - 512; s_ = 16 + (j_ >> 7); h_ = (j_ >> 4) & 7; c_ = j_ & 15; } } while (0)
            unsigned raw[3][12]; float abv[2];
            int it = F.vcu; int s = 0, h = 0, c = 0;
            if (it < 1536) { CL_DEC(it, s, h, c); gdn::cl_load(F, s, h, c, raw, abv); }
            for (; it < 1536; it += F.G) {
                const int nit = it + F.G; int ns = 0, nh = 0, nc = 0; const bool hn = nit < 1536; if (hn) CL_DEC(nit, ns, nh, nc);
                gdn::chunk_local(F, s, h, c, raw, abv, hn, ns, nh, nc);
                s = ns; h = nh; c = nc;
            }
#undef CL_DEC
        }
        __syncthreads();
        if (cl_first) {
        for (int u = 256 + F.vcu; u < 768; u += F.G) {
            const bf16 *Qp, *Kp, *Vp; bf16* Op; int nk;
            if (u < 256) { const int qb = u & 1, bh = u >> 1, b = bh >> 3, h = bh & 7; const size_t r0 = (size_t)(b * 256 + qb * 128);
                Qp = QA + r0 * 1024 + h * 128; Kp = (const bf16*)((unsigned char*)F.out + YO_KP) + (size_t)bh * 256 * 128; Vp = (const bf16*)((unsigned char*)F.out + YO_VP) + (size_t)bh * 256 * 128; Op = MIX + (size_t)((r0 >> 8) * 32 + 2 * h) * 16384 + ((r0 >> 7) & 1) * 8192; nk = 256;
            } else { const int su = (u < 512) ? 2 * (u - 256) : 2 * (u - 512) + 1; const int qb = su & 7, bh = su >> 3, b = bh >> 3, h = bh & 7; const size_t r0 = (size_t)(NPROMPT + b * 1024 + qb * 128);
                Qp = QA + r0 * 1024 + h * 128; Kp = (const bf16*)(F.ws + WS_KS) + (size_t)bh * 1536 * 128; Vp = (const bf16*)(F.ws + WS_VS) + (size_t)bh * 1536 * 128; Op = MIX + (size_t)((r0 >> 8) * 32 + 2 * h) * 16384 + ((r0 >> 7) & 1) * 8192; nk = 1536; }
            dattn::attn_unit(Qp, Kp, Vp, Op, nk, lam, F.inp[16], (char*)lds);
        }
        }
        SEAM(3);
    }
    if (IN(4)) {
        if (F.vcu < 128 && F.tid == 0) __hip_atomic_store((unsigned*)(F.ctl + CW_PAIR + 64 * F.vcu) + 1, xb_xcc_id() + 1u, __ATOMIC_RELAXED, __HIP_MEMORY_SCOPE_AGENT);
        for (int k = 0; k < 2; ++k) {
            int s_, h_, d_;
            if (F.vcu < 128) { if (k) break; s_ = 16 + (F.vcu >> 4); h_ = (F.vcu >> 1) & 7; d_ = F.vcu & 1; }
            else { const int p = 2 * (F.vcu - 128) + k; if (p >= 256) break; s_ = p >> 4; h_ = (p >> 1) & 7; d_ = p & 1; }
            gscan::scan_item(F, s_, h_, d_);
        }
        { int fr0, fn, fh;
          if (F.vcu < 128) { pair_sync((unsigned*)(F.ctl + CW_PAIR + 64 * F.vcu), (unsigned*)(F.ctl + CW_PAIR + 64 * (F.vcu ^ 1))); fr0 = NPROMPT + (F.vcu >> 4) * 1024 + (F.vcu & 1) * 512; fn = 512; fh = (F.vcu >> 1) & 7; }
          else { asm volatile("s_waitcnt vmcnt(0)" ::: "memory"); __syncthreads(); const int p = 2 * (F.vcu - 128); fr0 = (p >> 4) * 256; fn = 256; fh = (p >> 1) & 7; }
          gdn_finalize(F, fr0, fn, fh); __syncthreads(); }
        if (F.vcu >= 128) {
            const float* lp = F.inp[15];
            const float lam = __expf(wave_sum(lp[F.lane] * lp[64 + F.lane])) - __expf(wave_sum(lp[128 + F.lane] * lp[192 + F.lane])) + 0.2f;
            const bf16* QA = (const bf16*)((unsigned char*)F.out + YO_QA); bf16* MIX = (bf16*)(F.ws + WS_MIX);
            for (int k = 0; k < 2; ++k) { const int u = 2 * (F.vcu - 128) + k; const int qb = u & 1, bh = u >> 1, b = bh >> 3, h = bh & 7; const size_t r0 = (size_t)(b * 256 + qb * 128);
                dattn::attn_unit(QA + r0 * 1024 + h * 128, (const bf16*)((unsigned char*)F.out + YO_KP) + (size_t)bh * 256 * 128, (const bf16*)((unsigned char*)F.out + YO_VP) + (size_t)bh * 256 * 128,
                                 MIX + (size_t)((r0 >> 8) * 32 + 2 * h) * 16384 + ((r0 >> 7) & 1) * 8192, 256, lam, F.inp[16], (char*)lds); }
        }
        SEAM(4);
    }
    if (IN(6)) {
        pg8::Gemm g{(const pg8::bf16_t*)(F.ws + WS_MIX), (const pg8::bf16_t*)(F.ws + WS_WOUT), MROWS, DM, DM, 1}; pg8::PairOrder S; S.init(MROWS, DM, DM, F.G, (int)blockIdx.x, 24);
        pg8::EpiOutProj E{F.inp[0], F.inp[1], (const float*)(F.ws + WS_MOD), F.inp[18], (pg8::bf16_t*)(F.ws + WS_HB), (pg8::bf16_t*)(F.ws + WS_HW), (float*)(F.ws + WS_PART)};
        pg8::gemm_phase<pg8::EpiOutProj, pg8::PairOrder, true, true>(F.lds + RING_OFF, g, S, E, (float*)(F.ws + WS_WIN), (unsigned*)(F.ctl + CW_FLAG), 116, (unsigned)((WS_INTRA - WS_WIN) - 116 * 262144));
        SEAM(6);
    }
    if (IN(7)) {
        pg8::Gemm g{(const pg8::bf16_t*)(F.ws + WS_HW), (const pg8::bf16_t*)(F.ws + WS_WFF1), MROWS, DFF, DM, 1}; pg8::StaticOrder S; S.init(MROWS, DFF, DM, F.G, (int)blockIdx.x);
        LAS float* rt = (LAS float*)(F.lds + RSTD_OFF); const float* PART = (const float*)(F.ws + WS_PART);
        { const int half = F.tid >> 8, rr = F.tid & 255;
            f32x4 pv[3][8]; bool ok[3];
#pragma unroll
            for (int j = 0; j < 3; ++j) { pg8::Unit u; ok[j] = S.next(2 * j + half, u); const float* p = PART + ((size_t)(ok[j] ? u.pm : 0) * 256 + rr) * 32;
#pragma unroll
                for (int q = 0; q < 8; ++q) pv[j][q] = *(const f32x4*)(p + 4 * q); }
#pragma unroll
            for (int j = 0; j < 3; ++j) { float s = 0.f;
#pragma unroll
                for (int q = 0; q < 8; ++q) s += (pv[j][q][0] + pv[j][q][1]) + (pv[j][q][2] + pv[j][q][3]);
                if (ok[j]) rt[(2 * j + half) * 256 + rr] = rsqrtf(s * (1.0f / DM) + EPS); } }
        __syncthreads();
        pg8::EpiFF1 E{(const float*)(F.ws + WS_C2), (pg8::bf16_t*)(F.ws + WS_FF), (const LAS float*)rt};
        pg8::gemm_phase<pg8::EpiFF1, pg8::StaticOrder, true, true>(F.lds + RING_OFF, g, S, E);
        SEAM(7);
    }
    if (IN(8)) {
        pg8::Gemm g{(const pg8::bf16_t*)(F.ws + WS_FF), (const pg8::bf16_t*)(F.ws + WS_WFF2), MROWS, DM, DFF, 1}; pg8::PairOrder S; S.init(MROWS, DM, DFF, F.G, (int)blockIdx.x, 76);
        pg8::EpiFF2 E{(const float*)(F.ws + WS_MOD), (const pg8::bf16_t*)(F.ws + WS_HB), F.out, (float*)(F.ws + WS_PART2), F.inp[21], (unsigned*)(F.ctl + CW_PANEL)};
        pg8::gemm_phase<pg8::EpiFF2, pg8::PairOrder, true, true>(F.lds + RING_OFF, g, S, E, (float*)(F.ws + WS_WIN), (unsigned*)(F.ctl + CW_FLAG + 1024), 116, (unsigned)((WS_INTRA - WS_WIN) - 116 * 262144));
    }
#undef IN
#undef SEAM
}

extern "C" void kernel_launch(void* const* d_in, const int* in_sizes, int n_in, void* d_out, int out_size, void* d_ws, size_t ws_size, hipStream_t stream) {
    static int grid = 0;
    if (grid == 0) {
        if (n_in != 22 || out_size != 37748736 || ws_size < WS_END) { fprintf(stderr, "kernel_launch: unexpected shapes: n_in %d out %d ws %zu (need %zu)\n", n_in, out_size, ws_size, (size_t)WS_END); grid = -1; return; }
        if (hipFuncSetAttribute((const void*)mega_fwd, hipFuncAttributeMaxDynamicSharedMemorySize, LDS_BYTES) != hipSuccess) { fprintf(stderr, "kernel_launch: hipFuncSetAttribute failed\n"); grid = -1; return; }
        int per_cu = 0; (void)hipOccupancyMaxActiveBlocksPerMultiprocessor(&per_cu, (const void*)mega_fwd, NWAVES * 64, LDS_BYTES); (void)hipGetLastError();
        if (per_cu < 1) fprintf(stderr, "kernel_launch: occupancy query reports %d blocks per CU\n", per_cu);
        grid = 256;
    }
    if (grid < 0) return;
    if (hipMemsetAsync((char*)d_ws + WS_CTL, 0, CTL_ZERO_BYTES, stream) != hipSuccess) { fprintf(stderr, "kernel_launch: memset failed\n"); return; }
    Args a{};
    for (int i = 0; i < 22; ++i) a.in[i] = (const float*)d_in[i];
    a.out = (float*)d_out; a.ws = (unsigned char*)d_ws;
    if (N_LAUNCHES == 1) { a.ph_lo = 0; a.ph_hi = N_PHASES; a.li = 0; hipLaunchKernelGGL(mega_fwd, dim3(grid), dim3(NWAVES * 64), LDS_BYTES, stream, a); }
    else { for (int li = 0; li < N_PHASES; ++li) { a.ph_lo = li; a.ph_hi = li + 1; a.li = li; hipLaunchKernelGGL(mega_fwd, dim3(grid), dim3(NWAVES * 64), LDS_BYTES, stream, a); } }
    const hipError_t le = hipPeekAtLastError();
    if (le != hipSuccess) fprintf(stderr, "kernel_launch: launch failed: %s\n", hipGetErrorName(le));
}
```
